# Optimizing an MI355X kernel written in HIP

```python
import jax, jax.numpy as jnp
from jax import lax
import numpy as np

D_MODEL = 2048
BATCH = 2
SEQ = 4096
DEPTH = 1

CONV_CH = D_MODEL // 2
CONV_WIDTH = 31
N_HEADS = 8
HEAD_DIM = 128
ATTN_WIDTH = N_HEADS * HEAD_DIM
ROPE_DIM = HEAD_DIM // 4
ROPE_THETA = 500000.0
MOBA_BLOCK = 256
MOBA_TOPK = 3
Q_CHUNK = 32
N_GROUPS = 4
EXPERTS_PER_GROUP = 8
TOPK_IN_GROUP = 2
EXPERT_FF = D_MODEL // 4
LN_EPS = 1e-5
NEG_INF = -1e30
ALPHA = (2.0 * DEPTH) ** 0.25
BETA = (8.0 * DEPTH) ** -0.25

OFF_GLU_B = CONV_CH
OFF_Q = OFF_GLU_B + CONV_CH
OFF_K = OFF_Q + ATTN_WIDTH
OFF_V = OFF_K + ATTN_WIDTH
OFF_G_CONV = OFF_V + ATTN_WIDTH
OFF_G_ATTN = OFF_G_CONV + D_MODEL
IN_COLS = OFF_G_ATTN + D_MODEL

kernel_name = "hybrid_conformer_moba_hmoe_block"


def layer_norm(x):
    xf = x.astype(jnp.float32)
    mu = jnp.mean(xf, axis=-1, keepdims=True)
    var = jnp.mean(jnp.square(xf - mu), axis=-1, keepdims=True)
    return ((xf - mu) * lax.rsqrt(var + LN_EPS)).astype(x.dtype)


def partial_rope(x, positions):
    half = ROPE_DIM // 2
    inv_freq = jnp.power(ROPE_THETA, -jnp.arange(half, dtype=jnp.float32) / half)
    ang = positions.astype(jnp.float32)[..., None] * inv_freq
    cos = jnp.cos(ang)[:, :, None, :]
    sin = jnp.sin(ang)[:, :, None, :]
    xr = x[..., :ROPE_DIM].astype(jnp.float32)
    x1, x2 = xr[..., :half], xr[..., half:]
    rot = jnp.concatenate([x1 * cos - x2 * sin, x2 * cos + x1 * sin], axis=-1).astype(x.dtype)
    return jnp.concatenate([rot, x[..., ROPE_DIM:]], axis=-1)


def conformer_conv(a, b, w_dw, b_dw, g_cn, b_cn, w_out, b_out):
    h = a * jax.nn.sigmoid(b)
    h = lax.conv_general_dilated(
        h, w_dw[:, None, :], window_strides=(1,), padding=[(CONV_WIDTH - 1, 0)],
        dimension_numbers=("NWC", "WIO", "NWC"), feature_group_count=CONV_CH) + b_dw
    h = jax.nn.silu(layer_norm(h) * g_cn + b_cn)
    return h @ w_out + b_out


def moba_attention(q, k, v):
    B, T, H, hd = q.shape
    nb = -(-T // MOBA_BLOCK)
    tp = nb * MOBA_BLOCK
    pad = ((0, 0), (0, tp - T), (0, 0), (0, 0))
    qh = jnp.pad(q, pad).transpose(0, 2, 1, 3)
    kh = jnp.pad(k, pad).transpose(0, 2, 1, 3)
    vh = jnp.pad(v, pad).transpose(0, 2, 1, 3)
    kblk = kh.reshape(B, H, nb, MOBA_BLOCK, hd)
    vblk = vh.reshape(B, H, nb, MOBA_BLOCK, hd)
    kmean = jnp.mean(kblk.astype(jnp.float32), axis=3)
    gate = jnp.einsum('bhtd,bhnd->bhtn', qh.astype(jnp.float32), kmean)
    q_block = jnp.arange(tp) // MOBA_BLOCK
    fully_past = jnp.arange(nb)[None, :] < q_block[:, None]
    gate = jnp.where(fully_past, gate, -jnp.inf)
    n_sel = min(MOBA_TOPK, nb)
    _, sel = lax.top_k(gate, n_sel)
    scale = hd ** -0.5
    b_idx = jnp.arange(B)[:, None, None, None]
    h_idx = jnp.arange(H)[None, :, None, None]

    def step(ci):
        s = ci * Q_CHUNK
        blk = s // MOBA_BLOCK
        qc = lax.dynamic_slice_in_dim(qh, s, Q_CHUNK, axis=2)
        selc = lax.dynamic_slice_in_dim(sel, s, Q_CHUNK, axis=2)
        valid = selc < blk
        k_sel = kblk[b_idx, h_idx, selc]
        v_sel = vblk[b_idx, h_idx, selc]
        k_own = lax.dynamic_slice_in_dim(kh, blk * MOBA_BLOCK, MOBA_BLOCK, axis=2)
        v_own = lax.dynamic_slice_in_dim(vh, blk * MOBA_BLOCK, MOBA_BLOCK, axis=2)
        s_sel = jnp.einsum('bhqd,bhqjsd->bhqjs', qc, k_sel).astype(jnp.float32) * scale
        s_sel = jnp.where(valid[..., None], s_sel, NEG_INF).reshape(B, H, Q_CHUNK, n_sel * MOBA_BLOCK)
        s_own = jnp.einsum('bhqd,bhsd->bhqs', qc, k_own).astype(jnp.float32) * scale
        qpos = s + jnp.arange(Q_CHUNK)
        kpos = blk * MOBA_BLOCK + jnp.arange(MOBA_BLOCK)
        s_own = jnp.where(kpos[None, :] <= qpos[:, None], s_own, NEG_INF)
        p = jax.nn.softmax(jnp.concatenate([s_sel, s_own], axis=-1), axis=-1).astype(v.dtype)
        p_sel = p[..., :n_sel * MOBA_BLOCK].reshape(B, H, Q_CHUNK, n_sel, MOBA_BLOCK)
        p_own = p[..., n_sel * MOBA_BLOCK:]
        return (jnp.einsum('bhqjs,bhqjsd->bhqd', p_sel, v_sel)
                + jnp.einsum('bhqs,bhsd->bhqd', p_own, v_own))

    out = lax.map(step, jnp.arange(tp // Q_CHUNK))
    out = out.transpose(1, 0, 3, 2, 4).reshape(B, tp, H, hd)
    return out[:, :T]


def hier_moe(u, w_grp, b_grp, w_er, b_er, w1, w3, w2):
    B, T, D = u.shape
    uf = u.reshape(B * T, D)
    grp_logits = (uf @ w_grp).astype(jnp.float32) + b_grp.astype(jnp.float32)
    grp_prob = jax.nn.softmax(grp_logits, axis=-1)
    p_top, g_top = lax.top_k(grp_prob, 1)
    exp_logits = ((uf @ w_er).astype(jnp.float32) + b_er.astype(jnp.float32)).reshape(
        -1, N_GROUPS, EXPERTS_PER_GROUP)
    in_grp = jnp.take_along_axis(exp_logits, g_top[:, :, None], axis=1)[:, 0]
    e_val, e_idx = lax.top_k(in_grp, TOPK_IN_GROUP)
    e_w = jax.nn.softmax(e_val, axis=-1) * p_top
    exp_gate = jnp.sum(jax.nn.one_hot(e_idx, EXPERTS_PER_GROUP, dtype=jnp.float32) * e_w[..., None], axis=1)
    grp_mask = jax.nn.one_hot(g_top[:, 0], N_GROUPS, dtype=jnp.float32)
    gate = (grp_mask[:, :, None] * exp_gate[:, None, :]).astype(u.dtype)
    y = jnp.zeros_like(uf)
    for g in range(N_GROUPS):
        h = jax.nn.silu(jnp.einsum('nd,edf->nef', uf, w1[g])) * jnp.einsum('nd,edf->nef', uf, w3[g])
        y = y + jnp.einsum('nef,efd->nd', h * gate[:, g, :, None], w2[g])
    return y.reshape(B, T, D)


def setup_inputs(seed: int = 0) -> dict:
    key = jax.random.key(seed)
    ks = jax.random.split(key, 26)
    L, D, G, E, F = DEPTH, D_MODEL, N_GROUPS, EXPERTS_PER_GROUP, EXPERT_FF

    def nrm(k, shape, s):
        return jax.random.normal(k, shape, jnp.float32) * s

    col_scale = jnp.ones((IN_COLS,), jnp.float32).at[OFF_V:OFF_V + ATTN_WIDTH].set(BETA)
    positions = (jnp.arange(SEQ, dtype=jnp.int32)[None, :]
                 + jax.random.randint(ks[2], (BATCH, 1), 0, 1024, dtype=jnp.int32))
    return {
        "x": nrm(ks[0], (BATCH, SEQ, D), 1.0),
        "c": nrm(ks[1], (BATCH, D), 1.0),
        "positions": positions,
        "w_cond": nrm(ks[3], (L, D, 6 * D), 0.5 * D ** -0.5),
        "b_cond": nrm(ks[4], (L, 6 * D), 0.01),
        "w_in": nrm(ks[5], (L, D, IN_COLS), D ** -0.5) * col_scale,
        "b_glu": nrm(ks[6], (L, 2 * CONV_CH), 0.01),
        "w_dw": nrm(ks[7], (L, CONV_WIDTH, CONV_CH), CONV_WIDTH ** -0.5),
        "b_dw": nrm(ks[8], (L, CONV_CH), 0.01),
        "g_cn": 1.0 + nrm(ks[9], (L, CONV_CH), 0.02),
        "b_cn": nrm(ks[10], (L, CONV_CH), 0.01),
        "w_conv_out": nrm(ks[11], (L, CONV_CH, D), BETA * CONV_CH ** -0.5),
        "b_conv_out": nrm(ks[12], (L, D), 0.01),
        "w_attn_out": nrm(ks[13], (L, ATTN_WIDTH, D), BETA * ATTN_WIDTH ** -0.5),
        "w_mix_out": nrm(ks[14], (L, D, D), BETA * D ** -0.5),
        "g_ln1": 1.0 + nrm(ks[15], (L, D), 0.02),
        "b_ln1": nrm(ks[16], (L, D), 0.01),
        "w_grp": nrm(ks[17], (L, D, G), D ** -0.5),
        "b_grp": nrm(ks[18], (L, G), 0.01),
        "w_erouter": nrm(ks[19], (L, D, G * E), D ** -0.5),
        "b_erouter": nrm(ks[20], (L, G * E), 0.01),
        "w1": nrm(ks[21], (L, G, E, D, F), D ** -0.5),
        "w3": nrm(ks[22], (L, G, E, D, F), D ** -0.5),
        "w2": nrm(ks[23], (L, G, E, F, D), BETA * F ** -0.5),
        "g_ln2": 1.0 + nrm(ks[24], (L, D), 0.02),
        "b_ln2": nrm(ks[25], (L, D), 0.01),
    }


def reference(x, c, positions, w_cond, b_cond, w_in, b_glu, w_dw, b_dw, g_cn, b_cn,
              w_conv_out, b_conv_out, w_attn_out, w_mix_out, g_ln1, b_ln1,
              w_grp, b_grp, w_erouter, b_erouter, w1, w3, w2, g_ln2, b_ln2):
    B, T, D = x.shape
    for l in range(DEPTH):
        mod = jax.nn.silu(c) @ w_cond[l] + b_cond[l]
        sh1, sc1, gt1, sh2, sc2, gt2 = jnp.split(mod[:, None, :], 6, axis=-1)

        u = layer_norm(x) * (1 + sc1) + sh1
        z = u @ w_in[l]
        glu_a, glu_b, q, k, v, g_conv, g_attn = jnp.split(
            z, [OFF_GLU_B, OFF_Q, OFF_K, OFF_V, OFF_G_CONV, OFF_G_ATTN], axis=-1)
        ba, bb = jnp.split(b_glu[l], 2)
        y_conv = conformer_conv(glu_a + ba, glu_b + bb, w_dw[l], b_dw[l], g_cn[l], b_cn[l],
                                w_conv_out[l], b_conv_out[l])
        q = partial_rope(q.reshape(B, T, N_HEADS, HEAD_DIM), positions)
        k = partial_rope(k.reshape(B, T, N_HEADS, HEAD_DIM), positions)
        v = v.reshape(B, T, N_HEADS, HEAD_DIM)
        y_attn = moba_attention(q, k, v).reshape(B, T, ATTN_WIDTH) @ w_attn_out[l]
        merged = jax.nn.sigmoid(g_conv) * y_conv + jax.nn.sigmoid(g_attn) * y_attn
        t_out = merged @ w_mix_out[l]
        x = layer_norm(ALPHA * x + (1 + gt1) * t_out) * g_ln1[l] + b_ln1[l]

        u2 = layer_norm(x) * (1 + sc2) + sh2
        f = hier_moe(u2, w_grp[l], b_grp[l], w_erouter[l], b_erouter[l], w1[l], w3[l], w2[l])
        x = layer_norm(ALPHA * x + (1 + gt2) * f) * g_ln2[l] + b_ln2[l]
    return x
```

```cpp
#include <hip/hip_runtime.h>
#include <hip/hip_cooperative_groups.h>
#include <cstdio>
#include <cstdint>
#define MK_PER_PHASE 0
namespace mk {
#define LAS __attribute__((address_space(3)))
#define GAS __attribute__((address_space(1)))
typedef unsigned short bf16_t;
typedef short bf16x8 __attribute__((ext_vector_type(8)));
typedef short s16x4 __attribute__((ext_vector_type(4)));
typedef float f32x4 __attribute__((ext_vector_type(4)));
typedef float f32x2 __attribute__((ext_vector_type(2)));
typedef float f32x16 __attribute__((ext_vector_type(16)));
typedef unsigned u32x4 __attribute__((ext_vector_type(4)));
typedef unsigned u32x2 __attribute__((ext_vector_type(2)));

constexpr int D = 2048, NB = 2, T = 4096, NTOK = NB * T, CC = 1024, CW = 31, NH = 8, HD = 128, AW = 1024;
constexpr int INC = 9216, NEXP = 32, FF = 512, MB = 256, NBLK = T / MB;
constexpr float EPS = 1e-5f, ALPHA = 1.189207115002721f;
constexpr int NWAVES = 8, NTHR = 512;

__device__ __forceinline__ unsigned cvt_pk_bf16(float lo, float hi) { unsigned r; asm volatile("v_cvt_pk_bf16_f32 %0, %1, %2" : "=v"(r) : "v"(lo), "v"(hi)); return r; }
__device__ __forceinline__ float bf_lo(unsigned w) { return __uint_as_float(w << 16); }
__device__ __forceinline__ float bf_hi(unsigned w) { return __uint_as_float(w & 0xffff0000u); }
__device__ __forceinline__ float sigm(float v) { return 1.f / (1.f + __expf(-v)); }
__device__ __forceinline__ float silu(float v) { return v / (1.f + __expf(-v)); }
__device__ __forceinline__ float wave_sum(float v) {
#pragma unroll
    for (int o = 1; o < 64; o <<= 1) v += __shfl_xor(v, o);
    return v;
}

constexpr int BM = 256, BK = 64, HALF = 128, HTB = HALF * BK * 2, STAGE_BYTES = 8 * HTB, NXCD = 8, WGM = 8;
__host__ __device__ __forceinline__ int lds_byte(int r, int c) { const int st = (r >> 4) * 2 + (c >> 5), rr = r & 15, cc = c & 31, ob = rr * 64 + cc * 2; return st * 1024 + (ob ^ (((ob >> 9) & 1) << 5)); }
__host__ __device__ __forceinline__ void stage_rc(int b, int& R, int& C) { const int st = b / 1024, sb = b % 1024, swz = sb ^ (((sb >> 9) & 1) << 5); R = (st >> 1) * 16 + swz / 64; C = (st & 1) * 32 + (swz % 64) / 2; }
__host__ __device__ __forceinline__ int perm32(int rho) { const int n = rho >> 4, i = rho & 15; return 8 * (i >> 2) + 4 * n + (i & 3); }

struct Unit { const char* Ab; const char* Bb; unsigned ao[4]; int pm, pn, e, nrow, rbase; };

struct TileOrder {
    int nM, nN, nwg, G, c;
    __device__ void init(int nM_, int nN_, int G_, int c_) { nM = nM_; nN = nN_; nwg = nM * nN; G = G_; c = c_; }
    __device__ bool get(int i, int& pm, int& pn) const {
        const long L = (long)i * G + c; if (L >= nwg) return false;
        int wgid = (int)L; { const int q = nwg / NXCD, r = nwg % NXCD, xcd = wgid % NXCD, off = wgid / NXCD; wgid = (xcd < r ? xcd * (q + 1) : r * (q + 1) + (xcd - r) * q) + off; }
        const int nig = WGM * nN, gid = wgid / nig, fm = gid * WGM, gsz = (nM - fm) < WGM ? (nM - fm) : WGM;
        pm = fm + ((wgid % nig) % gsz); pn = (wgid % nig) / gsz; return true;
    }
};
struct DenseSched {
    const char* A; const char* Bt; int K; TileOrder to; unsigned vo[2];
    __device__ void init(const bf16_t* A_, const bf16_t* Bt_, int M, int N, int K_, int G, int c, int tid) {
        A = (const char*)A_; Bt = (const char*)Bt_; K = K_; to.init(M / BM, N / BM, G, c);
        for (int i = 0; i < 2; ++i) { int R, C; stage_rc(tid * 16 + i * 8192, R, C); vo[i] = (unsigned)(R * K + C) * 2u; }
    }
    __device__ bool next(int i, Unit& u) const {
        int pm, pn; if (!to.get(i, pm, pn)) return false;
        u.pm = pm; u.pn = pn; u.e = 0; u.nrow = 256; u.rbase = pm * 256;
        u.Ab = A + (size_t)pm * 256 * K * 2; u.Bb = Bt + (size_t)pn * 256 * K * 2;
        const unsigned hs = (unsigned)HALF * K * 2u; u.ao[0] = vo[0]; u.ao[1] = vo[1]; u.ao[2] = vo[0] + hs; u.ao[3] = vo[1] + hs; return true;
    }
};

template <class Epi, class Sched, bool ALIGN_EPI, bool SP2>
__device__ __forceinline__ void gemm_phase(LAS unsigned char* lds, const int K, const Sched& S, const Epi& E) {
    int tid_ = threadIdx.x; asm volatile("" : "+v"(tid_));
    const int tid = tid_, wid = __builtin_amdgcn_readfirstlane(tid >> 6), lane = tid & 63, wr = wid >> 2, wc = wid & 3, fr = lane & 15, fq = lane >> 4;
    const int nt = K / BK;
    unsigned voffB[2];
#pragma unroll
    for (int i = 0; i < 2; ++i) { int R, C; stage_rc(tid * 16 + i * 8192, R, C); const int Rb = Epi::PERM ? ((R & ~31) + perm32(R & 31)) : R; voffB[i] = (unsigned)(Rb * K + C) * 2u; }
    const size_t kstep = (size_t)(BK * 2);
    const size_t hstep = (size_t)HALF * K * 2;
    const unsigned ldsw = (unsigned)wid * 1024u;
    const int aoff = lds_byte(wr * 64 + fr, fq * 8), boff = lds_byte(wc * 32 + fr, fq * 8);
#define PG8_SA(b, h) (((b) * 2 + (h)) * HTB)
#define PG8_SB(b, h) ((4 + (b) * 2 + (h)) * HTB)
#define PG8_STAGE(bufoff, gbase, voff) do { _Pragma("unroll") for (int _i = 0; _i < 2; ++_i) \
        __builtin_amdgcn_global_load_lds((const unsigned*)((const char*)(gbase) + (voff)[_i]), (LAS unsigned*)(lds + (bufoff) + ldsw + _i * 8192), 16, 0, 0); } while (0)
#define PG8_STAGEA(bufoff, gbase, o0, o1) do { \
        __builtin_amdgcn_global_load_lds((const unsigned*)((const char*)(gbase) + (o0)), (LAS unsigned*)(lds + (bufoff) + ldsw), 16, 0, 0); \
        __builtin_amdgcn_global_load_lds((const unsigned*)((const char*)(gbase) + (o1)), (LAS unsigned*)(lds + (bufoff) + ldsw + 8192), 16, 0, 0); } while (0)
#define PG8_LDA(dst, b, h) do { _Pragma("unroll") for (int m = 0; m < 4; ++m) _Pragma("unroll") for (int k = 0; k < 2; ++k) dst[m][k] = *(const LAS bf16x8*)(lds + PG8_SA(b, h) + aoff + m * 2048 + k * 1024); } while (0)
#define PG8_LDB(dst, b, h) do { _Pragma("unroll") for (int n = 0; n < 2; ++n) _Pragma("unroll") for (int k = 0; k < 2; ++k) dst[n][k] = *(const LAS bf16x8*)(lds + PG8_SB(b, h) + boff + n * 2048 + k * 1024); } while (0)
#define PG8_MMA(ai, bj, At, Bt) do { __builtin_amdgcn_s_setprio(1); _Pragma("unroll") for (int m = 0; m < 4; ++m) _Pragma("unroll") for (int n = 0; n < 2; ++n) _Pragma("unroll") for (int k = 0; k < 2; ++k) \
        acc[ai][bj][m][n] = __builtin_amdgcn_mfma_f32_16x16x32_bf16(Bt[n][k], At[m][k], acc[ai][bj][m][n], 0, 0, 0); __builtin_amdgcn_s_setprio(0); } while (0)
#define PG8_WAIT_V(n) asm volatile("s_waitcnt vmcnt(" #n ")" ::: "memory")
#define PG8_WAIT_L(n) asm volatile("s_waitcnt lgkmcnt(" #n ")" ::: "memory")
#define PG8_BAR __builtin_amdgcn_s_barrier()
#define PG8_SCHED __builtin_amdgcn_sched_barrier(0)
    Unit cur, nxt; int ui = 0;
    if (!S.next(0, cur)) return;
    f32x4 acc[2][2][4][2];
#pragma unroll
    for (int a = 0; a < 2; ++a)
#pragma unroll
        for (int b = 0; b < 2; ++b)
#pragma unroll
            for (int m = 0; m < 4; ++m)
#pragma unroll
                for (int n = 0; n < 2; ++n) acc[a][b][m][n] = (f32x4){0.f, 0.f, 0.f, 0.f};
    bf16x8 At[4][2], B0[2][2], B1[2][2];
    const char* cA = cur.Ab; const char* cB = cur.Bb;
    if constexpr (SP2) {
        PG8_STAGE(PG8_SB(0, 0), cB, voffB); PG8_STAGE(PG8_SB(0, 1), cB + hstep, voffB); PG8_STAGEA(PG8_SA(0, 0), cA, cur.ao[0], cur.ao[1]); PG8_STAGEA(PG8_SA(0, 1), cA, cur.ao[2], cur.ao[3]);
        if (wr == 1) PG8_BAR;
        PG8_WAIT_V(2); PG8_BAR;
        PG8_STAGE(PG8_SB(1, 0), cB + kstep, voffB); PG8_STAGEA(PG8_SA(1, 0), cA + kstep, cur.ao[0], cur.ao[1]); PG8_STAGE(PG8_SB(1, 1), cB + hstep + kstep, voffB);
        PG8_WAIT_V(6); PG8_BAR;
    } else {
        PG8_STAGE(PG8_SB(0, 0), cB, voffB); PG8_STAGEA(PG8_SA(0, 0), cA, cur.ao[0], cur.ao[1]); PG8_STAGE(PG8_SB(0, 1), cB + hstep, voffB); PG8_STAGEA(PG8_SA(0, 1), cA, cur.ao[2], cur.ao[3]);
        if (wr == 1) PG8_BAR;
        PG8_WAIT_V(4); PG8_BAR;
        PG8_STAGE(PG8_SB(1, 0), cB + kstep, voffB); PG8_STAGEA(PG8_SA(1, 0), cA + kstep, cur.ao[0], cur.ao[1]); PG8_STAGE(PG8_SB(1, 1), cB + hstep + kstep, voffB);
        PG8_WAIT_V(6); PG8_BAR;
    }
    for (;;) {
        const bool has_next = S.next(ui + 1, nxt);
        if (!has_next) nxt = cur;
        const char* nA = nxt.Ab; const char* nB = nxt.Bb;
        for (int t = 0; t < nt; t += 2) {
            const bool last = (t == nt - 2);
            const char* a1 = cA + (size_t)(t + 1) * kstep;
            const char* a2 = last ? nA : cA + (size_t)(t + 2) * kstep; const char* b2 = last ? nB : cB + (size_t)(t + 2) * kstep;
            const char* a3 = a2 + kstep; const char* b3 = b2 + kstep;
            const unsigned o0 = last ? nxt.ao[0] : cur.ao[0], o1 = last ? nxt.ao[1] : cur.ao[1], o2 = last ? nxt.ao[2] : cur.ao[2], o3 = last ? nxt.ao[3] : cur.ao[3];
            if constexpr (SP2) {
            PG8_LDB(B0, 0, 0); PG8_LDB(B1, 0, 1); PG8_SCHED; PG8_LDA(At, 0, 0); PG8_STAGEA(PG8_SA(1, 1), a1, cur.ao[2], cur.ao[3]);
            PG8_WAIT_V(8); PG8_WAIT_L(0); PG8_BAR; PG8_MMA(0, 0, At, B0); PG8_MMA(0, 1, At, B1); PG8_BAR; PG8_SCHED;
            PG8_LDA(At, 0, 1); PG8_STAGE(PG8_SB(0, 0), b2, voffB); PG8_STAGE(PG8_SB(0, 1), b2 + hstep, voffB); PG8_STAGEA(PG8_SA(0, 0), a2, o0, o1);
            PG8_WAIT_V(8); PG8_WAIT_L(0); PG8_BAR; PG8_MMA(1, 0, At, B0); PG8_MMA(1, 1, At, B1); PG8_BAR; PG8_SCHED;
            PG8_LDB(B0, 1, 0); PG8_LDB(B1, 1, 1); PG8_SCHED; PG8_LDA(At, 1, 0); PG8_STAGEA(PG8_SA(0, 1), a2, o2, o3);
            PG8_WAIT_V(8); PG8_WAIT_L(0); PG8_BAR; PG8_MMA(0, 0, At, B0); PG8_MMA(0, 1, At, B1); PG8_BAR; PG8_SCHED;
            PG8_LDA(At, 1, 1); PG8_STAGE(PG8_SB(1, 0), b3, voffB); PG8_STAGE(PG8_SB(1, 1), b3 + hstep, voffB); PG8_STAGEA(PG8_SA(1, 0), a3, o0, o1);
            PG8_WAIT_V(8); PG8_WAIT_L(0); PG8_BAR; PG8_MMA(1, 0, At, B0); PG8_MMA(1, 1, At, B1); PG8_BAR; PG8_SCHED;
            } else {
            PG8_LDB(B0, 0, 0); PG8_SCHED; PG8_LDA(At, 0, 0); PG8_STAGEA(PG8_SA(1, 1), a1, cur.ao[2], cur.ao[3]);
            PG8_WAIT_L(8); PG8_BAR; PG8_WAIT_L(0); PG8_MMA(0, 0, At, B0); PG8_BAR; PG8_SCHED;
            PG8_LDB(B1, 0, 1); PG8_STAGE(PG8_SB(0, 0), b2, voffB);
            PG8_BAR; PG8_WAIT_L(0); PG8_MMA(0, 1, At, B1); PG8_BAR;
            PG8_LDA(At, 0, 1); PG8_STAGEA(PG8_SA(0, 0), a2, o0, o1);
            PG8_BAR; PG8_WAIT_L(0); PG8_MMA(1, 0, At, B0); PG8_BAR; PG8_SCHED;
            PG8_STAGE(PG8_SB(0, 1), b2 + hstep, voffB);
            PG8_WAIT_V(6); PG8_BAR; PG8_MMA(1, 1, At, B1); PG8_BAR;
            PG8_LDB(B0, 1, 0); PG8_SCHED; PG8_LDA(At, 1, 0); PG8_STAGEA(PG8_SA(0, 1), a2, o2, o3);
            PG8_WAIT_L(8); PG8_BAR; PG8_WAIT_L(0); PG8_MMA(0, 0, At, B0); PG8_BAR; PG8_SCHED;
            PG8_LDB(B1, 1, 1); PG8_STAGE(PG8_SB(1, 0), b3, voffB);
            PG8_BAR; PG8_WAIT_L(0); PG8_MMA(0, 1, At, B1); PG8_BAR;
            PG8_LDA(At, 1, 1); PG8_STAGEA(PG8_SA(1, 0), a3, o0, o1);
            PG8_BAR; PG8_WAIT_L(0); PG8_MMA(1, 0, At, B0); PG8_BAR; PG8_SCHED;
            PG8_STAGE(PG8_SB(1, 1), b3 + hstep, voffB);
            PG8_WAIT_V(6); PG8_BAR; PG8_MMA(1, 1, At, B1); PG8_BAR;
            }
        }
        if constexpr (ALIGN_EPI) { if (wr == 0) PG8_BAR; }
        E(acc, cur, wr, wc, fr, fq);
        if (!has_next) break;
#pragma unroll
        for (int a = 0; a < 2; ++a)
#pragma unroll
            for (int b = 0; b < 2; ++b)
#pragma unroll
                for (int m = 0; m < 4; ++m)
#pragma unroll
                    for (int n = 0; n < 2; ++n) acc[a][b][m][n] = (f32x4){0.f, 0.f, 0.f, 0.f};
        cur = nxt; cA = nA; cB = nB; ++ui;
        if constexpr (ALIGN_EPI) { if (wr == 1) PG8_BAR; }
    }
    PG8_WAIT_V(0);
    if constexpr (!ALIGN_EPI) { if (wr == 0) PG8_BAR; }
    PG8_BAR;
#undef PG8_SA
#undef PG8_SB
#undef PG8_STAGE
#undef PG8_STAGEA
#undef PG8_LDA
#undef PG8_LDB
#undef PG8_MMA
#undef PG8_WAIT_V
#undef PG8_WAIT_L
#undef PG8_BAR
#undef PG8_SCHED
}
constexpr size_t MiB = 1u << 20;
constexpr size_t WS_CTL = 0, CTL_ZERO_BYTES = 1 * MiB;
constexpr size_t WS_MODPART = 1 * MiB, WS_MODF = 3 * MiB, WS_ROPE = 4 * MiB, WS_WRT = 5 * MiB, WS_KMEAN = 6 * MiB, WS_TOKL = 7 * MiB, WS_WL = 8 * MiB, WS_PAIR = 9 * MiB;
constexpr size_t WS_WIN = 16 * MiB, WS_WCO = 52 * MiB, WS_WAO = 56 * MiB, WS_WMIX = 60 * MiB, WS_W13 = 68 * MiB, WS_W2 = 196 * MiB;
constexpr size_t WS_R1 = 260 * MiB, WS_U = WS_R1, WS_HGLU = WS_R1 + 32 * MiB, WS_Q = WS_R1 + 48 * MiB, WS_K = WS_R1 + 64 * MiB, WS_V = WS_R1 + 80 * MiB, WS_YPAIR = WS_R1;
constexpr size_t WS_R2 = 356 * MiB, WS_SG = WS_R2, WS_VPRE = WS_R2, WS_HBUF = WS_R2;
constexpr size_t WS_R3 = 420 * MiB, WS_M1 = WS_R3, WS_MERGED = WS_R3 + 32 * MiB, WS_X1 = WS_R3;
constexpr size_t WS_R4 = 484 * MiB, WS_HC = WS_R4, WS_AO = WS_R4 + 16 * MiB, WS_U2 = WS_R4;
constexpr size_t WS_END = 516 * MiB;
constexpr int CW_CNT = 64;
constexpr int MODKC = 16;
constexpr int HB_ROWS = 24576;

constexpr int RING_BYTES = 131072, LDS_MISC = RING_BYTES, LDS_BYTES = 147456;

struct Frame {
    unsigned char* lds; int tid, lane, wave, vcu, G;
    const float *x, *c, *w_cond, *b_cond, *w_in, *b_glu, *w_dw, *b_dw, *g_cn, *b_cn, *w_conv_out, *b_conv_out, *w_attn_out, *w_mix_out, *g_ln1, *b_ln1,
                *w_grp, *b_grp, *w_er, *b_er, *w1, *w3, *w2, *g_ln2, *b_ln2;
    const int* pos; float* out; unsigned char* ws;
};
#define WSP(T, off) ((T*)(F.ws + (off)))

__device__ __forceinline__ unsigned f2bf(float f) { unsigned u = __builtin_bit_cast(unsigned, f); return (u + 0x7fffu + ((u >> 16) & 1u)) >> 16; }
__device__ __forceinline__ unsigned pk2(float lo, float hi) { return f2bf(lo) | (f2bf(hi) << 16); }
__device__ __forceinline__ void transpose_item(const float* W, int K, int N, bf16_t* WT, int k0, int n0, int drow0, float* scr, int lane) {
#pragma unroll 8
    for (int i = 0; i < 32; ++i) { const int kk = 2 * i + (lane >> 5); scr[kk * 33 + (lane & 31)] = W[(size_t)(k0 + kk) * N + n0 + (lane & 31)]; }
    asm volatile("s_waitcnt lgkmcnt(0)" ::: "memory");
    const int cch = lane & 7;
#pragma unroll
    for (int j = 0; j < 4; ++j) { const int n = (lane >> 3) + 8 * j; const float* s = scr + (8 * cch) * 33 + n;
        u32x4 o; o.x = pk2(s[0 * 33], s[1 * 33]); o.y = pk2(s[2 * 33], s[3 * 33]); o.z = pk2(s[4 * 33], s[5 * 33]); o.w = pk2(s[6 * 33], s[7 * 33]);
        *(u32x4*)(WT + (size_t)(drow0 + n) * K + k0 + 8 * cch) = o; }
    asm volatile("s_waitcnt lgkmcnt(0)" ::: "memory");
}
__device__ __forceinline__ int glu_rowmap(int n0, int half) { return (n0 >> 7) * 256 + half * 128 + (n0 & 127); }
__device__ __forceinline__ void p0_prologue(Frame& F) {
    float* ssilu = (float*)F.lds;
    for (int i = F.tid; i < 2 * D; i += NTHR) ssilu[i] = silu(F.c[i]);
    __syncthreads();
    float* scr = (float*)(F.lds + 16384 + F.wave * 8704);
    const int gw = F.vcu * NWAVES + F.wave, NGW = F.G * NWAVES;
    for (int it = gw; it < 192 * MODKC; it += NGW) {
        const int cg = it % 192, kc = it / 192; const int col = cg * 64 + F.lane; float a0 = 0.f, a1 = 0.f;
        const float* wp = F.w_cond + (size_t)(kc * 128) * (6 * D) + col;
#pragma unroll 16
        for (int k = 0; k < 128; ++k) { const float w = wp[(size_t)k * (6 * D)]; a0 += ssilu[kc * 128 + k] * w; a1 += ssilu[D + kc * 128 + k] * w; }
        float* part = WSP(float, WS_MODPART);
        part[(size_t)(kc * 2 + 0) * (6 * D) + col] = a0; part[(size_t)(kc * 2 + 1) * (6 * D) + col] = a1;
    }
    constexpr int I_IN = (D / 64) * (INC / 32), I_CO = (CC / 64) * (D / 32), I_AO = (AW / 64) * (D / 32), I_MIX = (D / 64) * (D / 32);
    constexpr int I_W1E = (D / 64) * (FF / 32), I_W2E = (FF / 64) * (D / 32);
    constexpr int NITEMS = I_IN + I_CO + I_AO + I_MIX + NEXP * (2 * I_W1E + I_W2E);
    for (int it = gw; it < NITEMS; it += NGW) {
        int r = it;
        if (r < I_IN) { const int nblk = INC / 32, kb = r / nblk, nb = r % nblk, n0 = nb * 32; int dr = n0; if (n0 < 1024) dr = glu_rowmap(n0, 0); else if (n0 < 2048) dr = glu_rowmap(n0 - 1024, 1);
            transpose_item(F.w_in, D, INC, WSP(bf16_t, WS_WIN), kb * 64, n0, dr, scr, F.lane); continue; } r -= I_IN;
        if (r < I_CO) { const int nblk = D / 32, kb = r / nblk, nb = r % nblk; transpose_item(F.w_conv_out, CC, D, WSP(bf16_t, WS_WCO), kb * 64, nb * 32, nb * 32, scr, F.lane); continue; } r -= I_CO;
        if (r < I_AO) { const int nblk = D / 32, kb = r / nblk, nb = r % nblk; transpose_item(F.w_attn_out, AW, D, WSP(bf16_t, WS_WAO), kb * 64, nb * 32, nb * 32, scr, F.lane); continue; } r -= I_AO;
        if (r < I_MIX) { const int nblk = D / 32, kb = r / nblk, nb = r % nblk; transpose_item(F.w_mix_out, D, D, WSP(bf16_t, WS_WMIX), kb * 64, nb * 32, nb * 32, scr, F.lane); continue; } r -= I_MIX;
        const int e = r / (2 * I_W1E + I_W2E); r -= e * (2 * I_W1E + I_W2E);
        if (r < 2 * I_W1E) { const int which = r / I_W1E; r -= which * I_W1E; const int nblk = FF / 32, kb = r / nblk, nb = r % nblk, n0 = nb * 32;
            transpose_item((which ? F.w3 : F.w1) + (size_t)e * D * FF, D, FF, WSP(bf16_t, WS_W13) + (size_t)e * 1024 * D, kb * 64, n0, glu_rowmap(n0, which), scr, F.lane); continue; }
        r -= 2 * I_W1E;
        { const int nblk = D / 32, kb = r / nblk, nb = r % nblk; transpose_item(F.w2 + (size_t)e * FF * D, FF, D, WSP(bf16_t, WS_W2) + (size_t)e * D * FF, kb * 64, nb * 32, nb * 32, scr, F.lane); }
    }
    for (int idx = gw * 64 + F.lane; idx < NTOK * 16; idx += NGW * 64) { const int row = idx >> 4, f = idx & 15;
        const float inv = powf(500000.f, -(float)f / 16.f); const float ang = (float)F.pos[row] * inv; float sn, cs; sincosf(ang, &sn, &cs);
        float* rp = WSP(float, WS_ROPE); rp[row * 32 + f] = cs; rp[row * 32 + 16 + f] = sn; }
    for (int idx = gw * 64 + F.lane; idx < 36 * D; idx += NGW * 64) { const int o = idx / D, k = idx % D;
        WSP(float, WS_WRT)[idx] = (o < 4) ? F.w_grp[k * 4 + o] : F.w_er[k * 32 + (o - 4)]; }
}

__device__ __forceinline__ void p1_ln(Frame& F) {
    float* sm = (float*)F.lds;
    const int r0 = F.vcu * 32, b = r0 / T;
    const float* part = WSP(float, WS_MODPART);
    for (int idx = F.tid; idx < 2 * D; idx += NTHR) { const int j = idx; float v = F.b_cond[j];
#pragma unroll
        for (int kc = 0; kc < MODKC; ++kc) v += part[(size_t)(kc * 2 + b) * (6 * D) + j];
        sm[idx] = v; }
    if (F.tid < 96) { const int idx = F.vcu * 96 + F.tid; const int bb = idx / (6 * D), j = idx % (6 * D); float v = F.b_cond[j];
#pragma unroll
        for (int kc = 0; kc < MODKC; ++kc) v += part[(size_t)(kc * 2 + bb) * (6 * D) + j];
        WSP(float, WS_MODF)[idx] = v; }
    __syncthreads();
#pragma unroll 1
    for (int i = 0; i < 4; ++i) {
        const int row = r0 + F.wave * 4 + i;
        const f32x4* xr = (const f32x4*)(F.x + (size_t)row * D) + F.lane;
        f32x4 v[8]; float s = 0.f;
#pragma unroll
        for (int j = 0; j < 8; ++j) { v[j] = xr[64 * j]; s += (v[j].x + v[j].y) + (v[j].z + v[j].w); }
        const float mean = wave_sum(s) * (1.f / D); float s2 = 0.f;
#pragma unroll
        for (int j = 0; j < 8; ++j) { v[j] = v[j] - mean; s2 += (v[j].x * v[j].x + v[j].y * v[j].y) + (v[j].z * v[j].z + v[j].w * v[j].w); }
        const float rstd = rsqrtf(wave_sum(s2) * (1.f / D) + EPS);
        u32x2* o8 = (u32x2*)(WSP(bf16_t, WS_U) + (size_t)row * D) + F.lane;
#pragma unroll
        for (int j = 0; j < 8; ++j) { const int col = 4 * F.lane + 256 * j; const f32x4 sh = *(const f32x4*)(sm + col), sc = *(const f32x4*)(sm + D + col);
            const f32x4 y = v[j] * rstd * (sc + 1.f) + sh; u32x2 w; w.x = cvt_pk_bf16(y.x, y.y); w.y = cvt_pk_bf16(y.z, y.w); o8[64 * j] = w; }
    }
}

struct EpiIn {
    static constexpr bool PERM = true;
    const float* b_glu; const float* ropecs; bf16_t *hglu, *q, *k, *v, *sg;
    __device__ __forceinline__ void operator()(const f32x4 (&acc)[2][2][4][2], const Unit& u, int wr, int wc, int fr, int fq) const {
        const int row0 = u.pm * BM + wr * 64 + fr, pn = u.pn;
        if (pn < 8) {
            const int c0 = pn * 128 + wc * 32 + 8 * fq;
            const f32x4 ba0 = *(const f32x4*)(b_glu + c0), ba1 = *(const f32x4*)(b_glu + c0 + 4), bb0 = *(const f32x4*)(b_glu + CC + c0), bb1 = *(const f32x4*)(b_glu + CC + c0 + 4);
#pragma unroll
            for (int ai = 0; ai < 2; ++ai)
#pragma unroll
                for (int m = 0; m < 4; ++m) { const int row = row0 + ai * HALF + m * 16;
                    const f32x4 a0 = acc[ai][0][m][0] + ba0, a1 = acc[ai][0][m][1] + ba1, g0 = acc[ai][1][m][0] + bb0, g1 = acc[ai][1][m][1] + bb1;
                    u32x4 w; w.x = cvt_pk_bf16(a0[0] * sigm(g0[0]), a0[1] * sigm(g0[1])); w.y = cvt_pk_bf16(a0[2] * sigm(g0[2]), a0[3] * sigm(g0[3]));
                    w.z = cvt_pk_bf16(a1[0] * sigm(g1[0]), a1[1] * sigm(g1[1])); w.w = cvt_pk_bf16(a1[2] * sigm(g1[2]), a1[3] * sigm(g1[3]));
                    *(u32x4*)(hglu + (size_t)row * CC + c0) = w; }
        } else if (pn < 16) {
            bf16_t* dst = (pn < 12) ? q : k; const int colt = (pn - ((pn < 12) ? 8 : 12)) * 256;
#pragma unroll
            for (int ai = 0; ai < 2; ++ai)
#pragma unroll
                for (int m = 0; m < 4; ++m) { const int row = row0 + ai * HALF + m * 16;
                    f32x4 cs0, cs1, sn0, sn1;
                    if (wc == 0) { const float* rp = ropecs + (size_t)row * 32 + 8 * (fq & 1); cs0 = *(const f32x4*)rp; cs1 = *(const f32x4*)(rp + 4); sn0 = *(const f32x4*)(rp + 16); sn1 = *(const f32x4*)(rp + 20);
                        if (fq < 2) { sn0 = -sn0; sn1 = -sn1; } }
#pragma unroll
                    for (int bj = 0; bj < 2; ++bj) { f32x4 v0 = acc[ai][bj][m][0], v1 = acc[ai][bj][m][1];
                        if (wc == 0) { f32x4 p0, p1;
#pragma unroll
                            for (int j = 0; j < 4; ++j) { p0[j] = __shfl_xor(v0[j], 32); p1[j] = __shfl_xor(v1[j], 32); }
                            v0 = v0 * cs0 + p0 * sn0; v1 = v1 * cs1 + p1 * sn1; }
                        u32x4 w; w.x = cvt_pk_bf16(v0[0], v0[1]); w.y = cvt_pk_bf16(v0[2], v0[3]); w.z = cvt_pk_bf16(v1[0], v1[1]); w.w = cvt_pk_bf16(v1[2], v1[3]);
                        *(u32x4*)(dst + (size_t)row * AW + colt + bj * HALF + wc * 32 + 8 * fq) = w; } }
        } else if (pn < 20) {
            const int colt = (pn - 16) * 256;
#pragma unroll
            for (int ai = 0; ai < 2; ++ai)
#pragma unroll
                for (int m = 0; m < 4; ++m) { const int row = row0 + ai * HALF + m * 16;
#pragma unroll
                    for (int bj = 0; bj < 2; ++bj) { const f32x4 v0 = acc[ai][bj][m][0], v1 = acc[ai][bj][m][1];
                        u32x4 w; w.x = cvt_pk_bf16(v0[0], v0[1]); w.y = cvt_pk_bf16(v0[2], v0[3]); w.z = cvt_pk_bf16(v1[0], v1[1]); w.w = cvt_pk_bf16(v1[2], v1[3]);
                        *(u32x4*)(v + (size_t)row * AW + colt + bj * HALF + wc * 32 + 8 * fq) = w; } }
        } else {
            const int colt = (pn - 20) * 256;
#pragma unroll
            for (int ai = 0; ai < 2; ++ai)
#pragma unroll
                for (int m = 0; m < 4; ++m) { const int row = row0 + ai * HALF + m * 16;
#pragma unroll
                    for (int bj = 0; bj < 2; ++bj) { const f32x4 v0 = acc[ai][bj][m][0], v1 = acc[ai][bj][m][1];
                        u32x4 w; w.x = cvt_pk_bf16(sigm(v0[0]), sigm(v0[1])); w.y = cvt_pk_bf16(sigm(v0[2]), sigm(v0[3])); w.z = cvt_pk_bf16(sigm(v1[0]), sigm(v1[1])); w.w = cvt_pk_bf16(sigm(v1[2]), sigm(v1[3]));
                        *(u32x4*)(sg + (size_t)row * 4096 + colt + bj * HALF + wc * 32 + 8 * fq) = w; } }
        }
    }
};

__device__ __forceinline__ void p3_conv_unit(Frame& F, int unit) {
    const int t0g = unit * 32;
    const int tin = t0g % T;
    float* st = (float*)F.lds;
    {
        const int ch = 2 * F.tid;
        const bf16_t* hg = WSP(bf16_t, WS_HGLU);
        unsigned in[62];
#pragma unroll
        for (int r = 0; r < 62; ++r) { const int tt = tin - 30 + r; in[r] = (tt >= 0) ? *(const unsigned*)(hg + (size_t)(t0g - 30 + r) * CC + ch) : 0u; }
        f32x2 acc[32]; const f32x2 bd = *(const f32x2*)(F.b_dw + ch);
#pragma unroll
        for (int o = 0; o < 32; ++o) acc[o] = bd;
#pragma unroll
        for (int w = 0; w < CW; ++w) { const f32x2 kw = *(const f32x2*)(F.w_dw + w * CC + ch);
#pragma unroll
            for (int o = 0; o < 32; ++o) { const unsigned iv = in[o + w]; acc[o].x += bf_lo(iv) * kw.x; acc[o].y += bf_hi(iv) * kw.y; } }
#pragma unroll
        for (int o = 0; o < 32; ++o) *(f32x2*)(st + o * CC + ch) = acc[o];
    }
    __syncthreads();
#pragma unroll 1
    for (int i = 0; i < 4; ++i) {
        const int o = F.wave * 4 + i; f32x4 v[4]; float s = 0.f;
#pragma unroll
        for (int j = 0; j < 4; ++j) { v[j] = *(const f32x4*)(st + o * CC + 4 * F.lane + 256 * j); s += (v[j].x + v[j].y) + (v[j].z + v[j].w); }
        const float mean = wave_sum(s) * (1.f / CC); float s2 = 0.f;
#pragma unroll
        for (int j = 0; j < 4; ++j) { v[j] = v[j] - mean; s2 += (v[j].x * v[j].x + v[j].y * v[j].y) + (v[j].z * v[j].z + v[j].w * v[j].w); }
        const float rstd = rsqrtf(wave_sum(s2) * (1.f / CC) + EPS);
        u32x2* o8 = (u32x2*)(WSP(bf16_t, WS_HC) + (size_t)(t0g + o) * CC) + F.lane;
#pragma unroll
        for (int j = 0; j < 4; ++j) { const int col = 4 * F.lane + 256 * j; const f32x4 g = *(const f32x4*)(F.g_cn + col), bb = *(const f32x4*)(F.b_cn + col);
            const f32x4 y = v[j] * rstd * g + bb; u32x2 w; w.x = cvt_pk_bf16(silu(y.x), silu(y.y)); w.y = cvt_pk_bf16(silu(y.z), silu(y.w)); o8[64 * j] = w; }
    }
    __syncthreads();
}
__device__ __forceinline__ void p3_kmean_unit(Frame& F, int unit) {
    const int blk = unit & 15, h = (unit >> 4) & 7, b = unit >> 7;
    const bf16_t* kp = WSP(bf16_t, WS_K) + (size_t)(b * T + blk * MB + F.wave * 32) * AW + h * HD + 2 * F.lane;
    float s0 = 0.f, s1 = 0.f;
#pragma unroll 8
    for (int r = 0; r < 32; ++r) { const unsigned w = *(const unsigned*)(kp + (size_t)r * AW); s0 += bf_lo(w); s1 += bf_hi(w); }
    float* red = (float*)F.lds;
    red[F.wave * 128 + 2 * F.lane] = s0; red[F.wave * 128 + 2 * F.lane + 1] = s1;
    __syncthreads();
    if (F.tid < 128) { float s = 0.f;
#pragma unroll
        for (int w = 0; w < 8; ++w) s += red[w * 128 + F.tid];
        WSP(float, WS_KMEAN)[unit * HD + F.tid] = s * (1.f / MB); }
    __syncthreads();
}
namespace att {
constexpr float SCALE = 0.088388347648318440f, THR = 8.f, NEGM = -1e37f;
constexpr int SHM_T = 16384;
#define KSWZ(row, colB) ((row) * 256 + ((colB) ^ (((row) & 7) << 4)))
#define SBAR() __builtin_amdgcn_sched_barrier(0)
__device__ __forceinline__ int crow(int r, int hi) { return (r & 3) + 8 * (r >> 2) + 4 * hi; }
__device__ __forceinline__ void partialSM(f32x16& p0, f32x16& p1, float& m_reg, float& mn, float& alpha) {
    constexpr float C = SCALE * 1.4426950408889634f;
    float pmax = p0[0];
#pragma unroll
    for (int r = 1; r < 16; ++r) pmax = fmaxf(pmax, p0[r]);
#pragma unroll
    for (int r = 0; r < 16; ++r) pmax = fmaxf(pmax, p1[r]);
    { auto rr = __builtin_amdgcn_permlane32_swap(__float_as_uint(pmax), __float_as_uint(pmax), false, false); pmax = fmaxf(__uint_as_float(rr[0]), __uint_as_float(rr[1])); }
    if (__builtin_expect(__all(pmax - m_reg <= THR / SCALE), 1)) { mn = m_reg; alpha = 1.f; }
    else { mn = fmaxf(m_reg, pmax); alpha = __builtin_amdgcn_exp2f((m_reg - mn) * C); m_reg = mn; }
    const float mnC = -mn * C;
#pragma unroll
    for (int r = 0; r < 16; ++r) p0[r] = fmaf(p0[r], C, mnC);
#pragma unroll
    for (int r = 0; r < 16; ++r) p1[r] = fmaf(p1[r], C, mnC);
#pragma unroll
    for (int r = 0; r < 16; ++r) p0[r] = __builtin_amdgcn_exp2f(p0[r]);
}
__device__ __forceinline__ void finishSM(f32x16& p0, f32x16& p1, float alpha, float& l_reg, bf16x8& pa0, bf16x8& pa1, bf16x8& pa2, bf16x8& pa3) {
#pragma unroll
    for (int r = 0; r < 16; ++r) p1[r] = __builtin_amdgcn_exp2f(p1[r]);
    float ps = 0;
#pragma unroll
    for (int r = 0; r < 16; ++r) ps += p0[r];
#pragma unroll
    for (int r = 0; r < 16; ++r) ps += p1[r];
    { auto rr = __builtin_amdgcn_permlane32_swap(__float_as_uint(ps), __float_as_uint(ps), false, false); ps = __uint_as_float(rr[0]) + __uint_as_float(rr[1]); }
    l_reg = l_reg * alpha + ps;
#define PK4(P, BASE, OUT) do { unsigned a0 = cvt_pk_bf16(P[BASE + 0], P[BASE + 1]), a1 = cvt_pk_bf16(P[BASE + 2], P[BASE + 3]);   \
    unsigned b0 = cvt_pk_bf16(P[BASE + 4], P[BASE + 5]), b1 = cvt_pk_bf16(P[BASE + 6], P[BASE + 7]);                              \
    auto r0 = __builtin_amdgcn_permlane32_swap(a0, b0, false, false); auto r1 = __builtin_amdgcn_permlane32_swap(a1, b1, false, false); \
    u32x4 w = {r0[0], r1[0], r0[1], r1[1]}; OUT = *reinterpret_cast<bf16x8*>(&w); } while (0)
    PK4(p0, 0, pa0); PK4(p0, 8, pa1); PK4(p1, 0, pa2); PK4(p1, 8, pa3);
#undef PK4
}
__device__ __forceinline__ void qkt(f32x16& p0, f32x16& p1, const unsigned char* Ks, const bf16x8* qr, int r32, int hi) {
    p0 = f32x16{}; p1 = f32x16{};
#pragma unroll
    for (int d0 = 0; d0 < 8; ++d0) { const int cb = (d0 * 16 + hi * 8) * 2;
        const bf16x8 b0 = *reinterpret_cast<const bf16x8*>(Ks + KSWZ(r32, cb));
        const bf16x8 b1 = *reinterpret_cast<const bf16x8*>(Ks + KSWZ(32 + r32, cb));
        p0 = __builtin_amdgcn_mfma_f32_32x32x16_bf16(b0, qr[d0], p0, 0, 0, 0);
        p1 = __builtin_amdgcn_mfma_f32_32x32x16_bf16(b1, qr[d0], p1, 0, 0, 0); }
}
__device__ __forceinline__ int v_st(int k, int c) { const int kk = (k & ~0xC) | ((k & 4) << 1) | ((k & 8) >> 1); return ((kk >> 3) * 4 + (c >> 5)) * 512 + ((kk & 7) * 32 + (c & 31)) * 2; }
__device__ __forceinline__ int v_rd_base(int lane) { return ((lane & 3) << 3) | (((lane >> 2) & 3) << 6) | (((lane >> 4) & 1) << 5) | (((lane >> 5) & 1) << 8); }
constexpr int v_rd_off(int d0, int ks, int half) { return d0 * 512 + ks * 4096 + half * 2048; }
template <int OFF> __device__ __forceinline__ s16x4 tr_read(int vb) { s16x4 r; asm volatile("ds_read_b64_tr_b16 %0, %1 offset:%2" : "=&v"(r) : "v"(vb), "i"(OFF) : "memory"); return r; }
template <int D0> __device__ __forceinline__ void pv_one(f32x16& od, int vb, bf16x8 pa0, bf16x8 pa1, bf16x8 pa2, bf16x8 pa3) {
    const s16x4 l0 = tr_read<v_rd_off(D0, 0, 0)>(vb), h0 = tr_read<v_rd_off(D0, 0, 1)>(vb), l1 = tr_read<v_rd_off(D0, 1, 0)>(vb), h1 = tr_read<v_rd_off(D0, 1, 1)>(vb);
    const s16x4 l2 = tr_read<v_rd_off(D0, 2, 0)>(vb), h2 = tr_read<v_rd_off(D0, 2, 1)>(vb), l3 = tr_read<v_rd_off(D0, 3, 0)>(vb), h3 = tr_read<v_rd_off(D0, 3, 1)>(vb);
    asm volatile("s_waitcnt lgkmcnt(0)" ::: "memory"); SBAR();
#define PK(L, H) (bf16x8){L[0], L[1], L[2], L[3], H[0], H[1], H[2], H[3]}
    od = __builtin_amdgcn_mfma_f32_32x32x16_bf16(pa0, PK(l0, h0), od, 0, 0, 0);
    od = __builtin_amdgcn_mfma_f32_32x32x16_bf16(pa1, PK(l1, h1), od, 0, 0, 0);
    od = __builtin_amdgcn_mfma_f32_32x32x16_bf16(pa2, PK(l2, h2), od, 0, 0, 0);
    od = __builtin_amdgcn_mfma_f32_32x32x16_bf16(pa3, PK(l3, h3), od, 0, 0, 0);
#undef PK
}
__device__ __forceinline__ void pv_d0(f32x16* o, int vb, bf16x8 pa0, bf16x8 pa1, bf16x8 pa2, bf16x8 pa3) {
    pv_one<0>(o[0], vb, pa0, pa1, pa2, pa3); pv_one<1>(o[1], vb, pa0, pa1, pa2, pa3); pv_one<2>(o[2], vb, pa0, pa1, pa2, pa3); pv_one<3>(o[3], vb, pa0, pa1, pa2, pa3);
}
__device__ __forceinline__ void amask(f32x16& p0, f32x16& p1, int tau, int iblk, unsigned selmask, int qin, int hi) {
    const int j = tau >> 2;
    if (j < iblk) { const bool ok = (selmask >> j) & 1u;
#pragma unroll
        for (int r = 0; r < 16; ++r) { p0[r] = ok ? p0[r] : NEGM; p1[r] = ok ? p1[r] : NEGM; }
    } else { const int kb = 64 * (tau & 3) + 4 * hi;
#pragma unroll
        for (int r = 0; r < 16; ++r) { const int kv = kb + (r & 3) + 8 * (r >> 2); p0[r] = (kv > qin) ? NEGM : p0[r]; p1[r] = (kv + 32 > qin) ? NEGM : p1[r]; } }
}
__device__ __forceinline__ void attn_unit(Frame& F, LAS unsigned char* ring, int b, int h, int iblk, int half) {
    const int tid = F.tid, wid = F.wave, lane = F.lane, r32 = lane & 31, hi = lane >> 5, grp = wid >> 2, wq = wid & 3;
    unsigned char* lds = F.lds; unsigned char* misc = lds + LDS_MISC;
    float* wsf = (float*)misc + wid * 64; float* li_l = wsf; float* al_l = wsf + 32;
    float* kml = (float*)(misc + 2048);
    const bf16_t* Qg = WSP(bf16_t, WS_Q); const bf16_t* Kg = WSP(bf16_t, WS_K); const bf16_t* Vg = WSP(bf16_t, WS_V);
    const size_t rowb = (size_t)b * T;
    { const float* km = WSP(float, WS_KMEAN) + (size_t)(b * NH + h) * NBLK * HD; *(f32x4*)(kml + tid * 4) = *(const f32x4*)(km + tid * 4); }
    const int qin = half * 128 + wq * 32 + r32;
    const bf16_t* Qw = Qg + (rowb + iblk * MB + qin) * AW + h * HD + hi * 8;
    bf16x8 qr[8];
#pragma unroll
    for (int d0 = 0; d0 < 8; ++d0) qr[d0] = *reinterpret_cast<const bf16x8*>(Qw + d0 * 16);
    __syncthreads();
    unsigned selmask = 0;
    {
        float* gl = (float*)lds + wid * 1024;
#pragma unroll 1
        for (int j = 0; j < iblk; ++j) { float g = 0.f; const float* kj = kml + j * HD + hi * 8;
#pragma unroll
            for (int d0 = 0; d0 < 8; ++d0) { const f32x4 k0 = *(const f32x4*)(kj + d0 * 16), k1 = *(const f32x4*)(kj + d0 * 16 + 4);
#define QF(e) __uint_as_float(((unsigned)(unsigned short)qr[d0][e]) << 16)
                g += (QF(0) * k0[0] + QF(1) * k0[1]) + (QF(2) * k0[2] + QF(3) * k0[3]) + (QF(4) * k1[0] + QF(5) * k1[1]) + (QF(6) * k1[2] + QF(7) * k1[3]);
#undef QF
            }
            g += __shfl_xor(g, 32); gl[j * 64 + lane] = g; }
#pragma unroll 1
        for (int sidx = 0; sidx < 3; ++sidx) { int best = -1; float bv = -INFINITY;
#pragma unroll 1
            for (int j = 0; j < iblk; ++j) { const float g = gl[j * 64 + lane]; const bool c = !((selmask >> j) & 1u) && (g > bv); bv = c ? g : bv; best = c ? j : best; }
            if (best >= 0) selmask |= 1u << best; }
    }
    __syncthreads();
    unsigned char* V_lds = lds; unsigned char* K_lds = lds + 4 * SHM_T;
    float m_reg = -1e30f, l_reg = 0; f32x16 o[4] = {};
    const bf16_t* Kh = Kg + rowb * AW + h * HD; const bf16_t* Vh = Vg + rowb * AW + h * HD;
    const int vb0 = (int)(uintptr_t)(V_lds + grp * SHM_T) + v_rd_base(lane);
    const char* Kb = (const char*)Kh; const char* Vb = (const char*)Vh;
    unsigned koff[4], voff[4];
#pragma unroll
    for (int i = 0; i < 4; ++i) { const int p = 4 * wq + i;
        const int row = 4 * p + (lane >> 4), cK = (lane & 15) ^ (row & 7); koff[i] = (unsigned)(((64 * grp + row) * AW + 8 * cK) * 2);
        const int sbt = 2 * p + (lane >> 5), kk = (sbt >> 2) * 8 + ((lane & 31) >> 2), kv = (kk & ~0xC) | ((kk & 4) << 1) | ((kk & 8) >> 1), cV = (sbt & 3) * 32 + 8 * (lane & 3);
        voff[i] = (unsigned)(((64 * grp + kv) * AW + cV) * 2); }
#define DMA_K(bf, step) do { _Pragma("unroll") for (int i_ = 0; i_ < 4; ++i_) { unsigned o_ = koff[i_]; asm volatile("" : "+v"(o_)); __builtin_amdgcn_global_load_lds((const unsigned*)(Kb + (size_t)(step) * 128 * AW * 2 + o_), \
        (LAS unsigned*)(ring + 4 * SHM_T + ((bf) * 2 + grp) * SHM_T + (4 * wq + i_) * 1024), 16, 0, 0); } } while (0)
#define DMA_V(bf, step) do { _Pragma("unroll") for (int i_ = 0; i_ < 4; ++i_) { unsigned o_ = voff[i_]; asm volatile("" : "+v"(o_)); __builtin_amdgcn_global_load_lds((const unsigned*)(Vb + (size_t)(step) * 128 * AW * 2 + o_), \
        (LAS unsigned*)(ring + ((bf) * 2 + grp) * SHM_T + (4 * wq + i_) * 1024), 16, 0, 0); } } while (0)
#define WAITB() do { asm volatile("s_waitcnt vmcnt(0) lgkmcnt(0)" ::: "memory"); __builtin_amdgcn_s_barrier(); asm volatile("" ::: "memory"); } while (0)
#define RESC(a) do { if (__any((a) < 1.f)) { if (hi == 0) al_l[r32] = (a); asm volatile("s_waitcnt lgkmcnt(0)" ::: "memory"); \
    _Pragma("unroll") for (int d = 0; d < 4; ++d) _Pragma("unroll") for (int r = 0; r < 16; ++r) o[d][r] *= al_l[crow(r, hi)]; } } while (0)
#define KBUF(bf) (K_lds + ((bf) * 2 + grp) * SHM_T)
#define MASK(P0, P1, s) amask(P0, P1, 2 * (s) + grp, iblk, selmask, qin, hi)
    f32x16 p0, p1; float mn, al; bf16x8 pa0, pa1, pa2, pa3; const int NT = 2 * (iblk + 1);
    DMA_K(0, 0); DMA_V(0, 0);
#pragma unroll 1
    for (int st = 0; st < NT; ++st) {
        const int bf = st & 1;
        WAITB();
        if (st + 1 < NT) { DMA_K(bf ^ 1, st + 1); DMA_V(bf ^ 1, st + 1); }
        qkt(p0, p1, KBUF(bf), qr, r32, hi); MASK(p0, p1, st); partialSM(p0, p1, m_reg, mn, al);
        RESC(al);
        finishSM(p0, p1, al, l_reg, pa0, pa1, pa2, pa3); SBAR();
        pv_d0(o, vb0 + bf * 2 * SHM_T, pa0, pa1, pa2, pa3);
    }
#undef DMA_K
#undef DMA_V
#undef WAITB
#undef RESC
#undef KBUF
#undef MASK
    __syncthreads();
    float* obuf = (float*)lds;
    float* ml = (float*)(misc + 10240);
    if (grp == 1) {
#pragma unroll
        for (int d = 0; d < 4; ++d)
#pragma unroll
            for (int r = 0; r < 16; ++r) obuf[(wq * 64 + d * 16 + r) * 64 + lane] = o[d][r];
        if (hi == 0) { ml[wq * 64 + r32] = m_reg; ml[wq * 64 + 32 + r32] = l_reg; }
    }
    __syncthreads();
    if (grp == 0) {
        constexpr float C = SCALE * 1.4426950408889634f;
        const float m1 = ml[wq * 64 + r32], l1 = ml[wq * 64 + 32 + r32];
        const float M = fmaxf(m_reg, m1), f0 = __builtin_amdgcn_exp2f((m_reg - M) * C), f1 = __builtin_amdgcn_exp2f((m1 - M) * C);
        const float linv = 1.f / (l_reg * f0 + l1 * f1);
        if (hi == 0) { li_l[r32] = f0 * linv; al_l[r32] = f1 * linv; }
        asm volatile("s_waitcnt lgkmcnt(0)" ::: "memory");
        bf16_t* stg = (bf16_t*)(lds + 65536 + wq * 8192);
#pragma unroll
        for (int r = 0; r < 16; ++r) { const int orow = crow(r, hi); const float a0 = li_l[orow], a1 = al_l[orow];
#pragma unroll
            for (int d = 0; d < 4; ++d) { const float v = o[d][r] * a0 + obuf[(wq * 64 + d * 16 + r) * 64 + lane] * a1; stg[orow * 128 + d * 32 + r32] = (bf16_t)(cvt_pk_bf16(v, 0.f) & 0xffffu); } }
        asm volatile("s_waitcnt lgkmcnt(0)" ::: "memory");
        bf16_t* Ow = WSP(bf16_t, WS_AO) + (rowb + iblk * MB + half * 128 + wq * 32) * AW + h * HD;
#pragma unroll
        for (int i = 0; i < 8; ++i) { const int row = i * 4 + (lane >> 4), ch = lane & 15; const u32x4 v = *(const u32x4*)(stg + row * 128 + ch * 8); *(u32x4*)(Ow + (size_t)row * AW + ch * 8) = v; }
    }
    __syncthreads();
}
#undef KSWZ
#undef SBAR
}

struct EpiConvOut {
    static constexpr bool PERM = true;
    const float* bias; const bf16_t* sg; bf16_t* m1;
    __device__ __forceinline__ void operator()(const f32x4 (&acc)[2][2][4][2], const Unit& u, int wr, int wc, int fr, int fq) const {
        const int row0 = u.pm * BM + wr * 64 + fr, col0 = u.pn * BM + wc * 32 + 8 * fq;
#pragma unroll
        for (int bj = 0; bj < 2; ++bj) { const int col = col0 + bj * HALF; const f32x4 b0 = *(const f32x4*)(bias + col), b1 = *(const f32x4*)(bias + col + 4);
#pragma unroll
            for (int ai = 0; ai < 2; ++ai)
#pragma unroll
                for (int m = 0; m < 4; ++m) { const int row = row0 + ai * HALF + m * 16; const u32x4 g = *(const u32x4*)(sg + (size_t)row * 4096 + col);
                    const f32x4 v0 = acc[ai][bj][m][0] + b0, v1 = acc[ai][bj][m][1] + b1; u32x4 w;
                    w.x = cvt_pk_bf16(v0[0] * bf_lo(g.x), v0[1] * bf_hi(g.x)); w.y = cvt_pk_bf16(v0[2] * bf_lo(g.y), v0[3] * bf_hi(g.y));
                    w.z = cvt_pk_bf16(v1[0] * bf_lo(g.z), v1[1] * bf_hi(g.z)); w.w = cvt_pk_bf16(v1[2] * bf_lo(g.w), v1[3] * bf_hi(g.w));
                    *(u32x4*)(m1 + (size_t)row * D + col) = w; } }
    }
};
struct EpiAttnOut {
    static constexpr bool PERM = true;
    const bf16_t* sg; const bf16_t* m1; bf16_t* merged;
    __device__ __forceinline__ void operator()(const f32x4 (&acc)[2][2][4][2], const Unit& u, int wr, int wc, int fr, int fq) const {
        const int row0 = u.pm * BM + wr * 64 + fr, col0 = u.pn * BM + wc * 32 + 8 * fq;
#pragma unroll
        for (int bj = 0; bj < 2; ++bj) { const int col = col0 + bj * HALF;
#pragma unroll
            for (int ai = 0; ai < 2; ++ai)
#pragma unroll
                for (int m = 0; m < 4; ++m) { const int row = row0 + ai * HALF + m * 16; const u32x4 g = *(const u32x4*)(sg + (size_t)row * 4096 + D + col); const u32x4 p = *(const u32x4*)(m1 + (size_t)row * D + col);
                    const f32x4 v0 = acc[ai][bj][m][0], v1 = acc[ai][bj][m][1]; u32x4 w;
                    w.x = cvt_pk_bf16(bf_lo(p.x) + v0[0] * bf_lo(g.x), bf_hi(p.x) + v0[1] * bf_hi(g.x)); w.y = cvt_pk_bf16(bf_lo(p.y) + v0[2] * bf_lo(g.y), bf_hi(p.y) + v0[3] * bf_hi(g.y));
                    w.z = cvt_pk_bf16(bf_lo(p.z) + v1[0] * bf_lo(g.z), bf_hi(p.z) + v1[1] * bf_hi(g.z)); w.w = cvt_pk_bf16(bf_lo(p.w) + v1[2] * bf_lo(g.w), bf_hi(p.w) + v1[3] * bf_hi(g.w));
                    *(u32x4*)(merged + (size_t)row * D + col) = w; } }
    }
};
struct EpiMix {
    static constexpr bool PERM = false;
    const float* x; const float* modf; float* vpre;
    __device__ __forceinline__ void operator()(const f32x4 (&acc)[2][2][4][2], const Unit& u, int wr, int wc, int fr, int fq) const {
        const int row0 = u.pm * BM + wr * 64 + fr, col0 = u.pn * BM + wc * 32 + 4 * fq; const int b = (u.pm * BM) / T;
#pragma unroll
        for (int bj = 0; bj < 2; ++bj)
#pragma unroll
            for (int n = 0; n < 2; ++n) { const int col = col0 + bj * HALF + n * 16; const f32x4 gt = *(const f32x4*)(modf + (size_t)b * 6 * D + 2 * D + col) + 1.f;
#pragma unroll
                for (int ai = 0; ai < 2; ++ai)
#pragma unroll
                    for (int m = 0; m < 4; ++m) { const size_t off = (size_t)(row0 + ai * HALF + m * 16) * D + col; const f32x4 xv = *(const f32x4*)(x + off);
                        *(f32x4*)(vpre + off) = xv * ALPHA + gt * acc[ai][bj][m][n]; } }
    }
};
struct EpiMoeUp {
    static constexpr bool PERM = true;
    const float* wl; bf16_t* hbuf;
    __device__ __forceinline__ void operator()(const f32x4 (&acc)[2][2][4][2], const Unit& u, int wr, int wc, int fr, int fq) const {
        const int rl0 = wr * 64 + fr, col = u.pn * 128 + wc * 32 + 8 * fq;
#pragma unroll
        for (int ai = 0; ai < 2; ++ai)
#pragma unroll
            for (int m = 0; m < 4; ++m) { const int rl = rl0 + ai * HALF + m * 16; if (rl < u.nrow) { const float wrow = wl[(size_t)u.e * NTOK + u.pm * 256 + rl];
                const f32x4 a0 = acc[ai][0][m][0], a1 = acc[ai][0][m][1], g0 = acc[ai][1][m][0], g1 = acc[ai][1][m][1]; u32x4 w;
                w.x = cvt_pk_bf16(silu(a0[0]) * g0[0] * wrow, silu(a0[1]) * g0[1] * wrow); w.y = cvt_pk_bf16(silu(a0[2]) * g0[2] * wrow, silu(a0[3]) * g0[3] * wrow);
                w.z = cvt_pk_bf16(silu(a1[0]) * g1[0] * wrow, silu(a1[1]) * g1[1] * wrow); w.w = cvt_pk_bf16(silu(a1[2]) * g1[2] * wrow, silu(a1[3]) * g1[3] * wrow);
                *(u32x4*)(hbuf + (size_t)(u.rbase + rl) * FF + col) = w; } }
    }
};
struct EpiMoeDown {
    static constexpr bool PERM = true;
    bf16_t* ypair;
    __device__ __forceinline__ void operator()(const f32x4 (&acc)[2][2][4][2], const Unit& u, int wr, int wc, int fr, int fq) const {
        const int rl0 = wr * 64 + fr, col0 = u.pn * BM + wc * 32 + 8 * fq;
#pragma unroll
        for (int ai = 0; ai < 2; ++ai)
#pragma unroll
            for (int m = 0; m < 4; ++m) { const int rl = rl0 + ai * HALF + m * 16; if (rl < u.nrow) {
#pragma unroll
                for (int bj = 0; bj < 2; ++bj) { const f32x4 v0 = acc[ai][bj][m][0], v1 = acc[ai][bj][m][1]; u32x4 w;
                    w.x = cvt_pk_bf16(v0[0], v0[1]); w.y = cvt_pk_bf16(v0[2], v0[3]); w.z = cvt_pk_bf16(v1[0], v1[1]); w.w = cvt_pk_bf16(v1[2], v1[3]);
                    *(u32x4*)(ypair + (size_t)(u.rbase + rl) * D + col0 + bj * HALF) = w; } } }
    }
};

__device__ __forceinline__ void moe_tables(Frame& F, int* ts, int* cn) {
    if (F.tid < 32) cn[F.tid] = (int)__hip_atomic_load(WSP(unsigned, WS_CTL) + CW_CNT + F.tid, __ATOMIC_RELAXED, __HIP_MEMORY_SCOPE_AGENT);
    __syncthreads();
    if (F.tid == 0) { int s = 0; for (int e = 0; e < 32; ++e) { ts[e] = s; s += (cn[e] + 255) >> 8; } ts[32] = s; }
    __syncthreads();
}
struct MoeSched {
    const char* A; const char* W; const int* tokl; const int* ts; const int* cn; int G, c, K, ntn, R[2], C[2]; bool gather; size_t wexp;
    __device__ void init(const void* A_, const void* W_, const int* tokl_, const int* ts_, const int* cn_, int G_, int c_, int K_, int ntn_, bool gather_, int tid) {
        A = (const char*)A_; W = (const char*)W_; tokl = tokl_; ts = ts_; cn = cn_; G = G_; c = c_; K = K_; ntn = ntn_; gather = gather_; wexp = (size_t)ntn * 256 * K * 2;
        for (int i = 0; i < 2; ++i) stage_rc(tid * 16 + i * 8192, R[i], C[i]);
    }
    __device__ bool next(int i, Unit& u) const {
        const int uidx = i * G + c; if (uidx >= ts[32] * ntn) return false;
        const int gmt = uidx / ntn, nt = uidx % ntn; int e = 0;
        for (int k = 1; k < 32; ++k) e += (ts[k] <= gmt) ? 1 : 0;
        const int mt = gmt - ts[e], cnt = cn[e];
        u.e = e; u.pm = mt; u.pn = nt; u.nrow = (cnt - 256 * mt < 256) ? cnt - 256 * mt : 256; u.rbase = 256 * gmt;
        u.Bb = W + (size_t)e * wexp + (size_t)nt * 256 * K * 2;
        if (gather) { u.Ab = A;
#pragma unroll
            for (int h = 0; h < 2; ++h)
#pragma unroll
                for (int p = 0; p < 2; ++p) { int r = 256 * mt + 128 * h + R[p]; r = (r < cnt) ? r : cnt - 1; const int tok = tokl[(size_t)e * NTOK + r]; u.ao[h * 2 + p] = (unsigned)(tok * K + C[p]) * 2u; }
        } else { u.Ab = A + (size_t)256 * gmt * K * 2; const unsigned hs = (unsigned)HALF * K * 2u;
            u.ao[0] = (unsigned)(R[0] * K + C[0]) * 2u; u.ao[1] = (unsigned)(R[1] * K + C[1]) * 2u; u.ao[2] = u.ao[0] + hs; u.ao[3] = u.ao[1] + hs; }
        return true;
    }
};

__device__ __forceinline__ float dot4(const f32x4 a, const f32x4 b) { return (a.x * b.x + a.y * b.y) + (a.z * b.z + a.w * b.w); }
__device__ __forceinline__ void p7_rows(Frame& F) {
    float* wg = (float*)F.lds;
    float* wch = (float*)(F.lds + 32768);
    int* cnt_l = (int*)(F.lds + LDS_MISC); int* base_l = cnt_l + 32; int* rowinfo = cnt_l + 64;
    float* roww = (float*)(cnt_l + 128);
    float* stat = (float*)(cnt_l + 192);
    const float* wrt = WSP(float, WS_WRT);
    const int r0 = F.vcu * 32, b = r0 / T;
    if (F.tid < 32) cnt_l[F.tid] = 0;
    for (int idx = F.tid; idx < 2048; idx += NTHR) *(f32x4*)(wg + idx * 4) = *(const f32x4*)(wrt + idx * 4);
    const float* modf = WSP(float, WS_MODF) + (size_t)b * 6 * D;
    const int rw0 = r0 + F.wave * 4;
#pragma unroll 1
    for (int i = 0; i < 4; ++i) {
        const int row = rw0 + i;
        const f32x4* vr = (const f32x4*)(WSP(float, WS_VPRE) + (size_t)row * D) + F.lane;
        f32x4 v[8]; float s = 0.f;
#pragma unroll
        for (int j = 0; j < 8; ++j) { v[j] = vr[64 * j]; s += (v[j].x + v[j].y) + (v[j].z + v[j].w); }
        float mean = wave_sum(s) * (1.f / D); float s2 = 0.f;
#pragma unroll
        for (int j = 0; j < 8; ++j) { v[j] = v[j] - mean; s2 += (v[j].x * v[j].x + v[j].y * v[j].y) + (v[j].z * v[j].z + v[j].w * v[j].w); }
        float rstd = rsqrtf(wave_sum(s2) * (1.f / D) + EPS);
        f32x4* x1r = (f32x4*)(WSP(float, WS_X1) + (size_t)row * D) + F.lane; s = 0.f;
#pragma unroll
        for (int j = 0; j < 8; ++j) { const int col = 4 * F.lane + 256 * j; v[j] = v[j] * rstd * *(const f32x4*)(F.g_ln1 + col) + *(const f32x4*)(F.b_ln1 + col); x1r[64 * j] = v[j]; s += (v[j].x + v[j].y) + (v[j].z + v[j].w); }
        mean = wave_sum(s) * (1.f / D); s2 = 0.f;
#pragma unroll
        for (int j = 0; j < 8; ++j) { const f32x4 d = v[j] - mean; s2 += (d.x * d.x + d.y * d.y) + (d.z * d.z + d.w * d.w); }
        rstd = rsqrtf(wave_sum(s2) * (1.f / D) + EPS);
        if (F.lane == 0) { stat[(F.wave * 4 + i) * 2] = mean; stat[(F.wave * 4 + i) * 2 + 1] = rstd; }
        u32x2* o8 = (u32x2*)(WSP(bf16_t, WS_U2) + (size_t)row * D) + F.lane;
#pragma unroll
        for (int j = 0; j < 8; ++j) { const int col = 4 * F.lane + 256 * j; const f32x4 y = (v[j] - mean) * rstd * (*(const f32x4*)(modf + 4 * D + col) + 1.f) + *(const f32x4*)(modf + 3 * D + col);
            u32x2 w; w.x = cvt_pk_bf16(y.x, y.y); w.y = cvt_pk_bf16(y.z, y.w); o8[64 * j] = w; }
    }
    __syncthreads();
    float mean2[4], rstd2[4];
#pragma unroll
    for (int i = 0; i < 4; ++i) { mean2[i] = stat[(F.wave * 4 + i) * 2]; rstd2[i] = stat[(F.wave * 4 + i) * 2 + 1]; }
    const float* x1w = WSP(float, WS_X1) + (size_t)rw0 * D + 4 * F.lane;
    float ag[4][4];
#pragma unroll
    for (int i = 0; i < 4; ++i)
#pragma unroll
        for (int o = 0; o < 4; ++o) ag[i][o] = 0.f;
#pragma unroll 1
    for (int j = 0; j < 8; ++j) { const int col = 4 * F.lane + 256 * j; const f32x4 sc = *(const f32x4*)(modf + 4 * D + col) + 1.f, sh = *(const f32x4*)(modf + 3 * D + col);
        f32x4 u[4];
#pragma unroll
        for (int i = 0; i < 4; ++i) u[i] = (*(const f32x4*)(x1w + (size_t)i * D + 256 * j) - mean2[i]) * rstd2[i] * sc + sh;
#pragma unroll
        for (int o = 0; o < 4; ++o) { const f32x4 w = *(const f32x4*)(wg + o * D + col);
#pragma unroll
            for (int i = 0; i < 4; ++i) ag[i][o] += dot4(u[i], w); } }
    int gtop[4]; float ptop[4];
#pragma unroll
    for (int i = 0; i < 4; ++i) { float lg[4];
#pragma unroll
        for (int o = 0; o < 4; ++o) lg[o] = wave_sum(ag[i][o]) + F.b_grp[o];
        int gt = 0; float mx = lg[0];
#pragma unroll
        for (int o = 1; o < 4; ++o) if (lg[o] > mx) { mx = lg[o]; gt = o; }
        float den = 0.f;
#pragma unroll
        for (int o = 0; o < 4; ++o) den += expf(lg[o] - mx);
        gtop[i] = __builtin_amdgcn_readfirstlane(gt); ptop[i] = 1.f / den; }
    float ae[4][8];
#pragma unroll
    for (int i = 0; i < 4; ++i)
#pragma unroll
        for (int e = 0; e < 8; ++e) ae[i][e] = 0.f;
#pragma unroll 1
    for (int j = 0; j < 8; ++j) {
        __syncthreads();
        for (int idx = F.tid; idx < 2048; idx += NTHR) { const int o = idx >> 6, c4 = idx & 63; *(f32x4*)(wch + o * 256 + c4 * 4) = *(const f32x4*)(wrt + (size_t)(4 + o) * D + 256 * j + c4 * 4); }
        __syncthreads();
        const int col = 4 * F.lane + 256 * j; const f32x4 sc = *(const f32x4*)(modf + 4 * D + col) + 1.f, sh = *(const f32x4*)(modf + 3 * D + col);
#pragma unroll
        for (int i = 0; i < 4; ++i) { const f32x4 u = (*(const f32x4*)(x1w + (size_t)i * D + 256 * j) - mean2[i]) * rstd2[i] * sc + sh;
#pragma unroll
            for (int e = 0; e < 8; ++e) { const f32x4 w = *(const f32x4*)(wch + (gtop[i] * 8 + e) * 256 + 4 * F.lane); ae[i][e] += dot4(u, w); } }
    }
#pragma unroll
    for (int i = 0; i < 4; ++i) { float le[8];
#pragma unroll
        for (int e = 0; e < 8; ++e) le[e] = wave_sum(ae[i][e]) + F.b_er[gtop[i] * 8 + e];
        int e0 = 0; float v0 = le[0];
#pragma unroll
        for (int e = 1; e < 8; ++e) if (le[e] > v0) { v0 = le[e]; e0 = e; }
        int e1 = -1; float v1 = -INFINITY;
#pragma unroll
        for (int e = 0; e < 8; ++e) if (e != e0 && le[e] > v1) { v1 = le[e]; e1 = e; }
        const float w0 = 1.f / (1.f + expf(v1 - v0));
        if (F.lane == 0) { const int rl = F.wave * 4 + i; const int E0 = gtop[i] * 8 + e0, E1 = gtop[i] * 8 + e1;
            const int s0 = atomicAdd(&cnt_l[E0], 1), s1 = atomicAdd(&cnt_l[E1], 1);
            rowinfo[rl * 2] = (E0 << 16) | s0; rowinfo[rl * 2 + 1] = (E1 << 16) | s1; roww[rl * 2] = w0 * ptop[i]; roww[rl * 2 + 1] = (1.f - w0) * ptop[i]; } }
    __syncthreads();
    if (F.tid < 32) { const int n = cnt_l[F.tid]; base_l[F.tid] = n ? (int)__hip_atomic_fetch_add(WSP(unsigned, WS_CTL) + CW_CNT + F.tid, (unsigned)n, __ATOMIC_RELAXED, __HIP_MEMORY_SCOPE_AGENT) : 0; }
    __syncthreads();
    if (F.tid < 64) { const int rl = F.tid >> 1, jj = F.tid & 1; const int info = rowinfo[rl * 2 + jj]; const int E = info >> 16, slot = base_l[E] + (info & 0xffff); const int tok = r0 + rl;
        WSP(int, WS_TOKL)[(size_t)E * NTOK + slot] = tok; WSP(float, WS_WL)[(size_t)E * NTOK + slot] = roww[rl * 2 + jj]; WSP(int, WS_PAIR)[tok * 2 + jj] = (E << 16) | slot; }
    __syncthreads();
}

__device__ __forceinline__ void p10_rows(Frame& F, const int* ts) {
    const int r0 = F.vcu * 32, b = r0 / T; const float* modf = WSP(float, WS_MODF) + (size_t)b * 6 * D;
#pragma unroll 1
    for (int i = 0; i < 4; ++i) {
        const int row = r0 + F.wave * 4 + i;
        const int i0 = WSP(int, WS_PAIR)[row * 2], i1 = WSP(int, WS_PAIR)[row * 2 + 1];
        const size_t ra = (size_t)ts[i0 >> 16] * 256 + (i0 & 0xffff), rb = (size_t)ts[i1 >> 16] * 256 + (i1 & 0xffff);
        const f32x4* xr = (const f32x4*)(WSP(float, WS_X1) + (size_t)row * D) + F.lane;
        const u32x2* ya = (const u32x2*)(WSP(bf16_t, WS_YPAIR) + ra * D) + F.lane; const u32x2* yb = (const u32x2*)(WSP(bf16_t, WS_YPAIR) + rb * D) + F.lane;
        f32x4 v[8]; float s = 0.f;
#pragma unroll
        for (int j = 0; j < 8; ++j) { const int col = 4 * F.lane + 256 * j; const u32x2 a = ya[64 * j], c = yb[64 * j];
            const f32x4 f = (f32x4){bf_lo(a.x) + bf_lo(c.x), bf_hi(a.x) + bf_hi(c.x), bf_lo(a.y) + bf_lo(c.y), bf_hi(a.y) + bf_hi(c.y)};
            v[j] = xr[64 * j] * ALPHA + (*(const f32x4*)(modf + 5 * D + col) + 1.f) * f; s += (v[j].x + v[j].y) + (v[j].z + v[j].w); }
        const float mean = wave_sum(s) * (1.f / D); float s2 = 0.f;
#pragma unroll
        for (int j = 0; j < 8; ++j) { v[j] = v[j] - mean; s2 += (v[j].x * v[j].x + v[j].y * v[j].y) + (v[j].z * v[j].z + v[j].w * v[j].w); }
        const float rstd = rsqrtf(wave_sum(s2) * (1.f / D) + EPS);
        f32x4* orow = (f32x4*)(F.out + (size_t)row * D) + F.lane;
#pragma unroll
        for (int j = 0; j < 8; ++j) { const int col = 4 * F.lane + 256 * j; orow[64 * j] = v[j] * rstd * *(const f32x4*)(F.g_ln2 + col) + *(const f32x4*)(F.b_ln2 + col); }
    }
}
struct Args { const void* in[26]; float* out; unsigned char* ws; int ph_lo, ph_hi; };
constexpr int NPHASE = 11;
__global__ void __launch_bounds__(NTHR, 2) mk_fwd(Args a) {
    extern __shared__ __attribute__((aligned(16))) unsigned char lds[];
    Frame F;
    F.lds = lds; F.tid = threadIdx.x; F.lane = F.tid & 63; F.wave = __builtin_amdgcn_readfirstlane(F.tid >> 6);
    F.G = gridDim.x; { const int bx = blockIdx.x; F.vcu = (F.G % 8 == 0) ? (bx % 8) * (F.G / 8) + bx / 8 : bx; }
    F.x = (const float*)a.in[0]; F.c = (const float*)a.in[1]; F.pos = (const int*)a.in[2]; F.w_cond = (const float*)a.in[3]; F.b_cond = (const float*)a.in[4];
    F.w_in = (const float*)a.in[5]; F.b_glu = (const float*)a.in[6]; F.w_dw = (const float*)a.in[7]; F.b_dw = (const float*)a.in[8]; F.g_cn = (const float*)a.in[9];
    F.b_cn = (const float*)a.in[10]; F.w_conv_out = (const float*)a.in[11]; F.b_conv_out = (const float*)a.in[12]; F.w_attn_out = (const float*)a.in[13];
    F.w_mix_out = (const float*)a.in[14]; F.g_ln1 = (const float*)a.in[15]; F.b_ln1 = (const float*)a.in[16]; F.w_grp = (const float*)a.in[17]; F.b_grp = (const float*)a.in[18];
    F.w_er = (const float*)a.in[19]; F.b_er = (const float*)a.in[20]; F.w1 = (const float*)a.in[21]; F.w3 = (const float*)a.in[22]; F.w2 = (const float*)a.in[23];
    F.g_ln2 = (const float*)a.in[24]; F.b_ln2 = (const float*)a.in[25]; F.out = a.out; F.ws = a.ws;
    const int lo = a.ph_lo, hi = a.ph_hi;
    LAS unsigned char* ring = (LAS unsigned char*)lds;
    int* ts = (int*)(lds + LDS_MISC + 12288); int* cn = ts + 40;
#ifndef ONLY_PHASE
#define ONLY_PHASE -1
#endif
#define IN(k) ((ONLY_PHASE == -1 || ONLY_PHASE == (k)) && lo <= (k) && (k) < hi)
#define SEAM(k) do { if (IN(k) && IN((k) + 1)) cooperative_groups::this_grid().sync(); } while (0)
    if (IN(0)) { p0_prologue(F); } SEAM(0);
    if (IN(1)) { p1_ln(F); } SEAM(1);
    if (IN(2)) { DenseSched S; S.init(WSP(bf16_t, WS_U), WSP(bf16_t, WS_WIN), NTOK, INC, D, F.G, (int)blockIdx.x, F.tid);
        EpiIn E{F.b_glu, WSP(float, WS_ROPE), WSP(bf16_t, WS_HGLU), WSP(bf16_t, WS_Q), WSP(bf16_t, WS_K), WSP(bf16_t, WS_V), WSP(bf16_t, WS_SG)};
        gemm_phase<EpiIn, DenseSched, true, true>(ring, D, S, E); } SEAM(2);
    if (IN(3)) { p3_conv_unit(F, F.vcu); p3_kmean_unit(F, F.vcu); } SEAM(3);
    if (IN(4)) {
        { const int p = F.vcu, bh = p >> 4, s = (p >> 1) & 7, half = p & 1;
#pragma unroll 1
            for (int uu = 0; uu < 2; ++uu) att::attn_unit(F, ring, bh >> 3, bh & 7, uu ? s : 15 - s, half); }
        int tidg = F.tid; asm volatile("" : "+v"(tidg));
        DenseSched S; S.init(WSP(bf16_t, WS_HC), WSP(bf16_t, WS_WCO), NTOK, D, CC, F.G, (int)blockIdx.x, tidg);
        EpiConvOut E{F.b_conv_out, WSP(bf16_t, WS_SG), WSP(bf16_t, WS_M1)};
        gemm_phase<EpiConvOut, DenseSched, true, true>(ring, CC, S, E); } SEAM(4);
    if (IN(5)) { DenseSched S; S.init(WSP(bf16_t, WS_AO), WSP(bf16_t, WS_WAO), NTOK, D, AW, F.G, (int)blockIdx.x, F.tid);
        EpiAttnOut E{WSP(bf16_t, WS_SG), WSP(bf16_t, WS_M1), WSP(bf16_t, WS_MERGED)};
        gemm_phase<EpiAttnOut, DenseSched, true, true>(ring, AW, S, E); } SEAM(5);
    if (IN(6)) { DenseSched S; S.init(WSP(bf16_t, WS_MERGED), WSP(bf16_t, WS_WMIX), NTOK, D, D, F.G, (int)blockIdx.x, F.tid);
        EpiMix E{F.x, WSP(float, WS_MODF), WSP(float, WS_VPRE)};
        gemm_phase<EpiMix, DenseSched, true, true>(ring, D, S, E); } SEAM(6);
    if (IN(7)) { p7_rows(F); } SEAM(7);
    if (IN(8)) { moe_tables(F, ts, cn); MoeSched S; S.init(WSP(bf16_t, WS_U2), WSP(bf16_t, WS_W13), WSP(int, WS_TOKL), ts, cn, F.G, F.vcu, D, 4, true, F.tid);
        EpiMoeUp E{WSP(float, WS_WL), WSP(bf16_t, WS_HBUF)};
        gemm_phase<EpiMoeUp, MoeSched, true, true>(ring, D, S, E); } SEAM(8);
    if (IN(9)) { moe_tables(F, ts, cn); MoeSched S; S.init(WSP(bf16_t, WS_HBUF), WSP(bf16_t, WS_W2), WSP(int, WS_TOKL), ts, cn, F.G, F.vcu, FF, 8, false, F.tid);
        EpiMoeDown E{WSP(bf16_t, WS_YPAIR)};
        gemm_phase<EpiMoeDown, MoeSched, true, true>(ring, FF, S, E); } SEAM(9);
    if (IN(10)) { moe_tables(F, ts, cn); p10_rows(F, ts); }
#undef IN
#undef SEAM
}
}

static int mk_launch(void* const* d_in, float* out, void* d_ws, size_t ws_size, hipStream_t stream, int ph_lo, int ph_hi, bool memset_ctl) {
    static int ready = 0;
    if (ready == 0) {
        int dev = 0, cus = 0, per_cu = 0;
        if (hipGetDevice(&dev) != hipSuccess || hipDeviceGetAttribute(&cus, hipDeviceAttributeMultiprocessorCount, dev) != hipSuccess) { fprintf(stderr, "mk: device query failed\n"); ready = -1; return -1; }
        if (hipFuncSetAttribute((const void*)mk::mk_fwd, hipFuncAttributeMaxDynamicSharedMemorySize, mk::LDS_BYTES) != hipSuccess) { fprintf(stderr, "mk: hipFuncSetAttribute failed\n"); ready = -1; return -1; }
        if (hipOccupancyMaxActiveBlocksPerMultiprocessor(&per_cu, (const void*)mk::mk_fwd, mk::NTHR, mk::LDS_BYTES) != hipSuccess || per_cu < 1) { fprintf(stderr, "mk: occupancy query says %d blocks/CU\n", per_cu); ready = -1; return -1; }
        if (cus != 256 || ws_size < mk::WS_END) { fprintf(stderr, "mk: need 256 CUs (got %d) and ws >= %zu (got %zu)\n", cus, (size_t)mk::WS_END, ws_size); ready = -1; return -1; }
        (void)hipGetLastError();
        ready = 1;
    }
    if (ready < 0) return -1;
    if (memset_ctl) (void)hipMemsetAsync((char*)d_ws + mk::WS_CTL, 0, mk::CTL_ZERO_BYTES, stream);
    mk::Args a{};
    for (int i = 0; i < 26; ++i) a.in[i] = d_in[i];
    a.out = out; a.ws = (unsigned char*)d_ws; a.ph_lo = ph_lo; a.ph_hi = ph_hi;
    void* args[] = {&a};
    hipError_t e = hipLaunchCooperativeKernel((const void*)mk::mk_fwd, dim3(256), dim3(mk::NTHR), args, mk::LDS_BYTES, stream);
    if (e != hipSuccess) { fprintf(stderr, "mk: cooperative launch failed: %s\n", hipGetErrorString(e)); return -1; }
    return 0;
}
extern "C" void kernel_launch(void* const* d_in, const int* in_sizes, int n_in, void* d_out, int out_size, void* d_ws, size_t ws_size, hipStream_t stream) {
#if MK_PER_PHASE
    for (int p = 0; p < mk::NPHASE; ++p) mk_launch(d_in, (float*)d_out, d_ws, ws_size, stream, p, p + 1, p == 0);
#else
    mk_launch(d_in, (float*)d_out, d_ws, ws_size, stream, 0, mk::NPHASE, true);
#endif
}
```

```cpp
#include <hip/hip_runtime.h>
#include <hip/hip_cooperative_groups.h>
#include <cstdio>
#include <cstdint>
#define MK_PER_PHASE 0
namespace mk {
#define LAS __attribute__((address_space(3)))
#define GAS __attribute__((address_space(1)))
typedef unsigned short bf16_t;
typedef short bf16x8 __attribute__((ext_vector_type(8)));
typedef short s16x4 __attribute__((ext_vector_type(4)));
typedef float f32x4 __attribute__((ext_vector_type(4)));
typedef float f32x2 __attribute__((ext_vector_type(2)));
typedef float f32x16 __attribute__((ext_vector_type(16)));
typedef unsigned u32x4 __attribute__((ext_vector_type(4)));
typedef unsigned u32x2 __attribute__((ext_vector_type(2)));

constexpr int D = 2048, NB = 2, T = 4096, NTOK = NB * T, CC = 1024, CW = 31, NH = 8, HD = 128, AW = 1024;
constexpr int INC = 9216, NEXP = 32, FF = 512, MB = 256, NBLK = T / MB;
constexpr float EPS = 1e-5f, ALPHA = 1.189207115002721f;
constexpr int NWAVES = 8, NTHR = 512;

__device__ __forceinline__ unsigned cvt_pk_bf16(float lo, float hi) { unsigned r; asm volatile("v_cvt_pk_bf16_f32 %0, %1, %2" : "=v"(r) : "v"(lo), "v"(hi)); return r; }
__device__ __forceinline__ float bf_lo(unsigned w) { return __uint_as_float(w << 16); }
__device__ __forceinline__ float bf_hi(unsigned w) { return __uint_as_float(w & 0xffff0000u); }
__device__ __forceinline__ float sigm(float v) { return 1.f / (1.f + __expf(-v)); }
__device__ __forceinline__ float silu(float v) { return v / (1.f + __expf(-v)); }
__device__ __forceinline__ float wave_sum(float v) {
#pragma unroll
    for (int o = 1; o < 64; o <<= 1) v += __shfl_xor(v, o);
    return v;
}

constexpr int BM = 256, BK = 64, HALF = 128, HTB = HALF * BK * 2, STAGE_BYTES = 8 * HTB, NXCD = 8, WGM = 8;
__host__ __device__ __forceinline__ int lds_byte(int r, int c) { const int st = (r >> 4) * 2 + (c >> 5), rr = r & 15, cc = c & 31, ob = rr * 64 + cc * 2; return st * 1024 + (ob ^ (((ob >> 9) & 1) << 5)); }
__host__ __device__ __forceinline__ void stage_rc(int b, int& R, int& C) { const int st = b / 1024, sb = b % 1024, swz = sb ^ (((sb >> 9) & 1) << 5); R = (st >> 1) * 16 + swz / 64; C = (st & 1) * 32 + (swz % 64) / 2; }
__host__ __device__ __forceinline__ int perm32(int rho) { const int n = rho >> 4, i = rho & 15; return 8 * (i >> 2) + 4 * n + (i & 3); }

struct Unit { const char* Ab; const char* Bb; unsigned ao[4]; int pm, pn, e, nrow, rbase; };

struct TileOrder {
    int nM, nN, nwg, G, c;
    __device__ void init(int nM_, int nN_, int G_, int c_) { nM = nM_; nN = nN_; nwg = nM * nN; G = G_; c = c_; }
    __device__ bool get(int i, int& pm, int& pn) const {
        const long L = (long)i * G + c; if (L >= nwg) return false;
        int wgid = (int)L; { const int q = nwg / NXCD, r = nwg % NXCD, xcd = wgid % NXCD, off = wgid / NXCD; wgid = (xcd < r ? xcd * (q + 1) : r * (q + 1) + (xcd - r) * q) + off; }
        const int nig = WGM * nN, gid = wgid / nig, fm = gid * WGM, gsz = (nM - fm) < WGM ? (nM - fm) : WGM;
        pm = fm + ((wgid % nig) % gsz); pn = (wgid % nig) / gsz; return true;
    }
};
struct DenseSched {
    const char* A; const char* Bt; int K; TileOrder to; unsigned vo[2];
    __device__ void init(const bf16_t* A_, const bf16_t* Bt_, int M, int N, int K_, int G, int c, int tid) {
        A = (const char*)A_; Bt = (const char*)Bt_; K = K_; to.init(M / BM, N / BM, G, c);
        for (int i = 0; i < 2; ++i) { int R, C; stage_rc(tid * 16 + i * 8192, R, C); vo[i] = (unsigned)(R * K + C) * 2u; }
    }
    __device__ bool next(int i, Unit& u) const {
        int pm, pn; if (!to.get(i, pm, pn)) return false;
        u.pm = pm; u.pn = pn; u.e = 0; u.nrow = 256; u.rbase = pm * 256;
        u.Ab = A + (size_t)pm * 256 * K * 2; u.Bb = Bt + (size_t)pn * 256 * K * 2;
        const unsigned hs = (unsigned)HALF * K * 2u; u.ao[0] = vo[0]; u.ao[1] = vo[1]; u.ao[2] = vo[0] + hs; u.ao[3] = vo[1] + hs; return true;
    }
};

template <class Epi, class Sched, bool ALIGN_EPI, bool SP2>
__device__ __forceinline__ void gemm_phase(LAS unsigned char* lds, const int K, const Sched& S, const Epi& E) {
    int tid_ = threadIdx.x; asm volatile("" : "+v"(tid_));
    const int tid = tid_, wid = __builtin_amdgcn_readfirstlane(tid >> 6), lane = tid & 63, wr = wid >> 2, wc = wid & 3, fr = lane & 15, fq = lane >> 4;
    const int nt = K / BK;
    unsigned voffB[2];
#pragma unroll
    for (int i = 0; i < 2; ++i) { int R, C; stage_rc(tid * 16 + i * 8192, R, C); const int Rb = Epi::PERM ? ((R & ~31) + perm32(R & 31)) : R; voffB[i] = (unsigned)(Rb * K + C) * 2u; }
    const size_t kstep = (size_t)(BK * 2);
    const size_t hstep = (size_t)HALF * K * 2;
    const unsigned ldsw = (unsigned)wid * 1024u;
    const int aoff = lds_byte(wr * 64 + fr, fq * 8), boff = lds_byte(wc * 32 + fr, fq * 8);
#define PG8_SA(b, h) (((b) * 2 + (h)) * HTB)
#define PG8_SB(b, h) ((4 + (b) * 2 + (h)) * HTB)
#define PG8_STAGE(bufoff, gbase, voff) do { _Pragma("unroll") for (int _i = 0; _i < 2; ++_i) \
        __builtin_amdgcn_global_load_lds((const unsigned*)((const char*)(gbase) + (voff)[_i]), (LAS unsigned*)(lds + (bufoff) + ldsw + _i * 8192), 16, 0, 0); } while (0)
#define PG8_STAGEA(bufoff, gbase, o0, o1) do { \
        __builtin_amdgcn_global_load_lds((const unsigned*)((const char*)(gbase) + (o0)), (LAS unsigned*)(lds + (bufoff) + ldsw), 16, 0, 0); \
        __builtin_amdgcn_global_load_lds((const unsigned*)((const char*)(gbase) + (o1)), (LAS unsigned*)(lds + (bufoff) + ldsw + 8192), 16, 0, 0); } while (0)
#define PG8_LDA(dst, b, h) do { _Pragma("unroll") for (int m = 0; m < 4; ++m) _Pragma("unroll") for (int k = 0; k < 2; ++k) dst[m][k] = *(const LAS bf16x8*)(lds + PG8_SA(b, h) + aoff + m * 2048 + k * 1024); } while (0)
#define PG8_LDB(dst, b, h) do { _Pragma("unroll") for (int n = 0; n < 2; ++n) _Pragma("unroll") for (int k = 0; k < 2; ++k) dst[n][k] = *(const LAS bf16x8*)(lds + PG8_SB(b, h) + boff + n * 2048 + k * 1024); } while (0)
#define PG8_MMA(ai, bj, At, Bt) do { __builtin_amdgcn_s_setprio(1); _Pragma("unroll") for (int m = 0; m < 4; ++m) _Pragma("unroll") for (int n = 0; n < 2; ++n) _Pragma("unroll") for (int k = 0; k < 2; ++k) \
        acc[ai][bj][m][n] = __builtin_amdgcn_mfma_f32_16x16x32_bf16(Bt[n][k], At[m][k], acc[ai][bj][m][n], 0, 0, 0); __builtin_amdgcn_s_setprio(0); } while (0)
#define PG8_WAIT_V(n) asm volatile("s_waitcnt vmcnt(" #n ")" ::: "memory")
#define PG8_WAIT_L(n) asm volatile("s_waitcnt lgkmcnt(" #n ")" ::: "memory")
#define PG8_BAR __builtin_amdgcn_s_barrier()
#define PG8_SCHED __builtin_amdgcn_sched_barrier(0)
    Unit cur, nxt; int ui = 0;
    if (!S.next(0, cur)) return;
    f32x4 acc[2][2][4][2];
#pragma unroll
    for (int a = 0; a < 2; ++a)
#pragma unroll
        for (int b = 0; b < 2; ++b)
#pragma unroll
            for (int m = 0; m < 4; ++m)
#pragma unroll
                for (int n = 0; n < 2; ++n) acc[a][b][m][n] = (f32x4){0.f, 0.f, 0.f, 0.f};
    bf16x8 At[4][2], B0[2][2], B1[2][2];
    const char* cA = cur.Ab; const char* cB = cur.Bb;
    if constexpr (SP2) {
        PG8_STAGE(PG8_SB(0, 0), cB, voffB); PG8_STAGE(PG8_SB(0, 1), cB + hstep, voffB); PG8_STAGEA(PG8_SA(0, 0), cA, cur.ao[0], cur.ao[1]); PG8_STAGEA(PG8_SA(0, 1), cA, cur.ao[2], cur.ao[3]);
        if (wr == 1) PG8_BAR;
        PG8_WAIT_V(2); PG8_BAR;
        PG8_STAGE(PG8_SB(1, 0), cB + kstep, voffB); PG8_STAGEA(PG8_SA(1, 0), cA + kstep, cur.ao[0], cur.ao[1]); PG8_STAGE(PG8_SB(1, 1), cB + hstep + kstep, voffB);
        PG8_WAIT_V(6); PG8_BAR;
    } else {
        PG8_STAGE(PG8_SB(0, 0), cB, voffB); PG8_STAGEA(PG8_SA(0, 0), cA, cur.ao[0], cur.ao[1]); PG8_STAGE(PG8_SB(0, 1), cB + hstep, voffB); PG8_STAGEA(PG8_SA(0, 1), cA, cur.ao[2], cur.ao[3]);
        if (wr == 1) PG8_BAR;
        PG8_WAIT_V(4); PG8_BAR;
        PG8_STAGE(PG8_SB(1, 0), cB + kstep, voffB); PG8_STAGEA(PG8_SA(1, 0), cA + kstep, cur.ao[0], cur.ao[1]); PG8_STAGE(PG8_SB(1, 1), cB + hstep + kstep, voffB);
        PG8_WAIT_V(6); PG8_BAR;
    }
    for (;;) {
        const bool has_next = S.next(ui + 1, nxt);
        if (!has_next) nxt = cur;
        const char* nA = nxt.Ab; const char* nB = nxt.Bb;
        for (int t = 0; t < nt; t += 2) {
            const bool last = (t == nt - 2);
            const char* a1 = cA + (size_t)(t + 1) * kstep;
            const char* a2 = last ? nA : cA + (size_t)(t + 2) * kstep; const char* b2 = last ? nB : cB + (size_t)(t + 2) * kstep;
            const char* a3 = a2 + kstep; const char* b3 = b2 + kstep;
            const unsigned o0 = last ? nxt.ao[0] : cur.ao[0], o1 = last ? nxt.ao[1] : cur.ao[1], o2 = last ? nxt.ao[2] : cur.ao[2], o3 = last ? nxt.ao[3] : cur.ao[3];
            if constexpr (SP2) {
            PG8_LDB(B0, 0, 0); PG8_LDB(B1, 0, 1); PG8_SCHED; PG8_LDA(At, 0, 0); PG8_STAGEA(PG8_SA(1, 1), a1, cur.ao[2], cur.ao[3]);
            PG8_WAIT_V(8); PG8_WAIT_L(0); PG8_BAR; PG8_MMA(0, 0, At, B0); PG8_MMA(0, 1, At, B1); PG8_BAR; PG8_SCHED;
            PG8_LDA(At, 0, 1); PG8_STAGE(PG8_SB(0, 0), b2, voffB); PG8_STAGE(PG8_SB(0, 1), b2 + hstep, voffB); PG8_STAGEA(PG8_SA(0, 0), a2, o0, o1);
            PG8_WAIT_V(8); PG8_WAIT_L(0); PG8_BAR; PG8_MMA(1, 0, At, B0); PG8_MMA(1, 1, At, B1); PG8_BAR; PG8_SCHED;
            PG8_LDB(B0, 1, 0); PG8_LDB(B1, 1, 1); PG8_SCHED; PG8_LDA(At, 1, 0); PG8_STAGEA(PG8_SA(0, 1), a2, o2, o3);
            PG8_WAIT_V(8); PG8_WAIT_L(0); PG8_BAR; PG8_MMA(0, 0, At, B0); PG8_MMA(0, 1, At, B1); PG8_BAR; PG8_SCHED;
            PG8_LDA(At, 1, 1); PG8_STAGE(PG8_SB(1, 0), b3, voffB); PG8_STAGE(PG8_SB(1, 1), b3 + hstep, voffB); PG8_STAGEA(PG8_SA(1, 0), a3, o0, o1);
            PG8_WAIT_V(8); PG8_WAIT_L(0); PG8_BAR; PG8_MMA(1, 0, At, B0); PG8_MMA(1, 1, At, B1); PG8_BAR; PG8_SCHED;
            } else {
            PG8_LDB(B0, 0, 0); PG8_SCHED; PG8_LDA(At, 0, 0); PG8_STAGEA(PG8_SA(1, 1), a1, cur.ao[2], cur.ao[3]);
            PG8_WAIT_L(8); PG8_BAR; PG8_WAIT_L(0); PG8_MMA(0, 0, At, B0); PG8_BAR; PG8_SCHED;
            PG8_LDB(B1, 0, 1); PG8_STAGE(PG8_SB(0, 0), b2, voffB);
            PG8_BAR; PG8_WAIT_L(0); PG8_MMA(0, 1, At, B1); PG8_BAR;
            PG8_LDA(At, 0, 1); PG8_STAGEA(PG8_SA(0, 0), a2, o0, o1);
            PG8_BAR; PG8_WAIT_L(0); PG8_MMA(1, 0, At, B0); PG8_BAR; PG8_SCHED;
            PG8_STAGE(PG8_SB(0, 1), b2 + hstep, voffB);
            PG8_WAIT_V(6); PG8_BAR; PG8_MMA(1, 1, At, B1); PG8_BAR;
            PG8_LDB(B0, 1, 0); PG8_SCHED; PG8_LDA(At, 1, 0); PG8_STAGEA(PG8_SA(0, 1), a2, o2, o3);
            PG8_WAIT_L(8); PG8_BAR; PG8_WAIT_L(0); PG8_MMA(0, 0, At, B0); PG8_BAR; PG8_SCHED;
            PG8_LDB(B1, 1, 1); PG8_STAGE(PG8_SB(1, 0), b3, voffB);
            PG8_BAR; PG8_WAIT_L(0); PG8_MMA(0, 1, At, B1); PG8_BAR;
            PG8_LDA(At, 1, 1); PG8_STAGEA(PG8_SA(1, 0), a3, o0, o1);
            PG8_BAR; PG8_WAIT_L(0); PG8_MMA(1, 0, At, B0); PG8_BAR; PG8_SCHED;
            PG8_STAGE(PG8_SB(1, 1), b3 + hstep, voffB);
            PG8_WAIT_V(6); PG8_BAR; PG8_MMA(1, 1, At, B1); PG8_BAR;
            }
        }
        if constexpr (ALIGN_EPI) { if (wr == 0) PG8_BAR; }
        E(acc, cur, wr, wc, fr, fq);
        if (!has_next) break;
#pragma unroll
        for (int a = 0; a < 2; ++a)
#pragma unroll
            for (int b = 0; b < 2; ++b)
#pragma unroll
                for (int m = 0; m < 4; ++m)
#pragma unroll
                    for (int n = 0; n < 2; ++n) acc[a][b][m][n] = (f32x4){0.f, 0.f, 0.f, 0.f};
        cur = nxt; cA = nA; cB = nB; ++ui;
        if constexpr (ALIGN_EPI) { if (wr == 1) PG8_BAR; }
    }
    PG8_WAIT_V(0);
    if constexpr (!ALIGN_EPI) { if (wr == 0) PG8_BAR; }
    PG8_BAR;
#undef PG8_SA
#undef PG8_SB
#undef PG8_STAGE
#undef PG8_STAGEA
#undef PG8_LDA
#undef PG8_LDB
#undef PG8_MMA
#undef PG8_WAIT_V
#undef PG8_WAIT_L
#undef PG8_BAR
#undef PG8_SCHED
}
constexpr size_t MiB = 1u << 20;
constexpr size_t WS_CTL = 0, CTL_ZERO_BYTES = 1 * MiB;
constexpr size_t WS_MODPART = 1 * MiB, WS_MODF = 3 * MiB, WS_ROPE = 4 * MiB, WS_WRT = 5 * MiB, WS_KMEAN = 6 * MiB, WS_TOKL = 7 * MiB, WS_WL = 8 * MiB, WS_PAIR = 9 * MiB;
constexpr size_t WS_WIN = 16 * MiB, WS_WCO = 52 * MiB, WS_WAO = 56 * MiB, WS_WMIX = 60 * MiB, WS_W13 = 68 * MiB, WS_W2 = 196 * MiB;
constexpr size_t WS_R1 = 260 * MiB, WS_U = WS_R1, WS_HGLU = WS_R1 + 32 * MiB, WS_Q = WS_R1 + 48 * MiB, WS_K = WS_R1 + 64 * MiB, WS_V = WS_R1 + 80 * MiB, WS_YPAIR = WS_R1;
constexpr size_t WS_R2 = 356 * MiB, WS_SG = WS_R2, WS_VPRE = WS_R2, WS_HBUF = WS_R2;
constexpr size_t WS_R3 = 420 * MiB, WS_M1 = WS_R3, WS_MERGED = WS_R3 + 32 * MiB, WS_X1 = WS_R3;
constexpr size_t WS_R4 = 484 * MiB, WS_HC = WS_R4, WS_AO = WS_R4 + 16 * MiB, WS_U2 = WS_R4;
constexpr size_t WS_END = 516 * MiB;
constexpr int CW_CNT = 64;
constexpr int MODKC = 16;
constexpr int HB_ROWS = 24576;

constexpr int RING_BYTES = 131072, LDS_MISC = RING_BYTES, LDS_BYTES = 147456;


#define XB_TMO      128
#define XB_XCNT(j)  (256  + 64 * (j))
#define XB_XSUB(j)  (1280 + 64 * (j))
#define XB_XGEN(j)  (2304 + 64 * (j))
#define XB_TOP      3328
#define XB_TOPGEN   3392
#define XCD_BAR_WORDS 3456
#define XB_SPIN_CAP (1u << 18)
constexpr int CW_BAR = 4096;
__device__ __forceinline__ unsigned xb_ld(unsigned* p)              { return __hip_atomic_load(p, __ATOMIC_RELAXED, __HIP_MEMORY_SCOPE_AGENT); }
__device__ __forceinline__ unsigned xb_add(unsigned* p, unsigned v) { return __hip_atomic_fetch_add(p, v, __ATOMIC_RELAXED, __HIP_MEMORY_SCOPE_AGENT); }
__device__ __forceinline__ unsigned xb_xcc_id() { return (unsigned)__builtin_amdgcn_s_getreg((3 << 11) | 20) & 0xFu; }
#define XB_SPIN(cond, bar) do { unsigned _sp = 0; while (cond) { __builtin_amdgcn_s_sleep(1); \
    if ((++_sp & 255u) == 0u) { if (xb_ld(&(bar)[XB_TMO])) break; if (_sp > XB_SPIN_CAP) { atomicAdd(&(bar)[XB_TMO], 1u); break; } } } } while (0)
struct XcdBarrier { unsigned* bar; unsigned x; volatile unsigned* st; };
__device__ __forceinline__ XcdBarrier xcd_barrier_post(unsigned* bar, volatile unsigned* st) {
    XcdBarrier b; b.bar = bar; b.x = xb_xcc_id(); b.st = st;
    if (threadIdx.x == 0) (void)xb_add(&bar[XB_XCNT(b.x)], 1u);
    return b;
}
__device__ __forceinline__ void xcd_barrier_complete(unsigned* bar, unsigned x, unsigned& nloc, unsigned& nx) {
    const unsigned G = gridDim.x * gridDim.y * gridDim.z;
    unsigned sum, cnt, mine, sp = 0u;
    for (;;) {
        sum = 0u; cnt = 0u; mine = 0u;
#pragma unroll
        for (unsigned j = 0; j < 16; ++j) { const unsigned c = xb_ld(&bar[XB_XCNT(j)]); sum += c; cnt += (c > 0u) ? 1u : 0u; mine = (j == x) ? c : mine; }
        if (sum == G) break;
        __builtin_amdgcn_s_sleep(1);
        if ((++sp & 255u) == 0u) { if (xb_ld(&bar[XB_TMO])) break; if (sp > XB_SPIN_CAP) { atomicAdd(&bar[XB_TMO], 1u); break; } }
    }
    nloc = mine > 0u ? mine : 1u; nx = cnt > 0u ? cnt : 1u;
}
__device__ __forceinline__ void xcd_barrier(const XcdBarrier& b) {
    asm volatile("s_waitcnt vmcnt(0)" ::: "memory");
    __syncthreads();
    if (threadIdx.x == 0) {
        unsigned* bar = b.bar;
        __builtin_amdgcn_s_waitcnt(0);
        unsigned nloc = b.st[0], nx = b.st[1];
        if (nloc == 0u) { xcd_barrier_complete(bar, b.x, nloc, nx); b.st[0] = nloc; b.st[1] = nx; }
        const unsigned old = xb_add(&bar[XB_XSUB(b.x)], 1u);
        const unsigned gen = old / nloc;
        if (old + 1u == (gen + 1u) * nloc) {
            __builtin_amdgcn_fence(__ATOMIC_RELEASE, "agent");
            asm volatile("s_waitcnt vmcnt(0)" ::: "memory");
            const unsigned og = xb_add(&bar[XB_TOP], 1u);
            const unsigned tg = og / nx;
            if (og + 1u == (tg + 1u) * nx) xb_add(&bar[XB_TOPGEN], 1u);
            else XB_SPIN(xb_ld(&bar[XB_TOPGEN]) == tg, bar);
            __builtin_amdgcn_fence(__ATOMIC_ACQUIRE, "agent");
            xb_add(&bar[XB_XGEN(b.x)], 1u);
            asm volatile("s_waitcnt vmcnt(0)" ::: "memory");
        } else {
            XB_SPIN(xb_ld(&bar[XB_XGEN(b.x)]) == gen, bar);
            __builtin_amdgcn_fence(__ATOMIC_ACQUIRE, "agent");
            asm volatile("s_waitcnt vmcnt(0)" ::: "memory");
        }
    }
    __syncthreads();
}

struct Frame {
    unsigned char* lds; int tid, lane, wave, vcu, G;
    const float *x, *c, *w_cond, *b_cond, *w_in, *b_glu, *w_dw, *b_dw, *g_cn, *b_cn, *w_conv_out, *b_conv_out, *w_attn_out, *w_mix_out, *g_ln1, *b_ln1,
                *w_grp, *b_grp, *w_er, *b_er, *w1, *w3, *w2, *g_ln2, *b_ln2;
    const int* pos; float* out; unsigned char* ws;
};
#define WSP(T, off) ((T*)(F.ws + (off)))

__device__ __forceinline__ unsigned f2bf(float f) { unsigned u = __builtin_bit_cast(unsigned, f); return (u + 0x7fffu + ((u >> 16) & 1u)) >> 16; }
__device__ __forceinline__ unsigned pk2(float lo, float hi) { return f2bf(lo) | (f2bf(hi) << 16); }
__device__ __forceinline__ void transpose_item(const float* W, int K, int N, bf16_t* WT, int k0, int n0, int drow0, float* scr, int lane) {
#pragma unroll 8
    for (int i = 0; i < 32; ++i) { const int kk = 2 * i + (lane >> 5); scr[kk * 33 + (lane & 31)] = W[(size_t)(k0 + kk) * N + n0 + (lane & 31)]; }
    asm volatile("s_waitcnt lgkmcnt(0)" ::: "memory");
    const int cch = lane & 7;
#pragma unroll
    for (int j = 0; j < 4; ++j) { const int n = (lane >> 3) + 8 * j; const float* s = scr + (8 * cch) * 33 + n;
        u32x4 o; o.x = pk2(s[0 * 33], s[1 * 33]); o.y = pk2(s[2 * 33], s[3 * 33]); o.z = pk2(s[4 * 33], s[5 * 33]); o.w = pk2(s[6 * 33], s[7 * 33]);
        *(u32x4*)(WT + (size_t)(drow0 + n) * K + k0 + 8 * cch) = o; }
    asm volatile("s_waitcnt lgkmcnt(0)" ::: "memory");
}
__device__ __forceinline__ int glu_rowmap(int n0, int half) { return (n0 >> 7) * 256 + half * 128 + (n0 & 127); }
__device__ __forceinline__ void p0_prologue(Frame& F) {
    float* ssilu = (float*)F.lds;
    for (int i = F.tid; i < 2 * D; i += NTHR) ssilu[i] = silu(F.c[i]);
    __syncthreads();
    float* scr = (float*)(F.lds + 16384 + F.wave * 8704);
    const int gw = F.vcu * NWAVES + F.wave, NGW = F.G * NWAVES;
    for (int it = gw; it < 192 * MODKC; it += NGW) {
        const int cg = it % 192, kc = it / 192; const int col = cg * 64 + F.lane; float a0 = 0.f, a1 = 0.f;
        const float* wp = F.w_cond + (size_t)(kc * 128) * (6 * D) + col;
#pragma unroll 16
        for (int k = 0; k < 128; ++k) { const float w = wp[(size_t)k * (6 * D)]; a0 += ssilu[kc * 128 + k] * w; a1 += ssilu[D + kc * 128 + k] * w; }
        float* part = WSP(float, WS_MODPART);
        part[(size_t)(kc * 2 + 0) * (6 * D) + col] = a0; part[(size_t)(kc * 2 + 1) * (6 * D) + col] = a1;
    }
    constexpr int I_IN = (D / 64) * (INC / 32), I_CO = (CC / 64) * (D / 32), I_AO = (AW / 64) * (D / 32), I_MIX = (D / 64) * (D / 32);
    constexpr int I_W1E = (D / 64) * (FF / 32), I_W2E = (FF / 64) * (D / 32);
    constexpr int NITEMS = I_IN + I_CO + I_AO + I_MIX + NEXP * (2 * I_W1E + I_W2E);
    for (int it = gw; it < NITEMS; it += NGW) {
        int r = it;
        if (r < I_IN) { const int nblk = INC / 32, kb = r / nblk, nb = r % nblk, n0 = nb * 32; int dr = n0; if (n0 < 1024) dr = glu_rowmap(n0, 0); else if (n0 < 2048) dr = glu_rowmap(n0 - 1024, 1);
            transpose_item(F.w_in, D, INC, WSP(bf16_t, WS_WIN), kb * 64, n0, dr, scr, F.lane); continue; } r -= I_IN;
        if (r < I_CO) { const int nblk = D / 32, kb = r / nblk, nb = r % nblk; transpose_item(F.w_conv_out, CC, D, WSP(bf16_t, WS_WCO), kb * 64, nb * 32, nb * 32, scr, F.lane); continue; } r -= I_CO;
        if (r < I_AO) { const int nblk = D / 32, kb = r / nblk, nb = r % nblk; transpose_item(F.w_attn_out, AW, D, WSP(bf16_t, WS_WAO), kb * 64, nb * 32, nb * 32, scr, F.lane); continue; } r -= I_AO;
        if (r < I_MIX) { const int nblk = D / 32, kb = r / nblk, nb = r % nblk; transpose_item(F.w_mix_out, D, D, WSP(bf16_t, WS_WMIX), kb * 64, nb * 32, nb * 32, scr, F.lane); continue; } r -= I_MIX;
        const int e = r / (2 * I_W1E + I_W2E); r -= e * (2 * I_W1E + I_W2E);
        if (r < 2 * I_W1E) { const int which = r / I_W1E; r -= which * I_W1E; const int nblk = FF / 32, kb = r / nblk, nb = r % nblk, n0 = nb * 32;
            transpose_item((which ? F.w3 : F.w1) + (size_t)e * D * FF, D, FF, WSP(bf16_t, WS_W13) + (size_t)e * 1024 * D, kb * 64, n0, glu_rowmap(n0, which), scr, F.lane); continue; }
        r -= 2 * I_W1E;
        { const int nblk = D / 32, kb = r / nblk, nb = r % nblk; transpose_item(F.w2 + (size_t)e * FF * D, FF, D, WSP(bf16_t, WS_W2) + (size_t)e * D * FF, kb * 64, nb * 32, nb * 32, scr, F.lane); }
    }
    for (int idx = gw * 64 + F.lane; idx < NTOK * 16; idx += NGW * 64) { const int row = idx >> 4, f = idx & 15;
        const float inv = powf(500000.f, -(float)f / 16.f); const float ang = (float)F.pos[row] * inv; float sn, cs; sincosf(ang, &sn, &cs);
        float* rp = WSP(float, WS_ROPE); rp[row * 32 + f] = cs; rp[row * 32 + 16 + f] = sn; }
    for (int idx = gw * 64 + F.lane; idx < 36 * D; idx += NGW * 64) { const int o = idx / D, k = idx % D;
        WSP(float, WS_WRT)[idx] = (o < 4) ? F.w_grp[k * 4 + o] : F.w_er[k * 32 + (o - 4)]; }
}

__device__ __forceinline__ void p1_ln(Frame& F) {
    float* sm = (float*)F.lds;
    const int r0 = F.vcu * 32, b = r0 / T;
    const float* part = WSP(float, WS_MODPART);
    for (int idx = F.tid; idx < 2 * D; idx += NTHR) { const int j = idx; float v = F.b_cond[j];
#pragma unroll
        for (int kc = 0; kc < MODKC; ++kc) v += part[(size_t)(kc * 2 + b) * (6 * D) + j];
        sm[idx] = v; }
    if (F.tid < 96) { const int idx = F.vcu * 96 + F.tid; const int bb = idx / (6 * D), j = idx % (6 * D); float v = F.b_cond[j];
#pragma unroll
        for (int kc = 0; kc < MODKC; ++kc) v += part[(size_t)(kc * 2 + bb) * (6 * D) + j];
        WSP(float, WS_MODF)[idx] = v; }
    __syncthreads();
#pragma unroll 1
    for (int i = 0; i < 4; ++i) {
        const int row = r0 + F.wave * 4 + i;
        const f32x4* xr = (const f32x4*)(F.x + (size_t)row * D) + F.lane;
        f32x4 v[8]; float s = 0.f;
#pragma unroll
        for (int j = 0; j < 8; ++j) { v[j] = xr[64 * j]; s += (v[j].x + v[j].y) + (v[j].z + v[j].w); }
        const float mean = wave_sum(s) * (1.f / D); float s2 = 0.f;
#pragma unroll
        for (int j = 0; j < 8; ++j) { v[j] = v[j] - mean; s2 += (v[j].x * v[j].x + v[j].y * v[j].y) + (v[j].z * v[j].z + v[j].w * v[j].w); }
        const float rstd = rsqrtf(wave_sum(s2) * (1.f / D) + EPS);
        u32x2* o8 = (u32x2*)(WSP(bf16_t, WS_U) + (size_t)row * D) + F.lane;
#pragma unroll
        for (int j = 0; j < 8; ++j) { const int col = 4 * F.lane + 256 * j; const f32x4 sh = *(const f32x4*)(sm + col), sc = *(const f32x4*)(sm + D + col);
            const f32x4 y = v[j] * rstd * (sc + 1.f) + sh; u32x2 w; w.x = cvt_pk_bf16(y.x, y.y); w.y = cvt_pk_bf16(y.z, y.w); o8[64 * j] = w; }
    }
}

struct EpiIn {
    static constexpr bool PERM = true;
    const float* b_glu; const float* ropecs; bf16_t *hglu, *q, *k, *v, *sg;
    __device__ __forceinline__ void operator()(const f32x4 (&acc)[2][2][4][2], const Unit& u, int wr, int wc, int fr, int fq) const {
        const int row0 = u.pm * BM + wr * 64 + fr, pn = u.pn;
        if (pn < 8) {
            const int c0 = pn * 128 + wc * 32 + 8 * fq;
            const f32x4 ba0 = *(const f32x4*)(b_glu + c0), ba1 = *(const f32x4*)(b_glu + c0 + 4), bb0 = *(const f32x4*)(b_glu + CC + c0), bb1 = *(const f32x4*)(b_glu + CC + c0 + 4);
#pragma unroll
            for (int ai = 0; ai < 2; ++ai)
#pragma unroll
                for (int m = 0; m < 4; ++m) { const int row = row0 + ai * HALF + m * 16;
                    const f32x4 a0 = acc[ai][0][m][0] + ba0, a1 = acc[ai][0][m][1] + ba1, g0 = acc[ai][1][m][0] + bb0, g1 = acc[ai][1][m][1] + bb1;
                    u32x4 w; w.x = cvt_pk_bf16(a0[0] * sigm(g0[0]), a0[1] * sigm(g0[1])); w.y = cvt_pk_bf16(a0[2] * sigm(g0[2]), a0[3] * sigm(g0[3]));
                    w.z = cvt_pk_bf16(a1[0] * sigm(g1[0]), a1[1] * sigm(g1[1])); w.w = cvt_pk_bf16(a1[2] * sigm(g1[2]), a1[3] * sigm(g1[3]));
                    *(u32x4*)(hglu + (size_t)row * CC + c0) = w; }
        } else if (pn < 16) {
            bf16_t* dst = (pn < 12) ? q : k; const int colt = (pn - ((pn < 12) ? 8 : 12)) * 256;
#pragma unroll
            for (int ai = 0; ai < 2; ++ai)
#pragma unroll
                for (int m = 0; m < 4; ++m) { const int row = row0 + ai * HALF + m * 16;
                    f32x4 cs0, cs1, sn0, sn1;
                    if (wc == 0) { const float* rp = ropecs + (size_t)row * 32 + 8 * (fq & 1); cs0 = *(const f32x4*)rp; cs1 = *(const f32x4*)(rp + 4); sn0 = *(const f32x4*)(rp + 16); sn1 = *(const f32x4*)(rp + 20);
                        if (fq < 2) { sn0 = -sn0; sn1 = -sn1; } }
#pragma unroll
                    for (int bj = 0; bj < 2; ++bj) { f32x4 v0 = acc[ai][bj][m][0], v1 = acc[ai][bj][m][1];
                        if (wc == 0) { f32x4 p0, p1;
#pragma unroll
                            for (int j = 0; j < 4; ++j) { p0[j] = __shfl_xor(v0[j], 32); p1[j] = __shfl_xor(v1[j], 32); }
                            v0 = v0 * cs0 + p0 * sn0; v1 = v1 * cs1 + p1 * sn1; }
                        u32x4 w; w.x = cvt_pk_bf16(v0[0], v0[1]); w.y = cvt_pk_bf16(v0[2], v0[3]); w.z = cvt_pk_bf16(v1[0], v1[1]); w.w = cvt_pk_bf16(v1[2], v1[3]);
                        *(u32x4*)(dst + (size_t)row * AW + colt + bj * HALF + wc * 32 + 8 * fq) = w; } }
        } else if (pn < 20) {
            const int colt = (pn - 16) * 256;
#pragma unroll
            for (int ai = 0; ai < 2; ++ai)
#pragma unroll
                for (int m = 0; m < 4; ++m) { const int row = row0 + ai * HALF + m * 16;
#pragma unroll
                    for (int bj = 0; bj < 2; ++bj) { const f32x4 v0 = acc[ai][bj][m][0], v1 = acc[ai][bj][m][1];
                        u32x4 w; w.x = cvt_pk_bf16(v0[0], v0[1]); w.y = cvt_pk_bf16(v0[2], v0[3]); w.z = cvt_pk_bf16(v1[0], v1[1]); w.w = cvt_pk_bf16(v1[2], v1[3]);
                        *(u32x4*)(v + (size_t)row * AW + colt + bj * HALF + wc * 32 + 8 * fq) = w; } }
        } else {
            const int colt = (pn - 20) * 256;
#pragma unroll
            for (int ai = 0; ai < 2; ++ai)
#pragma unroll
                for (int m = 0; m < 4; ++m) { const int row = row0 + ai * HALF + m * 16;
#pragma unroll
                    for (int bj = 0; bj < 2; ++bj) { const f32x4 v0 = acc[ai][bj][m][0], v1 = acc[ai][bj][m][1];
                        u32x4 w; w.x = cvt_pk_bf16(sigm(v0[0]), sigm(v0[1])); w.y = cvt_pk_bf16(sigm(v0[2]), sigm(v0[3])); w.z = cvt_pk_bf16(sigm(v1[0]), sigm(v1[1])); w.w = cvt_pk_bf16(sigm(v1[2]), sigm(v1[3]));
                        *(u32x4*)(sg + (size_t)row * 4096 + colt + bj * HALF + wc * 32 + 8 * fq) = w; } }
        }
    }
};

__device__ __forceinline__ void p3_conv_unit(Frame& F, int unit) {
    const int t0g = unit * 32;
    const int tin = t0g % T;
    float* st = (float*)F.lds;
    {
        const int ch = 2 * F.tid;
        const bf16_t* hg = WSP(bf16_t, WS_HGLU);
        unsigned in[62];
#pragma unroll
        for (int r = 0; r < 62; ++r) { const int tt = tin - 30 + r; in[r] = (tt >= 0) ? *(const unsigned*)(hg + (size_t)(t0g - 30 + r) * CC + ch) : 0u; }
        f32x2 acc[32]; const f32x2 bd = *(const f32x2*)(F.b_dw + ch);
#pragma unroll
        for (int o = 0; o < 32; ++o) acc[o] = bd;
#pragma unroll
        for (int w = 0; w < CW; ++w) { const f32x2 kw = *(const f32x2*)(F.w_dw + w * CC + ch);
#pragma unroll
            for (int o = 0; o < 32; ++o) { const unsigned iv = in[o + w]; acc[o].x += bf_lo(iv) * kw.x; acc[o].y += bf_hi(iv) * kw.y; } }
#pragma unroll
        for (int o = 0; o < 32; ++o) *(f32x2*)(st + o * CC + ch) = acc[o];
    }
    __syncthreads();
#pragma unroll 1
    for (int i = 0; i < 4; ++i) {
        const int o = F.wave * 4 + i; f32x4 v[4]; float s = 0.f;
#pragma unroll
        for (int j = 0; j < 4; ++j) { v[j] = *(const f32x4*)(st + o * CC + 4 * F.lane + 256 * j); s += (v[j].x + v[j].y) + (v[j].z + v[j].w); }
        const float mean = wave_sum(s) * (1.f / CC); float s2 = 0.f;
#pragma unroll
        for (int j = 0; j < 4; ++j) { v[j] = v[j] - mean; s2 += (v[j].x * v[j].x + v[j].y * v[j].y) + (v[j].z * v[j].z + v[j].w * v[j].w); }
        const float rstd = rsqrtf(wave_sum(s2) * (1.f / CC) + EPS);
        u32x2* o8 = (u32x2*)(WSP(bf16_t, WS_HC) + (size_t)(t0g + o) * CC) + F.lane;
#pragma unroll
        for (int j = 0; j < 4; ++j) { const int col = 4 * F.lane + 256 * j; const f32x4 g = *(const f32x4*)(F.g_cn + col), bb = *(const f32x4*)(F.b_cn + col);
            const f32x4 y = v[j] * rstd * g + bb; u32x2 w; w.x = cvt_pk_bf16(silu(y.x), silu(y.y)); w.y = cvt_pk_bf16(silu(y.z), silu(y.w)); o8[64 * j] = w; }
    }
    __syncthreads();
}
__device__ __forceinline__ void p3_kmean_unit(Frame& F, int unit) {
    const int blk = unit & 15, h = (unit >> 4) & 7, b = unit >> 7;
    const bf16_t* kp = WSP(bf16_t, WS_K) + (size_t)(b * T + blk * MB + F.wave * 32) * AW + h * HD + 2 * F.lane;
    float s0 = 0.f, s1 = 0.f;
#pragma unroll 8
    for (int r = 0; r < 32; ++r) { const unsigned w = *(const unsigned*)(kp + (size_t)r * AW); s0 += bf_lo(w); s1 += bf_hi(w); }
    float* red = (float*)F.lds;
    red[F.wave * 128 + 2 * F.lane] = s0; red[F.wave * 128 + 2 * F.lane + 1] = s1;
    __syncthreads();
    if (F.tid < 128) { float s = 0.f;
#pragma unroll
        for (int w = 0; w < 8; ++w) s += red[w * 128 + F.tid];
        WSP(float, WS_KMEAN)[unit * HD + F.tid] = s * (1.f / MB); }
    __syncthreads();
}
namespace att {
constexpr float SCALE = 0.088388347648318440f, THR = 8.f, NEGM = -1e37f;
constexpr int SHM_T = 16384;
#define KSWZ(row, colB) ((row) * 256 + ((colB) ^ (((row) & 7) << 4)))
#define SBAR() __builtin_amdgcn_sched_barrier(0)
__device__ __forceinline__ int crow(int r, int hi) { return (r & 3) + 8 * (r >> 2) + 4 * hi; }
__device__ __forceinline__ void partialSM(f32x16& p0, f32x16& p1, float& m_reg, float& mn, float& alpha) {
    constexpr float C = SCALE * 1.4426950408889634f;
    float pmax = p0[0];
#pragma unroll
    for (int r = 1; r < 16; ++r) pmax = fmaxf(pmax, p0[r]);
#pragma unroll
    for (int r = 0; r < 16; ++r) pmax = fmaxf(pmax, p1[r]);
    { auto rr = __builtin_amdgcn_permlane32_swap(__float_as_uint(pmax), __float_as_uint(pmax), false, false); pmax = fmaxf(__uint_as_float(rr[0]), __uint_as_float(rr[1])); }
    if (__builtin_expect(__all(pmax - m_reg <= THR / SCALE), 1)) { mn = m_reg; alpha = 1.f; }
    else { mn = fmaxf(m_reg, pmax); alpha = __builtin_amdgcn_exp2f((m_reg - mn) * C); m_reg = mn; }
    const float mnC = -mn * C;
#pragma unroll
    for (int r = 0; r < 16; ++r) p0[r] = fmaf(p0[r], C, mnC);
#pragma unroll
    for (int r = 0; r < 16; ++r) p1[r] = fmaf(p1[r], C, mnC);
#pragma unroll
    for (int r = 0; r < 16; ++r) p0[r] = __builtin_amdgcn_exp2f(p0[r]);
}
__device__ __forceinline__ void finishSM(f32x16& p0, f32x16& p1, float alpha, float& l_reg, bf16x8& pa0, bf16x8& pa1, bf16x8& pa2, bf16x8& pa3) {
#pragma unroll
    for (int r = 0; r < 16; ++r) p1[r] = __builtin_amdgcn_exp2f(p1[r]);
    float ps = 0;
#pragma unroll
    for (int r = 0; r < 16; ++r) ps += p0[r];
#pragma unroll
    for (int r = 0; r < 16; ++r) ps += p1[r];
    { auto rr = __builtin_amdgcn_permlane32_swap(__float_as_uint(ps), __float_as_uint(ps), false, false); ps = __uint_as_float(rr[0]) + __uint_as_float(rr[1]); }
    l_reg = l_reg * alpha + ps;
#define PK4(P, BASE, OUT) do { unsigned a0 = cvt_pk_bf16(P[BASE + 0], P[BASE + 1]), a1 = cvt_pk_bf16(P[BASE + 2], P[BASE + 3]);   \
    unsigned b0 = cvt_pk_bf16(P[BASE + 4], P[BASE + 5]), b1 = cvt_pk_bf16(P[BASE + 6], P[BASE + 7]);                              \
    auto r0 = __builtin_amdgcn_permlane32_swap(a0, b0, false, false); auto r1 = __builtin_amdgcn_permlane32_swap(a1, b1, false, false); \
    u32x4 w = {r0[0], r1[0], r0[1], r1[1]}; OUT = *reinterpret_cast<bf16x8*>(&w); } while (0)
    PK4(p0, 0, pa0); PK4(p0, 8, pa1); PK4(p1, 0, pa2); PK4(p1, 8, pa3);
#undef PK4
}
__device__ __forceinline__ void qkt(f32x16& p0, f32x16& p1, const unsigned char* Ks, const bf16x8* qr, int r32, int hi) {
    p0 = f32x16{}; p1 = f32x16{};
#pragma unroll
    for (int d0 = 0; d0 < 8; ++d0) { const int cb = (d0 * 16 + hi * 8) * 2;
        const bf16x8 b0 = *reinterpret_cast<const bf16x8*>(Ks + KSWZ(r32, cb));
        const bf16x8 b1 = *reinterpret_cast<const bf16x8*>(Ks + KSWZ(32 + r32, cb));
        p0 = __builtin_amdgcn_mfma_f32_32x32x16_bf16(b0, qr[d0], p0, 0, 0, 0);
        p1 = __builtin_amdgcn_mfma_f32_32x32x16_bf16(b1, qr[d0], p1, 0, 0, 0); }
}
__device__ __forceinline__ int v_st(int k, int c) { const int kk = (k & ~0xC) | ((k & 4) << 1) | ((k & 8) >> 1); return ((kk >> 3) * 4 + (c >> 5)) * 512 + ((kk & 7) * 32 + (c & 31)) * 2; }
__device__ __forceinline__ int v_rd_base(int lane) { return ((lane & 3) << 3) | (((lane >> 2) & 3) << 6) | (((lane >> 4) & 1) << 5) | (((lane >> 5) & 1) << 8); }
constexpr int v_rd_off(int d0, int ks, int half) { return d0 * 512 + ks * 4096 + half * 2048; }
template <int OFF> __device__ __forceinline__ s16x4 tr_read(int vb) { s16x4 r; asm volatile("ds_read_b64_tr_b16 %0, %1 offset:%2" : "=&v"(r) : "v"(vb), "i"(OFF) : "memory"); return r; }
template <int D0> __device__ __forceinline__ void pv_one(f32x16& od, int vb, bf16x8 pa0, bf16x8 pa1, bf16x8 pa2, bf16x8 pa3) {
    const s16x4 l0 = tr_read<v_rd_off(D0, 0, 0)>(vb), h0 = tr_read<v_rd_off(D0, 0, 1)>(vb), l1 = tr_read<v_rd_off(D0, 1, 0)>(vb), h1 = tr_read<v_rd_off(D0, 1, 1)>(vb);
    const s16x4 l2 = tr_read<v_rd_off(D0, 2, 0)>(vb), h2 = tr_read<v_rd_off(D0, 2, 1)>(vb), l3 = tr_read<v_rd_off(D0, 3, 0)>(vb), h3 = tr_read<v_rd_off(D0, 3, 1)>(vb);
    asm volatile("s_waitcnt lgkmcnt(0)" ::: "memory"); SBAR();
#define PK(L, H) (bf16x8){L[0], L[1], L[2], L[3], H[0], H[1], H[2], H[3]}
    od = __builtin_amdgcn_mfma_f32_32x32x16_bf16(pa0, PK(l0, h0), od, 0, 0, 0);
    od = __builtin_amdgcn_mfma_f32_32x32x16_bf16(pa1, PK(l1, h1), od, 0, 0, 0);
    od = __builtin_amdgcn_mfma_f32_32x32x16_bf16(pa2, PK(l2, h2), od, 0, 0, 0);
    od = __builtin_amdgcn_mfma_f32_32x32x16_bf16(pa3, PK(l3, h3), od, 0, 0, 0);
#undef PK
}
__device__ __forceinline__ void pv_d0(f32x16* o, int vb, bf16x8 pa0, bf16x8 pa1, bf16x8 pa2, bf16x8 pa3) {
    pv_one<0>(o[0], vb, pa0, pa1, pa2, pa3); pv_one<1>(o[1], vb, pa0, pa1, pa2, pa3); pv_one<2>(o[2], vb, pa0, pa1, pa2, pa3); pv_one<3>(o[3], vb, pa0, pa1, pa2, pa3);
}
__device__ __forceinline__ void amask(f32x16& p0, f32x16& p1, int tau, int iblk, unsigned selmask, int qin, int hi) {
    const int j = tau >> 2;
    if (j < iblk) { const bool ok = (selmask >> j) & 1u;
#pragma unroll
        for (int r = 0; r < 16; ++r) { p0[r] = ok ? p0[r] : NEGM; p1[r] = ok ? p1[r] : NEGM; }
    } else { const int kb = 64 * (tau & 3) + 4 * hi;
#pragma unroll
        for (int r = 0; r < 16; ++r) { const int kv = kb + (r & 3) + 8 * (r >> 2); p0[r] = (kv > qin) ? NEGM : p0[r]; p1[r] = (kv + 32 > qin) ? NEGM : p1[r]; } }
}
__device__ __forceinline__ void attn_unit(Frame& F, LAS unsigned char* ring, int b, int h, int iblk, int half) {
    const int tid = F.tid, wid = F.wave, lane = F.lane, r32 = lane & 31, hi = lane >> 5, grp = wid >> 2, wq = wid & 3;
    unsigned char* lds = F.lds; unsigned char* misc = lds + LDS_MISC;
    float* wsf = (float*)misc + wid * 64; float* li_l = wsf; float* al_l = wsf + 32;
    float* kml = (float*)(misc + 2048);
    const bf16_t* Qg = WSP(bf16_t, WS_Q); const bf16_t* Kg = WSP(bf16_t, WS_K); const bf16_t* Vg = WSP(bf16_t, WS_V);
    const size_t rowb = (size_t)b * T;
    { const float* km = WSP(float, WS_KMEAN) + (size_t)(b * NH + h) * NBLK * HD; *(f32x4*)(kml + tid * 4) = *(const f32x4*)(km + tid * 4); }
    const int qin = half * 128 + wq * 32 + r32;
    const bf16_t* Qw = Qg + (rowb + iblk * MB + qin) * AW + h * HD + hi * 8;
    bf16x8 qr[8];
#pragma unroll
    for (int d0 = 0; d0 < 8; ++d0) qr[d0] = *reinterpret_cast<const bf16x8*>(Qw + d0 * 16);
    __syncthreads();
    unsigned selmask = 0;
    {
        float* gl = (float*)lds + wid * 1024;
#pragma unroll 1
        for (int j = 0; j < iblk; ++j) { float g = 0.f; const float* kj = kml + j * HD + hi * 8;
#pragma unroll
            for (int d0 = 0; d0 < 8; ++d0) { const f32x4 k0 = *(const f32x4*)(kj + d0 * 16), k1 = *(const f32x4*)(kj + d0 * 16 + 4);
#define QF(e) __uint_as_float(((unsigned)(unsigned short)qr[d0][e]) << 16)
                g += (QF(0) * k0[0] + QF(1) * k0[1]) + (QF(2) * k0[2] + QF(3) * k0[3]) + (QF(4) * k1[0] + QF(5) * k1[1]) + (QF(6) * k1[2] + QF(7) * k1[3]);
#undef QF
            }
            g += __shfl_xor(g, 32); gl[j * 64 + lane] = g; }
#pragma unroll 1
        for (int sidx = 0; sidx < 3; ++sidx) { int best = -1; float bv = -INFINITY;
#pragma unroll 1
            for (int j = 0; j < iblk; ++j) { const float g = gl[j * 64 + lane]; const bool c = !((selmask >> j) & 1u) && (g > bv); bv = c ? g : bv; best = c ? j : best; }
            if (best >= 0) selmask |= 1u << best; }
    }
    __syncthreads();
    unsigned char* V_lds = lds; unsigned char* K_lds = lds + 4 * SHM_T;
    float m_reg = -1e30f, l_reg = 0; f32x16 o[4] = {};
    const bf16_t* Kh = Kg + rowb * AW + h * HD; const bf16_t* Vh = Vg + rowb * AW + h * HD;
    const int vb0 = (int)(uintptr_t)(V_lds + grp * SHM_T) + v_rd_base(lane);
    const char* Kb = (const char*)Kh; const char* Vb = (const char*)Vh;
    unsigned koff[4], voff[4];
#pragma unroll
    for (int i = 0; i < 4; ++i) { const int p = 4 * wq + i;
        const int row = 4 * p + (lane >> 4), cK = (lane & 15) ^ (row & 7); koff[i] = (unsigned)(((64 * grp + row) * AW + 8 * cK) * 2);
        const int sbt = 2 * p + (lane >> 5), kk = (sbt >> 2) * 8 + ((lane & 31) >> 2), kv = (kk & ~0xC) | ((kk & 4) << 1) | ((kk & 8) >> 1), cV = (sbt & 3) * 32 + 8 * (lane & 3);
        voff[i] = (unsigned)(((64 * grp + kv) * AW + cV) * 2); }
#define DMA_K(bf, step) do { _Pragma("unroll") for (int i_ = 0; i_ < 4; ++i_) { unsigned o_ = koff[i_]; asm volatile("" : "+v"(o_)); __builtin_amdgcn_global_load_lds((const unsigned*)(Kb + (size_t)(step) * 128 * AW * 2 + o_), \
        (LAS unsigned*)(ring + 4 * SHM_T + ((bf) * 2 + grp) * SHM_T + (4 * wq + i_) * 1024), 16, 0, 0); } } while (0)
#define DMA_V(bf, step) do { _Pragma("unroll") for (int i_ = 0; i_ < 4; ++i_) { unsigned o_ = voff[i_]; asm volatile("" : "+v"(o_)); __builtin_amdgcn_global_load_lds((const unsigned*)(Vb + (size_t)(step) * 128 * AW * 2 + o_), \
        (LAS unsigned*)(ring + ((bf) * 2 + grp) * SHM_T + (4 * wq + i_) * 1024), 16, 0, 0); } } while (0)
#define WAITB() do { asm volatile("s_waitcnt vmcnt(0) lgkmcnt(0)" ::: "memory"); __builtin_amdgcn_s_barrier(); asm volatile("" ::: "memory"); } while (0)
#define RESC(a) do { if (__any((a) < 1.f)) { if (hi == 0) al_l[r32] = (a); asm volatile("s_waitcnt lgkmcnt(0)" ::: "memory"); \
    _Pragma("unroll") for (int d = 0; d < 4; ++d) _Pragma("unroll") for (int r = 0; r < 16; ++r) o[d][r] *= al_l[crow(r, hi)]; } } while (0)
#define KBUF(bf) (K_lds + ((bf) * 2 + grp) * SHM_T)
#define MASK(P0, P1, s) amask(P0, P1, 2 * (s) + grp, iblk, selmask, qin, hi)
    f32x16 p0, p1; float mn, al; bf16x8 pa0, pa1, pa2, pa3; const int NT = 2 * (iblk + 1);
    DMA_K(0, 0); DMA_V(0, 0);
#pragma unroll 1
    for (int st = 0; st < NT; ++st) {
        const int bf = st & 1;
        WAITB();
        if (st + 1 < NT) { DMA_K(bf ^ 1, st + 1); DMA_V(bf ^ 1, st + 1); }
        qkt(p0, p1, KBUF(bf), qr, r32, hi); MASK(p0, p1, st); partialSM(p0, p1, m_reg, mn, al);
        RESC(al);
        finishSM(p0, p1, al, l_reg, pa0, pa1, pa2, pa3); SBAR();
        pv_d0(o, vb0 + bf * 2 * SHM_T, pa0, pa1, pa2, pa3);
    }
#undef DMA_K
#undef DMA_V
#undef WAITB
#undef RESC
#undef KBUF
#undef MASK
    __syncthreads();
    float* obuf = (float*)lds;
    float* ml = (float*)(misc + 10240);
    if (grp == 1) {
#pragma unroll
        for (int d = 0; d < 4; ++d)
#pragma unroll
            for (int r = 0; r < 16; ++r) obuf[(wq * 64 + d * 16 + r) * 64 + lane] = o[d][r];
        if (hi == 0) { ml[wq * 64 + r32] = m_reg; ml[wq * 64 + 32 + r32] = l_reg; }
    }
    __syncthreads();
    if (grp == 0) {
        constexpr float C = SCALE * 1.4426950408889634f;
        const float m1 = ml[wq * 64 + r32], l1 = ml[wq * 64 + 32 + r32];
        const float M = fmaxf(m_reg, m1), f0 = __builtin_amdgcn_exp2f((m_reg - M) * C), f1 = __builtin_amdgcn_exp2f((m1 - M) * C);
        const float linv = 1.f / (l_reg * f0 + l1 * f1);
        if (hi == 0) { li_l[r32] = f0 * linv; al_l[r32] = f1 * linv; }
        asm volatile("s_waitcnt lgkmcnt(0)" ::: "memory");
        bf16_t* stg = (bf16_t*)(lds + 65536 + wq * 8192);
#pragma unroll
        for (int r = 0; r < 16; ++r) { const int orow = crow(r, hi); const float a0 = li_l[orow], a1 = al_l[orow];
#pragma unroll
            for (int d = 0; d < 4; ++d) { const float v = o[d][r] * a0 + obuf[(wq * 64 + d * 16 + r) * 64 + lane] * a1; stg[orow * 128 + d * 32 + r32] = (bf16_t)(cvt_pk_bf16(v, 0.f) & 0xffffu); } }
        asm volatile("s_waitcnt lgkmcnt(0)" ::: "memory");
        bf16_t* Ow = WSP(bf16_t, WS_AO) + (rowb + iblk * MB + half * 128 + wq * 32) * AW + h * HD;
#pragma unroll
        for (int i = 0; i < 8; ++i) { const int row = i * 4 + (lane >> 4), ch = lane & 15; const u32x4 v = *(const u32x4*)(stg + row * 128 + ch * 8); *(u32x4*)(Ow + (size_t)row * AW + ch * 8) = v; }
    }
    __syncthreads();
}
#undef KSWZ
#undef SBAR
}

struct EpiConvOut {
    static constexpr bool PERM = true;
    const float* bias; const bf16_t* sg; bf16_t* m1;
    __device__ __forceinline__ void operator()(const f32x4 (&acc)[2][2][4][2], const Unit& u, int wr, int wc, int fr, int fq) const {
        const int row0 = u.pm * BM + wr * 64 + fr, col0 = u.pn * BM + wc * 32 + 8 * fq;
#pragma unroll
        for (int bj = 0; bj < 2; ++bj) { const int col = col0 + bj * HALF; const f32x4 b0 = *(const f32x4*)(bias + col), b1 = *(const f32x4*)(bias + col + 4);
#pragma unroll
            for (int ai = 0; ai < 2; ++ai)
#pragma unroll
                for (int m = 0; m < 4; ++m) { const int row = row0 + ai * HALF + m * 16; const u32x4 g = *(const u32x4*)(sg + (size_t)row * 4096 + col);
                    const f32x4 v0 = acc[ai][bj][m][0] + b0, v1 = acc[ai][bj][m][1] + b1; u32x4 w;
                    w.x = cvt_pk_bf16(v0[0] * bf_lo(g.x), v0[1] * bf_hi(g.x)); w.y = cvt_pk_bf16(v0[2] * bf_lo(g.y), v0[3] * bf_hi(g.y));
                    w.z = cvt_pk_bf16(v1[0] * bf_lo(g.z), v1[1] * bf_hi(g.z)); w.w = cvt_pk_bf16(v1[2] * bf_lo(g.w), v1[3] * bf_hi(g.w));
                    *(u32x4*)(m1 + (size_t)row * D + col) = w; } }
    }
};
struct EpiAttnOut {
    static constexpr bool PERM = true;
    const bf16_t* sg; const bf16_t* m1; bf16_t* merged;
    __device__ __forceinline__ void operator()(const f32x4 (&acc)[2][2][4][2], const Unit& u, int wr, int wc, int fr, int fq) const {
        const int row0 = u.pm * BM + wr * 64 + fr, col0 = u.pn * BM + wc * 32 + 8 * fq;
#pragma unroll
        for (int bj = 0; bj < 2; ++bj) { const int col = col0 + bj * HALF;
#pragma unroll
            for (int ai = 0; ai < 2; ++ai)
#pragma unroll
                for (int m = 0; m < 4; ++m) { const int row = row0 + ai * HALF + m * 16; const u32x4 g = *(const u32x4*)(sg + (size_t)row * 4096 + D + col); const u32x4 p = *(const u32x4*)(m1 + (size_t)row * D + col);
                    const f32x4 v0 = acc[ai][bj][m][0], v1 = acc[ai][bj][m][1]; u32x4 w;
                    w.x = cvt_pk_bf16(bf_lo(p.x) + v0[0] * bf_lo(g.x), bf_hi(p.x) + v0[1] * bf_hi(g.x)); w.y = cvt_pk_bf16(bf_lo(p.y) + v0[2] * bf_lo(g.y), bf_hi(p.y) + v0[3] * bf_hi(g.y));
                    w.z = cvt_pk_bf16(bf_lo(p.z) + v1[0] * bf_lo(g.z), bf_hi(p.z) + v1[1] * bf_hi(g.z)); w.w = cvt_pk_bf16(bf_lo(p.w) + v1[2] * bf_lo(g.w), bf_hi(p.w) + v1[3] * bf_hi(g.w));
                    *(u32x4*)(merged + (size_t)row * D + col) = w; } }
    }
};
struct EpiMix {
    static constexpr bool PERM = false;
    const float* x; const float* modf; float* vpre;
    __device__ __forceinline__ void operator()(const f32x4 (&acc)[2][2][4][2], const Unit& u, int wr, int wc, int fr, int fq) const {
        const int row0 = u.pm * BM + wr * 64 + fr, col0 = u.pn * BM + wc * 32 + 4 * fq; const int b = (u.pm * BM) / T;
#pragma unroll
        for (int bj = 0; bj < 2; ++bj)
#pragma unroll
            for (int n = 0; n < 2; ++n) { const int col = col0 + bj * HALF + n * 16; const f32x4 gt = *(const f32x4*)(modf + (size_t)b * 6 * D + 2 * D + col) + 1.f;
#pragma unroll
                for (int ai = 0; ai < 2; ++ai)
#pragma unroll
                    for (int m = 0; m < 4; ++m) { const size_t off = (size_t)(row0 + ai * HALF + m * 16) * D + col; const f32x4 xv = *(const f32x4*)(x + off);
                        *(f32x4*)(vpre + off) = xv * ALPHA + gt * acc[ai][bj][m][n]; } }
    }
};
struct EpiMoeUp {
    static constexpr bool PERM = true;
    const float* wl; bf16_t* hbuf;
    __device__ __forceinline__ void operator()(const f32x4 (&acc)[2][2][4][2], const Unit& u, int wr, int wc, int fr, int fq) const {
        const int rl0 = wr * 64 + fr, col = u.pn * 128 + wc * 32 + 8 * fq;
#pragma unroll
        for (int ai = 0; ai < 2; ++ai)
#pragma unroll
            for (int m = 0; m < 4; ++m) { const int rl = rl0 + ai * HALF + m * 16; if (rl < u.nrow) { const float wrow = wl[(size_t)u.e * NTOK + u.pm * 256 + rl];
                const f32x4 a0 = acc[ai][0][m][0], a1 = acc[ai][0][m][1], g0 = acc[ai][1][m][0], g1 = acc[ai][1][m][1]; u32x4 w;
                w.x = cvt_pk_bf16(silu(a0[0]) * g0[0] * wrow, silu(a0[1]) * g0[1] * wrow); w.y = cvt_pk_bf16(silu(a0[2]) * g0[2] * wrow, silu(a0[3]) * g0[3] * wrow);
                w.z = cvt_pk_bf16(silu(a1[0]) * g1[0] * wrow, silu(a1[1]) * g1[1] * wrow); w.w = cvt_pk_bf16(silu(a1[2]) * g1[2] * wrow, silu(a1[3]) * g1[3] * wrow);
                *(u32x4*)(hbuf + (size_t)(u.rbase + rl) * FF + col) = w; } }
    }
};
struct EpiMoeDown {
    static constexpr bool PERM = true;
    bf16_t* ypair;
    __device__ __forceinline__ void operator()(const f32x4 (&acc)[2][2][4][2], const Unit& u, int wr, int wc, int fr, int fq) const {
        const int rl0 = wr * 64 + fr, col0 = u.pn * BM + wc * 32 + 8 * fq;
#pragma unroll
        for (int ai = 0; ai < 2; ++ai)
#pragma unroll
            for (int m = 0; m < 4; ++m) { const int rl = rl0 + ai * HALF + m * 16; if (rl < u.nrow) {
#pragma unroll
                for (int bj = 0; bj < 2; ++bj) { const f32x4 v0 = acc[ai][bj][m][0], v1 = acc[ai][bj][m][1]; u32x4 w;
                    w.x = cvt_pk_bf16(v0[0], v0[1]); w.y = cvt_pk_bf16(v0[2], v0[3]); w.z = cvt_pk_bf16(v1[0], v1[1]); w.w = cvt_pk_bf16(v1[2], v1[3]);
                    *(u32x4*)(ypair + (size_t)(u.rbase + rl) * D + col0 + bj * HALF) = w; } } }
    }
};

__device__ __forceinline__ void moe_tables(Frame& F, int* ts, int* cn) {
    if (F.tid < 32) cn[F.tid] = (int)__hip_atomic_load(WSP(unsigned, WS_CTL) + CW_CNT + F.tid, __ATOMIC_RELAXED, __HIP_MEMORY_SCOPE_AGENT);
    __syncthreads();
    if (F.tid == 0) { int s = 0; for (int e = 0; e < 32; ++e) { ts[e] = s; s += (cn[e] + 255) >> 8; } ts[32] = s; }
    __syncthreads();
}
struct MoeSched {
    const char* A; const char* W; const int* tokl; const int* ts; const int* cn; int G, c, K, ntn, R[2], C[2]; bool gather; size_t wexp;
    __device__ void init(const void* A_, const void* W_, const int* tokl_, const int* ts_, const int* cn_, int G_, int c_, int K_, int ntn_, bool gather_, int tid) {
        A = (const char*)A_; W = (const char*)W_; tokl = tokl_; ts = ts_; cn = cn_; G = G_; c = c_; K = K_; ntn = ntn_; gather = gather_; wexp = (size_t)ntn * 256 * K * 2;
        for (int i = 0; i < 2; ++i) stage_rc(tid * 16 + i * 8192, R[i], C[i]);
    }
    __device__ bool next(int i, Unit& u) const {
        const int uidx = i * G + c; if (uidx >= ts[32] * ntn) return false;
        const int gmt = uidx / ntn, nt = uidx % ntn; int e = 0;
        for (int k = 1; k < 32; ++k) e += (ts[k] <= gmt) ? 1 : 0;
        const int mt = gmt - ts[e], cnt = cn[e];
        u.e = e; u.pm = mt; u.pn = nt; u.nrow = (cnt - 256 * mt < 256) ? cnt - 256 * mt : 256; u.rbase = 256 * gmt;
        u.Bb = W + (size_t)e * wexp + (size_t)nt * 256 * K * 2;
        if (gather) { u.Ab = A;
#pragma unroll
            for (int h = 0; h < 2; ++h)
#pragma unroll
                for (int p = 0; p < 2; ++p) { int r = 256 * mt + 128 * h + R[p]; r = (r < cnt) ? r : cnt - 1; const int tok = tokl[(size_t)e * NTOK + r]; u.ao[h * 2 + p] = (unsigned)(tok * K + C[p]) * 2u; }
        } else { u.Ab = A + (size_t)256 * gmt * K * 2; const unsigned hs = (unsigned)HALF * K * 2u;
            u.ao[0] = (unsigned)(R[0] * K + C[0]) * 2u; u.ao[1] = (unsigned)(R[1] * K + C[1]) * 2u; u.ao[2] = u.ao[0] + hs; u.ao[3] = u.ao[1] + hs; }
        return true;
    }
};

__device__ __forceinline__ float dot4(const f32x4 a, const f32x4 b) { return (a.x * b.x + a.y * b.y) + (a.z * b.z + a.w * b.w); }
__device__ __forceinline__ void p7_rows(Frame& F) {
    float* wg = (float*)F.lds;
    float* wch = (float*)(F.lds + 32768);
    int* cnt_l = (int*)(F.lds + LDS_MISC); int* base_l = cnt_l + 32; int* rowinfo = cnt_l + 64;
    float* roww = (float*)(cnt_l + 128);
    float* stat = (float*)(cnt_l + 192);
    const float* wrt = WSP(float, WS_WRT);
    const int r0 = F.vcu * 32, b = r0 / T;
    if (F.tid < 32) cnt_l[F.tid] = 0;
    for (int idx = F.tid; idx < 2048; idx += NTHR) *(f32x4*)(wg + idx * 4) = *(const f32x4*)(wrt + idx * 4);
    const float* modf = WSP(float, WS_MODF) + (size_t)b * 6 * D;
    const int rw0 = r0 + F.wave * 4;
#pragma unroll 1
    for (int i = 0; i < 4; ++i) {
        const int row = rw0 + i;
        const f32x4* vr = (const f32x4*)(WSP(float, WS_VPRE) + (size_t)row * D) + F.lane;
        f32x4 v[8]; float s = 0.f;
#pragma unroll
        for (int j = 0; j < 8; ++j) { v[j] = vr[64 * j]; s += (v[j].x + v[j].y) + (v[j].z + v[j].w); }
        float mean = wave_sum(s) * (1.f / D); float s2 = 0.f;
#pragma unroll
        for (int j = 0; j < 8; ++j) { v[j] = v[j] - mean; s2 += (v[j].x * v[j].x + v[j].y * v[j].y) + (v[j].z * v[j].z + v[j].w * v[j].w); }
        float rstd = rsqrtf(wave_sum(s2) * (1.f / D) + EPS);
        f32x4* x1r = (f32x4*)(WSP(float, WS_X1) + (size_t)row * D) + F.lane; s = 0.f;
#pragma unroll
        for (int j = 0; j < 8; ++j) { const int col = 4 * F.lane + 256 * j; v[j] = v[j] * rstd * *(const f32x4*)(F.g_ln1 + col) + *(const f32x4*)(F.b_ln1 + col); x1r[64 * j] = v[j]; s += (v[j].x + v[j].y) + (v[j].z + v[j].w); }
        mean = wave_sum(s) * (1.f / D); s2 = 0.f;
#pragma unroll
        for (int j = 0; j < 8; ++j) { const f32x4 d = v[j] - mean; s2 += (d.x * d.x + d.y * d.y) + (d.z * d.z + d.w * d.w); }
        rstd = rsqrtf(wave_sum(s2) * (1.f / D) + EPS);
        if (F.lane == 0) { stat[(F.wave * 4 + i) * 2] = mean; stat[(F.wave * 4 + i) * 2 + 1] = rstd; }
        u32x2* o8 = (u32x2*)(WSP(bf16_t, WS_U2) + (size_t)row * D) + F.lane;
#pragma unroll
        for (int j = 0; j < 8; ++j) { const int col = 4 * F.lane + 256 * j; const f32x4 y = (v[j] - mean) * rstd * (*(const f32x4*)(modf + 4 * D + col) + 1.f) + *(const f32x4*)(modf + 3 * D + col);
            u32x2 w; w.x = cvt_pk_bf16(y.x, y.y); w.y = cvt_pk_bf16(y.z, y.w); o8[64 * j] = w; }
    }
    __syncthreads();
    float mean2[4], rstd2[4];
#pragma unroll
    for (int i = 0; i < 4; ++i) { mean2[i] = stat[(F.wave * 4 + i) * 2]; rstd2[i] = stat[(F.wave * 4 + i) * 2 + 1]; }
    const float* x1w = WSP(float, WS_X1) + (size_t)rw0 * D + 4 * F.lane;
    float ag[4][4];
#pragma unroll
    for (int i = 0; i < 4; ++i)
#pragma unroll
        for (int o = 0; o < 4; ++o) ag[i][o] = 0.f;
#pragma unroll 1
    for (int j = 0; j < 8; ++j) { const int col = 4 * F.lane + 256 * j; const f32x4 sc = *(const f32x4*)(modf + 4 * D + col) + 1.f, sh = *(const f32x4*)(modf + 3 * D + col);
        f32x4 u[4];
#pragma unroll
        for (int i = 0; i < 4; ++i) u[i] = (*(const f32x4*)(x1w + (size_t)i * D + 256 * j) - mean2[i]) * rstd2[i] * sc + sh;
#pragma unroll
        for (int o = 0; o < 4; ++o) { const f32x4 w = *(const f32x4*)(wg + o * D + col);
#pragma unroll
            for (int i = 0; i < 4; ++i) ag[i][o] += dot4(u[i], w); } }
    int gtop[4]; float ptop[4];
#pragma unroll
    for (int i = 0; i < 4; ++i) { float lg[4];
#pragma unroll
        for (int o = 0; o < 4; ++o) lg[o] = wave_sum(ag[i][o]) + F.b_grp[o];
        int gt = 0; float mx = lg[0];
#pragma unroll
        for (int o = 1; o < 4; ++o) if (lg[o] > mx) { mx = lg[o]; gt = o; }
        float den = 0.f;
#pragma unroll
        for (int o = 0; o < 4; ++o) den += expf(lg[o] - mx);
        gtop[i] = __builtin_amdgcn_readfirstlane(gt); ptop[i] = 1.f / den; }
    float ae[4][8];
#pragma unroll
    for (int i = 0; i < 4; ++i)
#pragma unroll
        for (int e = 0; e < 8; ++e) ae[i][e] = 0.f;
#pragma unroll 1
    for (int j = 0; j < 8; ++j) {
        __syncthreads();
        for (int idx = F.tid; idx < 2048; idx += NTHR) { const int o = idx >> 6, c4 = idx & 63; *(f32x4*)(wch + o * 256 + c4 * 4) = *(const f32x4*)(wrt + (size_t)(4 + o) * D + 256 * j + c4 * 4); }
        __syncthreads();
        const int col = 4 * F.lane + 256 * j; const f32x4 sc = *(const f32x4*)(modf + 4 * D + col) + 1.f, sh = *(const f32x4*)(modf + 3 * D + col);
#pragma unroll
        for (int i = 0; i < 4; ++i) { const f32x4 u = (*(const f32x4*)(x1w + (size_t)i * D + 256 * j) - mean2[i]) * rstd2[i] * sc + sh;
#pragma unroll
            for (int e = 0; e < 8; ++e) { const f32x4 w = *(const f32x4*)(wch + (gtop[i] * 8 + e) * 256 + 4 * F.lane); ae[i][e] += dot4(u, w); } }
    }
#pragma unroll
    for (int i = 0; i < 4; ++i) { float le[8];
#pragma unroll
        for (int e = 0; e < 8; ++e) le[e] = wave_sum(ae[i][e]) + F.b_er[gtop[i] * 8 + e];
        int e0 = 0; float v0 = le[0];
#pragma unroll
        for (int e = 1; e < 8; ++e) if (le[e] > v0) { v0 = le[e]; e0 = e; }
        int e1 = -1; float v1 = -INFINITY;
#pragma unroll
        for (int e = 0; e < 8; ++e) if (e != e0 && le[e] > v1) { v1 = le[e]; e1 = e; }
        const float w0 = 1.f / (1.f + expf(v1 - v0));
        if (F.lane == 0) { const int rl = F.wave * 4 + i; const int E0 = gtop[i] * 8 + e0, E1 = gtop[i] * 8 + e1;
            const int s0 = atomicAdd(&cnt_l[E0], 1), s1 = atomicAdd(&cnt_l[E1], 1);
            rowinfo[rl * 2] = (E0 << 16) | s0; rowinfo[rl * 2 + 1] = (E1 << 16) | s1; roww[rl * 2] = w0 * ptop[i]; roww[rl * 2 + 1] = (1.f - w0) * ptop[i]; } }
    __syncthreads();
    if (F.tid < 32) { const int n = cnt_l[F.tid]; base_l[F.tid] = n ? (int)__hip_atomic_fetch_add(WSP(unsigned, WS_CTL) + CW_CNT + F.tid, (unsigned)n, __ATOMIC_RELAXED, __HIP_MEMORY_SCOPE_AGENT) : 0; }
    __syncthreads();
    if (F.tid < 64) { const int rl = F.tid >> 1, jj = F.tid & 1; const int info = rowinfo[rl * 2 + jj]; const int E = info >> 16, slot = base_l[E] + (info & 0xffff); const int tok = r0 + rl;
        WSP(int, WS_TOKL)[(size_t)E * NTOK + slot] = tok; WSP(float, WS_WL)[(size_t)E * NTOK + slot] = roww[rl * 2 + jj]; WSP(int, WS_PAIR)[tok * 2 + jj] = (E << 16) | slot; }
    __syncthreads();
}

__device__ __forceinline__ void p10_rows(Frame& F, const int* ts) {
    const int r0 = F.vcu * 32, b = r0 / T; const float* modf = WSP(float, WS_MODF) + (size_t)b * 6 * D;
#pragma unroll 1
    for (int i = 0; i < 4; ++i) {
        const int row = r0 + F.wave * 4 + i;
        const int i0 = WSP(int, WS_PAIR)[row * 2], i1 = WSP(int, WS_PAIR)[row * 2 + 1];
        const size_t ra = (size_t)ts[i0 >> 16] * 256 + (i0 & 0xffff), rb = (size_t)ts[i1 >> 16] * 256 + (i1 & 0xffff);
        const f32x4* xr = (const f32x4*)(WSP(float, WS_X1) + (size_t)row * D) + F.lane;
        const u32x2* ya = (const u32x2*)(WSP(bf16_t, WS_YPAIR) + ra * D) + F.lane; const u32x2* yb = (const u32x2*)(WSP(bf16_t, WS_YPAIR) + rb * D) + F.lane;
        f32x4 v[8]; float s = 0.f;
#pragma unroll
        for (int j = 0; j < 8; ++j) { const int col = 4 * F.lane + 256 * j; const u32x2 a = ya[64 * j], c = yb[64 * j];
            const f32x4 f = (f32x4){bf_lo(a.x) + bf_lo(c.x), bf_hi(a.x) + bf_hi(c.x), bf_lo(a.y) + bf_lo(c.y), bf_hi(a.y) + bf_hi(c.y)};
            v[j] = xr[64 * j] * ALPHA + (*(const f32x4*)(modf + 5 * D + col) + 1.f) * f; s += (v[j].x + v[j].y) + (v[j].z + v[j].w); }
        const float mean = wave_sum(s) * (1.f / D); float s2 = 0.f;
#pragma unroll
        for (int j = 0; j < 8; ++j) { v[j] = v[j] - mean; s2 += (v[j].x * v[j].x + v[j].y * v[j].y) + (v[j].z * v[j].z + v[j].w * v[j].w); }
        const float rstd = rsqrtf(wave_sum(s2) * (1.f / D) + EPS);
        f32x4* orow = (f32x4*)(F.out + (size_t)row * D) + F.lane;
#pragma unroll
        for (int j = 0; j < 8; ++j) { const int col = 4 * F.lane + 256 * j; orow[64 * j] = v[j] * rstd * *(const f32x4*)(F.g_ln2 + col) + *(const f32x4*)(F.b_ln2 + col); }
    }
}
struct Args { const void* in[26]; float* out; unsigned char* ws; int ph_lo, ph_hi; };
constexpr int NPHASE = 11;
__global__ void __launch_bounds__(NTHR, 2) mk_fwd(Args a) {
    extern __shared__ __attribute__((aligned(16))) unsigned char lds[];
    Frame F;
    F.lds = lds; F.tid = threadIdx.x; F.lane = F.tid & 63; F.wave = __builtin_amdgcn_readfirstlane(F.tid >> 6);
    F.G = gridDim.x; { const int bx = blockIdx.x; F.vcu = (F.G % 8 == 0) ? (bx % 8) * (F.G / 8) + bx / 8 : bx; }
    F.x = (const float*)a.in[0]; F.c = (const float*)a.in[1]; F.pos = (const int*)a.in[2]; F.w_cond = (const float*)a.in[3]; F.b_cond = (const float*)a.in[4];
    F.w_in = (const float*)a.in[5]; F.b_glu = (const float*)a.in[6]; F.w_dw = (const float*)a.in[7]; F.b_dw = (const float*)a.in[8]; F.g_cn = (const float*)a.in[9];
    F.b_cn = (const float*)a.in[10]; F.w_conv_out = (const float*)a.in[11]; F.b_conv_out = (const float*)a.in[12]; F.w_attn_out = (const float*)a.in[13];
    F.w_mix_out = (const float*)a.in[14]; F.g_ln1 = (const float*)a.in[15]; F.b_ln1 = (const float*)a.in[16]; F.w_grp = (const float*)a.in[17]; F.b_grp = (const float*)a.in[18];
    F.w_er = (const float*)a.in[19]; F.b_er = (const float*)a.in[20]; F.w1 = (const float*)a.in[21]; F.w3 = (const float*)a.in[22]; F.w2 = (const float*)a.in[23];
    F.g_ln2 = (const float*)a.in[24]; F.b_ln2 = (const float*)a.in[25]; F.out = a.out; F.ws = a.ws;
    const int lo = a.ph_lo, hi = a.ph_hi;
    volatile unsigned* xst = (volatile unsigned*)(lds + LDS_MISC + 16000);
    if (F.tid < 2) xst[F.tid] = 0u;
    __syncthreads();
    XcdBarrier xbar = xcd_barrier_post((unsigned*)(F.ws + WS_CTL) + CW_BAR, xst);
    if (lo < -1) cooperative_groups::this_grid().sync();
    LAS unsigned char* ring = (LAS unsigned char*)lds;
    int* ts = (int*)(lds + LDS_MISC + 12288); int* cn = ts + 40;
#ifndef ONLY_PHASE
#define ONLY_PHASE -1
#endif
#define IN(k) ((ONLY_PHASE == -1 || ONLY_PHASE == (k)) && lo <= (k) && (k) < hi)
#ifndef SYNC_REP
#define SYNC_REP 1
#endif
#define SEAM(k) do { if (IN(k) && IN((k) + 1)) { for (int sr_ = 0; sr_ < SYNC_REP; ++sr_) xcd_barrier(xbar); } } while (0)
#ifndef P3_REP
#define P3_REP 1
#endif
#ifndef P7_REP
#define P7_REP 1
#endif
#ifndef ATT_REP
#define ATT_REP 1
#endif
#ifndef REP_MASK
#define REP_MASK 0
#endif
#define RUNPH(k, ...) do { if (IN(k)) { { __VA_ARGS__ } if ((REP_MASK >> (k)) & 1) { __syncthreads(); { __VA_ARGS__ } } } } while (0)
    RUNPH(0, p0_prologue(F);); SEAM(0);
    RUNPH(1, p1_ln(F);); SEAM(1);
    RUNPH(2, DenseSched S; S.init(WSP(bf16_t, WS_U), WSP(bf16_t, WS_WIN), NTOK, INC, D, F.G, (int)blockIdx.x, F.tid);
        EpiIn E{F.b_glu, WSP(float, WS_ROPE), WSP(bf16_t, WS_HGLU), WSP(bf16_t, WS_Q), WSP(bf16_t, WS_K), WSP(bf16_t, WS_V), WSP(bf16_t, WS_SG)};
        gemm_phase<EpiIn, DenseSched, true, true>(ring, D, S, E);); SEAM(2);
    if (IN(3)) { _Pragma("unroll 1") for (int rr = 0; rr < P3_REP; ++rr) { p3_conv_unit(F, F.vcu); p3_kmean_unit(F, F.vcu); } } SEAM(3);
    RUNPH(4,
        { const int p = F.vcu, bh = p >> 4, s = (p >> 1) & 7, half = p & 1;
            _Pragma("unroll 1") for (int uu = 0; uu < 2 * ATT_REP; ++uu) att::attn_unit(F, ring, bh >> 3, bh & 7, (uu & 1) ? s : 15 - s, half); }
        int tidg = F.tid; asm volatile("" : "+v"(tidg));
        DenseSched S; S.init(WSP(bf16_t, WS_HC), WSP(bf16_t, WS_WCO), NTOK, D, CC, F.G, (int)blockIdx.x, tidg);
        EpiConvOut E{F.b_conv_out, WSP(bf16_t, WS_SG), WSP(bf16_t, WS_M1)};
        gemm_phase<EpiConvOut, DenseSched, true, true>(ring, CC, S, E);); SEAM(4);
    RUNPH(5, DenseSched S; S.init(WSP(bf16_t, WS_AO), WSP(bf16_t, WS_WAO), NTOK, D, AW, F.G, (int)blockIdx.x, F.tid);
        EpiAttnOut E{WSP(bf16_t, WS_SG), WSP(bf16_t, WS_M1), WSP(bf16_t, WS_MERGED)};
        gemm_phase<EpiAttnOut, DenseSched, true, true>(ring, AW, S, E);); SEAM(5);
    RUNPH(6, DenseSched S; S.init(WSP(bf16_t, WS_MERGED), WSP(bf16_t, WS_WMIX), NTOK, D, D, F.G, (int)blockIdx.x, F.tid);
        EpiMix E{F.x, WSP(float, WS_MODF), WSP(float, WS_VPRE)};
        gemm_phase<EpiMix, DenseSched, true, true>(ring, D, S, E);); SEAM(6);
    if (IN(7)) { p7_rows(F); } SEAM(7);
    RUNPH(8, moe_tables(F, ts, cn); MoeSched S; S.init(WSP(bf16_t, WS_U2), WSP(bf16_t, WS_W13), WSP(int, WS_TOKL), ts, cn, F.G, F.vcu, D, 4, true, F.tid);
        EpiMoeUp E{WSP(float, WS_WL), WSP(bf16_t, WS_HBUF)};
        gemm_phase<EpiMoeUp, MoeSched, true, true>(ring, D, S, E);); SEAM(8);
    RUNPH(9, moe_tables(F, ts, cn); MoeSched S; S.init(WSP(bf16_t, WS_HBUF), WSP(bf16_t, WS_W2), WSP(int, WS_TOKL), ts, cn, F.G, F.vcu, FF, 8, false, F.tid);
        EpiMoeDown E{WSP(bf16_t, WS_YPAIR)};
        gemm_phase<EpiMoeDown, MoeSched, true, true>(ring, FF, S, E);); SEAM(9);
    RUNPH(10, moe_tables(F, ts, cn); p10_rows(F, ts););
#undef RUNPH
#undef IN
#undef SEAM
}
}

static int mk_launch(void* const* d_in, float* out, void* d_ws, size_t ws_size, hipStream_t stream, int ph_lo, int ph_hi, bool memset_ctl) {
    static int ready = 0;
    if (ready == 0) {
        int dev = 0, cus = 0, per_cu = 0;
        if (hipGetDevice(&dev) != hipSuccess || hipDeviceGetAttribute(&cus, hipDeviceAttributeMultiprocessorCount, dev) != hipSuccess) { fprintf(stderr, "mk: device query failed\n"); ready = -1; return -1; }
        if (hipFuncSetAttribute((const void*)mk::mk_fwd, hipFuncAttributeMaxDynamicSharedMemorySize, mk::LDS_BYTES) != hipSuccess) { fprintf(stderr, "mk: hipFuncSetAttribute failed\n"); ready = -1; return -1; }
        if (hipOccupancyMaxActiveBlocksPerMultiprocessor(&per_cu, (const void*)mk::mk_fwd, mk::NTHR, mk::LDS_BYTES) != hipSuccess || per_cu < 1) { fprintf(stderr, "mk: occupancy query says %d blocks/CU\n", per_cu); ready = -1; return -1; }
        if (cus != 256 || ws_size < mk::WS_END) { fprintf(stderr, "mk: need 256 CUs (got %d) and ws >= %zu (got %zu)\n", cus, (size_t)mk::WS_END, ws_size); ready = -1; return -1; }
        (void)hipGetLastError();
        ready = 1;
    }
    if (ready < 0) return -1;
    if (memset_ctl) (void)hipMemsetAsync((char*)d_ws + mk::WS_CTL, 0, mk::CTL_ZERO_BYTES, stream);
    mk::Args a{};
    for (int i = 0; i < 26; ++i) a.in[i] = d_in[i];
    a.out = out; a.ws = (unsigned char*)d_ws; a.ph_lo = ph_lo; a.ph_hi = ph_hi;
    void* args[] = {&a};
    hipError_t e = hipLaunchCooperativeKernel((const void*)mk::mk_fwd, dim3(256), dim3(mk::NTHR), args, mk::LDS_BYTES, stream);
    if (e != hipSuccess) { fprintf(stderr, "mk: cooperative launch failed: %s\n", hipGetErrorString(e)); return -1; }
    return 0;
}
extern "C" void kernel_launch(void* const* d_in, const int* in_sizes, int n_in, void* d_out, int out_size, void* d_ws, size_t ws_size, hipStream_t stream) {
#if MK_PER_PHASE
    for (int p = 0; p < mk::NPHASE; ++p) mk_launch(d_in, (float*)d_out, d_ws, ws_size, stream, p, p + 1, p == 0);
#else
    mk_launch(d_in, (float*)d_out, d_ws, ws_size, stream, 0, mk::NPHASE, true);
#endif
}
```

```cpp
#include <hip/hip_runtime.h>
#include <hip/hip_cooperative_groups.h>
#include <cstdio>
#include <cstdint>
#define MK_PER_PHASE 0
namespace mk {
#define LAS __attribute__((address_space(3)))
#define GAS __attribute__((address_space(1)))
typedef unsigned short bf16_t;
typedef short bf16x8 __attribute__((ext_vector_type(8)));
typedef short s16x4 __attribute__((ext_vector_type(4)));
typedef float f32x4 __attribute__((ext_vector_type(4)));
typedef float f32x2 __attribute__((ext_vector_type(2)));
typedef float f32x16 __attribute__((ext_vector_type(16)));
typedef unsigned u32x4 __attribute__((ext_vector_type(4)));
typedef unsigned u32x2 __attribute__((ext_vector_type(2)));
typedef int v8i __attribute__((ext_vector_type(8)));
typedef unsigned u32x8 __attribute__((ext_vector_type(8)));

constexpr int D = 2048, NB = 2, T = 4096, NTOK = NB * T, CC = 1024, CW = 31, NH = 8, HD = 128, AW = 1024;
constexpr int INC = 9216, NEXP = 32, FF = 512, MB = 256, NBLK = T / MB;
constexpr float EPS = 1e-5f, ALPHA = 1.189207115002721f;
constexpr int NWAVES = 8, NTHR = 512;

typedef float f32x2_cv __attribute__((ext_vector_type(2)));
typedef __bf16 bf16x2_cv __attribute__((ext_vector_type(2)));
__device__ __forceinline__ unsigned cvt_pk_bf16(float lo, float hi) { const f32x2_cv v = {lo, hi}; return __builtin_bit_cast(unsigned, __builtin_convertvector(v, bf16x2_cv)); }
__device__ __forceinline__ unsigned cvt_pk_bf16_tr(float lo, float hi) { return cvt_pk_bf16(lo, hi); }
__device__ __forceinline__ unsigned pk4_fp8(float a, float b, float c, float d) { int w = __builtin_amdgcn_cvt_pk_fp8_f32(a, b, 0, false); w = __builtin_amdgcn_cvt_pk_fp8_f32(c, d, w, true); return (unsigned)w; }
__device__ __forceinline__ f32x4 f8x4(unsigned w) { return (f32x4){__builtin_amdgcn_cvt_f32_fp8((int)w, 0), __builtin_amdgcn_cvt_f32_fp8((int)w, 1), __builtin_amdgcn_cvt_f32_fp8((int)w, 2), __builtin_amdgcn_cvt_f32_fp8((int)w, 3)}; }
__device__ __forceinline__ float bf_lo(unsigned w) { return __uint_as_float(w << 16); }
__device__ __forceinline__ float bf_hi(unsigned w) { return __uint_as_float(w & 0xffff0000u); }
__device__ __forceinline__ float sigm(float v) { return __builtin_amdgcn_rcpf(1.f + __expf(-v)); }
__device__ __forceinline__ float silu(float v) { return v * __builtin_amdgcn_rcpf(1.f + __expf(-v)); }
template <int CTRL> __device__ __forceinline__ float dpp_mov(float v) { return __builtin_bit_cast(float, __builtin_amdgcn_update_dpp(0, __builtin_bit_cast(int, v), CTRL, 0xf, 0xf, true)); }
__device__ __forceinline__ float wave_sum(float v) {
    v += dpp_mov<0xB1>(v);
    v += dpp_mov<0x4E>(v);
    v += dpp_mov<0x141>(v);
    v += dpp_mov<0x140>(v);
    { float a = v, b = v; asm("s_nop 1\n\tv_permlane16_swap_b32 %0, %1" : "+v"(a), "+v"(b)); v = a + b; }
    { float a = v, b = v; asm("s_nop 1\n\tv_permlane32_swap_b32 %0, %1" : "+v"(a), "+v"(b)); v = a + b; }
    return v;
}

constexpr int BM = 256, BK = 64, HALF = 128, HTB = HALF * BK * 2, STAGE_BYTES = 8 * HTB, NXCD = 8, WGM = 8;
__host__ __device__ __forceinline__ int lds_byte(int r, int c) { const int st = (r >> 4) * 2 + (c >> 5), rr = r & 15, cc = c & 31, ob = rr * 64 + cc * 2; return st * 1024 + (ob ^ (((ob >> 9) & 1) << 5)); }
__host__ __device__ __forceinline__ void stage_rc(int b, int& R, int& C) { const int st = b / 1024, sb = b % 1024, swz = sb ^ (((sb >> 9) & 1) << 5); R = (st >> 1) * 16 + swz / 64; C = (st & 1) * 32 + (swz % 64) / 2; }
__host__ __device__ __forceinline__ int perm32(int rho) { const int n = rho >> 4, i = rho & 15; return 8 * (i >> 2) + 4 * n + (i & 3); }

struct Unit { const char* Ab; const char* Bb; unsigned ao[4]; int pm, pn, e, nrow, rbase; };

struct TileOrder {
    int nM, nN, nwg, G, c;
    __device__ void init(int nM_, int nN_, int G_, int c_) { nM = nM_; nN = nN_; nwg = nM * nN; G = G_; c = c_; }
    __device__ bool get(int i, int& pm, int& pn) const {
        const long L = (long)i * G + c; if (L >= nwg) return false;
        int wgid = (int)L; { const int q = nwg / NXCD, r = nwg % NXCD, xcd = wgid % NXCD, off = wgid / NXCD; wgid = (xcd < r ? xcd * (q + 1) : r * (q + 1) + (xcd - r) * q) + off; }
        const int nig = WGM * nN, gid = wgid / nig, fm = gid * WGM, gsz = (nM - fm) < WGM ? (nM - fm) : WGM;
        pm = fm + ((wgid % nig) % gsz); pn = (wgid % nig) / gsz; return true;
    }
};
template <bool F8> struct DenseSchedT {
    static constexpr bool HALFSKIP = false, FP8 = F8; static constexpr int SCALE_B = 0x79797979, ESZ = F8 ? 1 : 2;
    const char* A; const char* Bt; int K; TileOrder to; unsigned vo[2]; int nsplit, off0, off1, bsub; int hot = 0; int scale_a = 0x7f7f7f7f;
    __device__ void init(const void* A_, const void* Bt_, int M, int N, int K_, int G, int c, int tid, int nsplit_ = 1 << 30, int off0_ = 0, int off1_ = 0, int bsub_ = 0) {
        A = (const char*)A_; Bt = (const char*)Bt_; K = K_; to.init(M / BM, N / BM, G, c); nsplit = nsplit_; off0 = off0_; off1 = off1_; bsub = bsub_;
        for (int i = 0; i < 2; ++i) { int R, C; stage_rc(tid * 16 + i * 8192, R, C); vo[i] = (unsigned)(R * K * ESZ + C * 2); }
    }
    __device__ bool next(int i, Unit& u) const {
        int pm, pn; if (!to.get(i, pm, pn)) return false;
#ifdef HOT_PROBE
        if (hot) { if (i >= hot) return false; pm = 0; pn = 0; }
#endif
        pn += (pn < nsplit) ? off0 : off1;
        u.pm = pm; u.pn = pn; u.e = 0; u.nrow = 256; u.rbase = pm * 256;
        u.Ab = A + (size_t)pm * 256 * K * ESZ; u.Bb = Bt + (size_t)(pn - bsub) * 256 * K * ESZ;
        const unsigned hs = (unsigned)HALF * K * ESZ; u.ao[0] = vo[0]; u.ao[1] = vo[1]; u.ao[2] = vo[0] + hs; u.ao[3] = vo[1] + hs; return true;
    }
};
typedef DenseSchedT<false> DenseSched;

template <class Epi, class Sched, bool ALIGN_EPI, bool SP2>
__device__ __forceinline__ void gemm_phase(LAS unsigned char* lds, const int K, const Sched& S, const Epi& E, int tid_) {
    asm volatile("" : "+v"(tid_));
    const int tid = tid_, wid = __builtin_amdgcn_readfirstlane(tid >> 6), lane = tid & 63, wr = wid >> 2, wc = wid & 3, fr = lane & 15, fq = lane >> 4;
    constexpr bool F8 = Sched::FP8;
    const int rowb = F8 ? K : 2 * K;
    const int nt = rowb / 128;
    unsigned voffB[2];
#pragma unroll
    for (int i = 0; i < 2; ++i) { int R, C; stage_rc(tid * 16 + i * 8192, R, C); const int Rb = Epi::PERM ? ((R & ~31) + perm32(R & 31)) : R; voffB[i] = (unsigned)(Rb * rowb + C * 2); }
    const size_t kstep = (size_t)(BK * 2);
    const size_t hstep = (size_t)HALF * rowb;
    const unsigned ldsw = (unsigned)wid * 1024u;
    const int aoff = lds_byte(wr * 64 + fr, fq * 8), boff = lds_byte(wc * 32 + fr, fq * 8);
    const int c8 = 32 * (fq >> 1) + 16 * (fq & 1); const int aoff8 = lds_byte(wr * 64 + fr, c8), boff8 = lds_byte(wc * 32 + fr, c8);
    const int h16 = (fq & 1) << 4; const int aoff8a = aoff8 + h16, aoff8b = aoff8 + 16 - h16, boff8a = boff8 + h16, boff8b = boff8 + 16 - h16;
#define PG8_SA(b, h) (((b) * 2 + (h)) * HTB)
#define PG8_SB(b, h) ((4 + (b) * 2 + (h)) * HTB)
#define PG8_STAGE(bufoff, gbase, voff) do { _Pragma("unroll") for (int _i = 0; _i < 2; ++_i) { unsigned o_ = (voff)[_i]; asm volatile("" : "+v"(o_)); \
        __builtin_amdgcn_global_load_lds((const unsigned*)((const char*)(gbase) + o_), (LAS unsigned*)(lds + (bufoff) + ldsw + _i * 8192), 16, 0, 0); } } while (0)
#define PG8_STAGEA(bufoff, gbase, o0, o1) do { unsigned oa_ = (o0), ob_ = (o1); asm volatile("" : "+v"(oa_), "+v"(ob_)); \
        __builtin_amdgcn_global_load_lds((const unsigned*)((const char*)(gbase) + oa_), (LAS unsigned*)(lds + (bufoff) + ldsw), 16, 0, 0); \
        __builtin_amdgcn_global_load_lds((const unsigned*)((const char*)(gbase) + ob_), (LAS unsigned*)(lds + (bufoff) + ldsw + 8192), 16, 0, 0); } while (0)
#define PG8_LDA(dst, b, h) do { _Pragma("unroll") for (int m = 0; m < 4; ++m) _Pragma("unroll") for (int k = 0; k < 2; ++k) dst[m][k] = *(const LAS bf16x8*)(lds + PG8_SA(b, h) + aoff + m * 2048 + k * 1024); } while (0)
#define PG8_LDB(dst, b, h) do { _Pragma("unroll") for (int n = 0; n < 2; ++n) _Pragma("unroll") for (int k = 0; k < 2; ++k) dst[n][k] = *(const LAS bf16x8*)(lds + PG8_SB(b, h) + boff + n * 2048 + k * 1024); } while (0)
#define PG8_MMA(ai, bj, At, Bt) do { __builtin_amdgcn_s_setprio(1); _Pragma("unroll") for (int m = 0; m < 4; ++m) _Pragma("unroll") for (int n = 0; n < 2; ++n) _Pragma("unroll") for (int k = 0; k < 2; ++k) \
        acc[ai][bj][m][n] = __builtin_amdgcn_mfma_f32_16x16x32_bf16(Bt[n][k], At[m][k], acc[ai][bj][m][n], 0, 0, 0); __builtin_amdgcn_s_setprio(0); } while (0)
#define PG8_LD32(off, oa, ob) __builtin_shufflevector(*(const LAS u32x4*)(lds + (off) + (oa)), *(const LAS u32x4*)(lds + (off) + (ob)), 0, 1, 2, 3, 4, 5, 6, 7)
#define PG8_LDA8(dst, b, h) do { _Pragma("unroll") for (int m = 0; m < 4; ++m) dst[m] = PG8_LD32(PG8_SA(b, h) + m * 2048, aoff8a, aoff8b); } while (0)
#define PG8_LDB8(dst, b, h) do { _Pragma("unroll") for (int n = 0; n < 2; ++n) dst[n] = PG8_LD32(PG8_SB(b, h) + n * 2048, boff8a, boff8b); } while (0)
#define PG8_MMA8(ai, bj, At, Bt) do { __builtin_amdgcn_s_setprio(1); _Pragma("unroll") for (int m = 0; m < 4; ++m) _Pragma("unroll") for (int n = 0; n < 2; ++n) \
        asm volatile("v_mfma_scale_f32_16x16x128_f8f6f4 %0, %1, %2, %0, %3, %4 op_sel_hi:[0,0,0]" : "+v"(acc[ai][bj][m][n]) : "v"(Bt[n]), "v"(At[m]), "v"(scl_b), "v"(scl_a)); \
        __builtin_amdgcn_s_setprio(0); } while (0)
#define PG8_WAIT_V(n) asm volatile("s_waitcnt vmcnt(" #n ")" ::: "memory")
#define PG8_WAIT_L(n) asm volatile("s_waitcnt lgkmcnt(" #n ")" ::: "memory")
#define PG8_BAR __builtin_amdgcn_s_barrier()
#define PG8_SCHED __builtin_amdgcn_sched_barrier(0)
    Unit cur, nxt; int ui = 0;
    if (!S.next(0, cur)) return;
    f32x4 acc[2][2][4][2];
    bf16x8 At[4][2], B0[2][2], B1[2][2];
    u32x8 At8[4], B08[2], B18[2];
    int scl_a = S.scale_a, scl_b = Sched::SCALE_B; asm volatile("" : "+v"(scl_a), "+v"(scl_b));
    const char* cA = cur.Ab; const char* cB = cur.Bb;
    if constexpr (SP2) {
        PG8_STAGE(PG8_SB(0, 0), cB, voffB); PG8_STAGE(PG8_SB(0, 1), cB + hstep, voffB); PG8_STAGEA(PG8_SA(0, 0), cA, cur.ao[0], cur.ao[1]); PG8_STAGEA(PG8_SA(0, 1), cA, cur.ao[2], cur.ao[3]);
        if (wr == 1) PG8_BAR;
        PG8_WAIT_V(2); PG8_BAR;
        PG8_STAGE(PG8_SB(1, 0), cB + kstep, voffB); PG8_STAGEA(PG8_SA(1, 0), cA + kstep, cur.ao[0], cur.ao[1]); PG8_STAGE(PG8_SB(1, 1), cB + hstep + kstep, voffB);
        PG8_WAIT_V(6); PG8_BAR;
    } else {
        PG8_STAGE(PG8_SB(0, 0), cB, voffB); PG8_STAGEA(PG8_SA(0, 0), cA, cur.ao[0], cur.ao[1]); PG8_STAGE(PG8_SB(0, 1), cB + hstep, voffB); PG8_STAGEA(PG8_SA(0, 1), cA, cur.ao[2], cur.ao[3]);
        if (wr == 1) PG8_BAR;
        PG8_WAIT_V(4); PG8_BAR;
        PG8_STAGE(PG8_SB(1, 0), cB + kstep, voffB); PG8_STAGEA(PG8_SA(1, 0), cA + kstep, cur.ao[0], cur.ao[1]); PG8_STAGE(PG8_SB(1, 1), cB + hstep + kstep, voffB);
        PG8_WAIT_V(6); PG8_BAR;
    }
#pragma unroll
    for (int a = 0; a < 2; ++a)
#pragma unroll
        for (int b = 0; b < 2; ++b)
#pragma unroll
            for (int m = 0; m < 4; ++m)
#pragma unroll
                for (int n = 0; n < 2; ++n) acc[a][b][m][n] = (f32x4){0.f, 0.f, 0.f, 0.f};
    for (;;) {
        const bool has_next = S.next(ui + 1, nxt);
        if (!has_next) nxt = cur;
        const char* nA = nxt.Ab; const char* nB = nxt.Bb;
        const bool full = Sched::HALFSKIP ? (cur.nrow > 128) : true;
        for (int t = 0; t < nt; t += 2) {
            const bool last = (t == nt - 2);
            const char* a1 = cA + (size_t)(t + 1) * kstep;
            const char* a2 = last ? nA : cA + (size_t)(t + 2) * kstep; const char* b2 = last ? nB : cB + (size_t)(t + 2) * kstep;
            const char* a3 = a2 + kstep; const char* b3 = b2 + kstep;
            const unsigned o0 = last ? nxt.ao[0] : cur.ao[0], o1 = last ? nxt.ao[1] : cur.ao[1], o2 = last ? nxt.ao[2] : cur.ao[2], o3 = last ? nxt.ao[3] : cur.ao[3];
            if constexpr (SP2 && F8) {
            PG8_LDB8(B08, 0, 0); PG8_LDB8(B18, 0, 1); PG8_SCHED; PG8_LDA8(At8, 0, 0); PG8_STAGEA(PG8_SA(1, 1), a1, cur.ao[2], cur.ao[3]);
            PG8_WAIT_V(8); PG8_WAIT_L(0); PG8_BAR; PG8_MMA8(0, 0, At8, B08); PG8_MMA8(0, 1, At8, B18); PG8_BAR; PG8_SCHED;
            PG8_LDA8(At8, 0, 1); PG8_STAGE(PG8_SB(0, 0), b2, voffB); PG8_STAGE(PG8_SB(0, 1), b2 + hstep, voffB); PG8_STAGEA(PG8_SA(0, 0), a2, o0, o1);
            PG8_WAIT_V(8); PG8_WAIT_L(0); PG8_BAR; PG8_MMA8(1, 0, At8, B08); PG8_MMA8(1, 1, At8, B18); PG8_BAR; PG8_SCHED;
            PG8_LDB8(B08, 1, 0); PG8_LDB8(B18, 1, 1); PG8_SCHED; PG8_LDA8(At8, 1, 0); PG8_STAGEA(PG8_SA(0, 1), a2, o2, o3);
            PG8_WAIT_V(8); PG8_WAIT_L(0); PG8_BAR; PG8_MMA8(0, 0, At8, B08); PG8_MMA8(0, 1, At8, B18); PG8_BAR; PG8_SCHED;
            PG8_LDA8(At8, 1, 1); PG8_STAGE(PG8_SB(1, 0), b3, voffB); PG8_STAGE(PG8_SB(1, 1), b3 + hstep, voffB); PG8_STAGEA(PG8_SA(1, 0), a3, o0, o1);
            PG8_WAIT_V(8); PG8_WAIT_L(0); PG8_BAR; PG8_MMA8(1, 0, At8, B08); PG8_MMA8(1, 1, At8, B18); PG8_BAR; PG8_SCHED;
            } else if constexpr (SP2) {
            PG8_LDB(B0, 0, 0); PG8_LDB(B1, 0, 1); PG8_SCHED; PG8_LDA(At, 0, 0); PG8_STAGEA(PG8_SA(1, 1), a1, cur.ao[2], cur.ao[3]);
            PG8_WAIT_V(8); PG8_WAIT_L(0); PG8_BAR; PG8_MMA(0, 0, At, B0); PG8_MMA(0, 1, At, B1); PG8_BAR; PG8_SCHED;
            PG8_LDA(At, 0, 1); PG8_STAGE(PG8_SB(0, 0), b2, voffB); PG8_STAGE(PG8_SB(0, 1), b2 + hstep, voffB); PG8_STAGEA(PG8_SA(0, 0), a2, o0, o1);
            PG8_WAIT_V(8); PG8_WAIT_L(0); PG8_BAR; if (full) { PG8_MMA(1, 0, At, B0); PG8_MMA(1, 1, At, B1); } PG8_BAR; PG8_SCHED;
            PG8_LDB(B0, 1, 0); PG8_LDB(B1, 1, 1); PG8_SCHED; PG8_LDA(At, 1, 0); PG8_STAGEA(PG8_SA(0, 1), a2, o2, o3);
            PG8_WAIT_V(8); PG8_WAIT_L(0); PG8_BAR; PG8_MMA(0, 0, At, B0); PG8_MMA(0, 1, At, B1); PG8_BAR; PG8_SCHED;
            PG8_LDA(At, 1, 1); PG8_STAGE(PG8_SB(1, 0), b3, voffB); PG8_STAGE(PG8_SB(1, 1), b3 + hstep, voffB); PG8_STAGEA(PG8_SA(1, 0), a3, o0, o1);
            PG8_WAIT_V(8); PG8_WAIT_L(0); PG8_BAR; if (full) { PG8_MMA(1, 0, At, B0); PG8_MMA(1, 1, At, B1); } PG8_BAR; PG8_SCHED;
            } else {
            PG8_LDB(B0, 0, 0); PG8_SCHED; PG8_LDA(At, 0, 0); PG8_STAGEA(PG8_SA(1, 1), a1, cur.ao[2], cur.ao[3]);
            PG8_WAIT_L(8); PG8_BAR; PG8_WAIT_L(0); PG8_MMA(0, 0, At, B0); PG8_BAR; PG8_SCHED;
            PG8_LDB(B1, 0, 1); PG8_STAGE(PG8_SB(0, 0), b2, voffB);
            PG8_BAR; PG8_WAIT_L(0); PG8_MMA(0, 1, At, B1); PG8_BAR;
            PG8_LDA(At, 0, 1); PG8_STAGEA(PG8_SA(0, 0), a2, o0, o1);
            PG8_BAR; PG8_WAIT_L(0); PG8_MMA(1, 0, At, B0); PG8_BAR; PG8_SCHED;
            PG8_STAGE(PG8_SB(0, 1), b2 + hstep, voffB);
            PG8_WAIT_V(6); PG8_BAR; PG8_MMA(1, 1, At, B1); PG8_BAR;
            PG8_LDB(B0, 1, 0); PG8_SCHED; PG8_LDA(At, 1, 0); PG8_STAGEA(PG8_SA(0, 1), a2, o2, o3);
            PG8_WAIT_L(8); PG8_BAR; PG8_WAIT_L(0); PG8_MMA(0, 0, At, B0); PG8_BAR; PG8_SCHED;
            PG8_LDB(B1, 1, 1); PG8_STAGE(PG8_SB(1, 0), b3, voffB);
            PG8_BAR; PG8_WAIT_L(0); PG8_MMA(0, 1, At, B1); PG8_BAR;
            PG8_LDA(At, 1, 1); PG8_STAGEA(PG8_SA(1, 0), a3, o0, o1);
            PG8_BAR; PG8_WAIT_L(0); PG8_MMA(1, 0, At, B0); PG8_BAR; PG8_SCHED;
            PG8_STAGE(PG8_SB(1, 1), b3 + hstep, voffB);
            PG8_WAIT_V(6); PG8_BAR; PG8_MMA(1, 1, At, B1); PG8_BAR;
            }
        }
        if constexpr (ALIGN_EPI) { if (wr == 0) PG8_BAR; }
        E(acc, cur, wr, wc, fr, fq);
        if (!has_next) break;
#pragma unroll
        for (int a = 0; a < 2; ++a)
#pragma unroll
            for (int b = 0; b < 2; ++b)
#pragma unroll
                for (int m = 0; m < 4; ++m)
#pragma unroll
                    for (int n = 0; n < 2; ++n) acc[a][b][m][n] = (f32x4){0.f, 0.f, 0.f, 0.f};
        cur = nxt; cA = nA; cB = nB; ++ui;
        if constexpr (ALIGN_EPI) { if (wr == 1) PG8_BAR; }
    }
    PG8_WAIT_V(0);
    if constexpr (!ALIGN_EPI) { if (wr == 0) PG8_BAR; }
    PG8_BAR;
#undef PG8_SA
#undef PG8_SB
#undef PG8_STAGE
#undef PG8_STAGEA
#undef PG8_LDA
#undef PG8_LDB
#undef PG8_LD32
#undef PG8_LDA8
#undef PG8_LDB8
#undef PG8_MMA8
#undef PG8_MMA
#undef PG8_WAIT_V
#undef PG8_WAIT_L
#undef PG8_BAR
#undef PG8_SCHED
}
constexpr size_t MiB = 1u << 20;
constexpr size_t WS_CTL = 0, CTL_ZERO_BYTES = 1 * MiB;
constexpr size_t WS_MODPART = 1 * MiB, WS_MODF = 3 * MiB, WS_ROPE = 4 * MiB, WS_WRT = 5 * MiB, WS_KMEAN = 6 * MiB, WS_TOKL = 7 * MiB, WS_WL = 8 * MiB, WS_PAIR = 9 * MiB;
constexpr size_t WS_WIN = 16 * MiB, WS_WCO = 52 * MiB, WS_WAO = 56 * MiB, WS_WMIX = 60 * MiB, WS_W13 = 68 * MiB, WS_W2 = 196 * MiB;
constexpr size_t WS_R1 = 260 * MiB, WS_U = WS_R1, WS_HGLU = WS_R1 + 32 * MiB, WS_Q = WS_R1 + 48 * MiB, WS_K = WS_R1 + 64 * MiB, WS_V = WS_R1 + 80 * MiB, WS_YPAIR = WS_R1;
constexpr size_t WS_R2 = 356 * MiB, WS_SG = WS_R2, WS_VPRE = WS_R2, WS_HBUF = WS_R2;
constexpr size_t WS_R3 = 420 * MiB, WS_M1 = WS_R3, WS_MERGED = WS_R3 + 32 * MiB, WS_X1 = WS_R3;
constexpr size_t WS_R4 = 484 * MiB, WS_HC = WS_R4, WS_AO = WS_R4 + 16 * MiB, WS_U2 = WS_R4;
constexpr size_t WS_U8 = WS_R3;
constexpr size_t WS_WIN8 = WS_WIN + (size_t)2048 * 4096;
constexpr size_t WS_END = 516 * MiB;
constexpr int CW_CNT = 64;
constexpr int MODKC = 16;
constexpr int HB_ROWS = 24576;

#ifndef GATES_FP8
#define GATES_FP8 1
#endif
#ifndef MIX_FP8
#define MIX_FP8 1
#endif
#ifndef CONVOUT_FP8
#define CONVOUT_FP8 1
#endif
#ifndef GLU_FP8
#define GLU_FP8 1
#endif
#ifndef MOE_DOWN_FP8
#define MOE_DOWN_FP8 1
#endif
constexpr int RING_BYTES = 131072, LDS_MISC = RING_BYTES, LDS_BYTES = 147456;


#define XB_TMO      128
#define XB_XCNT(j)  (256  + 64 * (j))
#define XB_XSUB(j)  (1280 + 64 * (j))
#define XB_XGEN(j)  (2304 + 64 * (j))
#define XB_TOP      3328
#define XB_TOPGEN   3392
#define XCD_BAR_WORDS 3456
#define XB_SPIN_CAP (1u << 18)
constexpr int CW_BAR = 4096;
__device__ __forceinline__ unsigned xb_ld(unsigned* p)              { return __hip_atomic_load(p, __ATOMIC_RELAXED, __HIP_MEMORY_SCOPE_AGENT); }
__device__ __forceinline__ unsigned xb_add(unsigned* p, unsigned v) { return __hip_atomic_fetch_add(p, v, __ATOMIC_RELAXED, __HIP_MEMORY_SCOPE_AGENT); }
__device__ __forceinline__ unsigned xb_xcc_id() { return (unsigned)__builtin_amdgcn_s_getreg((3 << 11) | 20) & 0xFu; }
#define XB_SPIN(cond, bar) do { unsigned _sp = 0; while (cond) { __builtin_amdgcn_s_sleep(1); \
    if ((++_sp & 255u) == 0u) { if (xb_ld(&(bar)[XB_TMO])) break; if (_sp > XB_SPIN_CAP) { atomicAdd(&(bar)[XB_TMO], 1u); break; } } } } while (0)
struct XcdBarrier { unsigned* bar; unsigned x; volatile unsigned* st; };
__device__ __forceinline__ XcdBarrier xcd_barrier_post(unsigned* bar, volatile unsigned* st, const bool leader) {
    XcdBarrier b; b.bar = bar; b.x = xb_xcc_id(); b.st = st;
    if (leader) (void)xb_add(&bar[XB_XCNT(b.x)], 1u);
    return b;
}
__device__ __forceinline__ void xcd_barrier_complete(unsigned* bar, unsigned x, unsigned& nloc, unsigned& nx) {
    const unsigned G = gridDim.x * gridDim.y * gridDim.z;
    unsigned sum, cnt, mine, sp = 0u;
    for (;;) {
        sum = 0u; cnt = 0u; mine = 0u;
#pragma unroll
        for (unsigned j = 0; j < 16; ++j) { const unsigned c = xb_ld(&bar[XB_XCNT(j)]); sum += c; cnt += (c > 0u) ? 1u : 0u; mine = (j == x) ? c : mine; }
        if (sum == G) break;
        __builtin_amdgcn_s_sleep(1);
        if ((++sp & 255u) == 0u) { if (xb_ld(&bar[XB_TMO])) break; if (sp > XB_SPIN_CAP) { atomicAdd(&bar[XB_TMO], 1u); break; } }
    }
    nloc = mine > 0u ? mine : 1u; nx = cnt > 0u ? cnt : 1u;
}
#ifndef FLAT_WAIT
#define FLAT_WAIT 1
#endif
__device__ __forceinline__ void xcd_barrier(const XcdBarrier& b, const bool leader) {
    asm volatile("s_waitcnt vmcnt(0)" ::: "memory");
    __syncthreads();
    if (leader) {
        unsigned* bar = b.bar;
        __builtin_amdgcn_s_waitcnt(0);
        unsigned nloc = b.st[0], nx = b.st[1];
        if (nloc == 0u) { xcd_barrier_complete(bar, b.x, nloc, nx); b.st[0] = nloc; b.st[1] = nx; }
#if FLAT_WAIT
        const unsigned old = xb_add(&bar[XB_XSUB(b.x)], 1u);
        const unsigned gen = old / nloc;
        if (old + 1u == (gen + 1u) * nloc) {
            __builtin_amdgcn_fence(__ATOMIC_RELEASE, "agent");
            asm volatile("s_waitcnt vmcnt(0)" ::: "memory");
            (void)xb_add(&bar[XB_TOP], 1u);
        }
        const unsigned target = (gen + 1u) * nx;
        XB_SPIN(xb_ld(&bar[XB_TOP]) < target, bar);
        __builtin_amdgcn_fence(__ATOMIC_ACQUIRE, "agent");
        asm volatile("s_waitcnt vmcnt(0)" ::: "memory");
#else
        const unsigned old = xb_add(&bar[XB_XSUB(b.x)], 1u);
        const unsigned gen = old / nloc;
        if (old + 1u == (gen + 1u) * nloc) {
            __builtin_amdgcn_fence(__ATOMIC_RELEASE, "agent");
            asm volatile("s_waitcnt vmcnt(0)" ::: "memory");
            const unsigned og = xb_add(&bar[XB_TOP], 1u);
            const unsigned tg = og / nx;
            if (og + 1u == (tg + 1u) * nx) xb_add(&bar[XB_TOPGEN], 1u);
            else XB_SPIN(xb_ld(&bar[XB_TOPGEN]) == tg, bar);
            __builtin_amdgcn_fence(__ATOMIC_ACQUIRE, "agent");
            xb_add(&bar[XB_XGEN(b.x)], 1u);
            asm volatile("s_waitcnt vmcnt(0)" ::: "memory");
        } else {
            XB_SPIN(xb_ld(&bar[XB_XGEN(b.x)]) == gen, bar);
            __builtin_amdgcn_fence(__ATOMIC_ACQUIRE, "agent");
            asm volatile("s_waitcnt vmcnt(0)" ::: "memory");
        }
#endif
    }
    __syncthreads();
}

struct Frame {
    unsigned char* lds; int tid, lane, wave, vcu, G;
    const float *x, *c, *w_cond, *b_cond, *w_in, *b_glu, *w_dw, *b_dw, *g_cn, *b_cn, *w_conv_out, *b_conv_out, *w_attn_out, *w_mix_out, *g_ln1, *b_ln1,
                *w_grp, *b_grp, *w_er, *b_er, *w1, *w3, *w2, *g_ln2, *b_ln2;
    const int* pos; float* out; unsigned char* ws;
};
#define WSP(T, off) ((T*)(F.ws + (off)))

__device__ __forceinline__ unsigned f2bf(float f) { unsigned u = __builtin_bit_cast(unsigned, f); return (u + 0x7fffu + ((u >> 16) & 1u)) >> 16; }
__device__ __forceinline__ unsigned pk2(float lo, float hi) { return f2bf(lo) | (f2bf(hi) << 16); }
__device__ __forceinline__ void transpose_item(const float* W, int K, int N, bf16_t* WT, int k0, int n0, int drow0, float* scr, int lane) {
    {
        f32x4 v[8]; const int rr = lane >> 3, c4 = (lane & 7) * 4;
#pragma unroll
        for (int i = 0; i < 8; ++i) v[i] = __builtin_nontemporal_load((const f32x4*)(W + (size_t)(k0 + 8 * i + rr) * N + n0 + c4));
#pragma unroll
        for (int i = 0; i < 8; ++i) { float* d = scr + (8 * i + rr) * 33 + c4; d[0] = v[i].x; d[1] = v[i].y; d[2] = v[i].z; d[3] = v[i].w; }
    }
    asm volatile("s_waitcnt lgkmcnt(0)" ::: "memory");
    const int cch = lane & 7;
#pragma unroll
    for (int j = 0; j < 4; ++j) { const int n = (lane >> 3) + 8 * j; const float* s = scr + (8 * cch) * 33 + n;
        u32x4 o; o.x = pk2(s[0 * 33], s[1 * 33]); o.y = pk2(s[2 * 33], s[3 * 33]); o.z = pk2(s[4 * 33], s[5 * 33]); o.w = pk2(s[6 * 33], s[7 * 33]);
        *(u32x4*)(WT + (size_t)(drow0 + n) * K + k0 + 8 * cch) = o; }
    asm volatile("s_waitcnt lgkmcnt(0)" ::: "memory");
}
template <bool NT = false> __device__ __forceinline__ void transpose_item8(const float* W, int K, int N, unsigned char* WT, int k0, int n0, int drow0, float* scr, int lane) {
    {
        f32x4 v[8]; const int rr = lane >> 3, c4 = (lane & 7) * 4;
#pragma unroll
        for (int i = 0; i < 8; ++i) v[i] = __builtin_nontemporal_load((const f32x4*)(W + (size_t)(k0 + 8 * i + rr) * N + n0 + c4));
#pragma unroll
        for (int i = 0; i < 8; ++i) { float* d = scr + (8 * i + rr) * 33 + c4; d[0] = v[i].x; d[1] = v[i].y; d[2] = v[i].z; d[3] = v[i].w; }
    }
    asm volatile("s_waitcnt lgkmcnt(0)" ::: "memory");
    const int cch = lane & 7;
#pragma unroll
    for (int j = 0; j < 4; ++j) { const int n = (lane >> 3) + 8 * j; const float* s = scr + (8 * cch) * 33 + n;
        u32x2 o; o.x = pk4_fp8(s[0 * 33] * 64.f, s[1 * 33] * 64.f, s[2 * 33] * 64.f, s[3 * 33] * 64.f); o.y = pk4_fp8(s[4 * 33] * 64.f, s[5 * 33] * 64.f, s[6 * 33] * 64.f, s[7 * 33] * 64.f);
        if (NT) __builtin_nontemporal_store(o, (u32x2*)(WT + (size_t)(drow0 + n) * K + k0 + 8 * cch)); else *(u32x2*)(WT + (size_t)(drow0 + n) * K + k0 + 8 * cch) = o; }
    asm volatile("s_waitcnt lgkmcnt(0)" ::: "memory");
}
__device__ __forceinline__ int glu_rowmap(int n0, int half) { return (n0 >> 7) * 256 + half * 128 + (n0 & 127); }
constexpr int I_IN = (D / 64) * (INC / 32), I_CO = (CC / 64) * (D / 32), I_AO = (AW / 64) * (D / 32), I_MIX = (D / 64) * (D / 32);
constexpr int I_W1E = (D / 64) * (FF / 32), I_W2E = (FF / 64) * (D / 32);
constexpr int I_DENSE = I_IN + I_CO + I_AO + I_MIX, I_W13 = NEXP * 2 * I_W1E, I_W2 = NEXP * I_W2E;
#ifndef N_W13_P0
#define N_W13_P0 23552
#endif
#ifndef N_W2_P0
#define N_W2_P0 0
#endif
__device__ __forceinline__ void transpose_dense(Frame& F, int r, float* scr) {
    if (r < I_IN) { const int nblk = INC / 32, kb = r / nblk, nb = r % nblk, n0 = nb * 32; int dr = n0; if (n0 < 1024) dr = glu_rowmap(n0, 0); else if (n0 < 2048) dr = glu_rowmap(n0 - 1024, 1);
        if (GLU_FP8) transpose_item8(F.w_in, D, INC, WSP(unsigned char, WS_WIN), kb * 64, n0, dr, scr, F.lane);
        else if (n0 >= 2048 && (GATES_FP8 || n0 < 5120)) transpose_item8(F.w_in, D, INC, WSP(unsigned char, WS_WIN8), kb * 64, n0, n0 - 2048, scr, F.lane);
        else transpose_item(F.w_in, D, INC, WSP(bf16_t, WS_WIN), kb * 64, n0, dr, scr, F.lane);
        return; } r -= I_IN;
    if (r < I_CO) { const int nblk = D / 32, kb = r / nblk, nb = r % nblk;
        if (CONVOUT_FP8) transpose_item8(F.w_conv_out, CC, D, WSP(unsigned char, WS_WCO), kb * 64, nb * 32, nb * 32, scr, F.lane);
        else transpose_item(F.w_conv_out, CC, D, WSP(bf16_t, WS_WCO), kb * 64, nb * 32, nb * 32, scr, F.lane);
        return; } r -= I_CO;
    if (r < I_AO) { const int nblk = D / 32, kb = r / nblk, nb = r % nblk; transpose_item8(F.w_attn_out, AW, D, WSP(unsigned char, WS_WAO), kb * 64, nb * 32, nb * 32, scr, F.lane); return; } r -= I_AO;
    { const int nblk = D / 32, kb = r / nblk, nb = r % nblk;
      if (MIX_FP8) transpose_item8(F.w_mix_out, D, D, WSP(unsigned char, WS_WMIX), kb * 64, nb * 32, nb * 32, scr, F.lane);
      else transpose_item(F.w_mix_out, D, D, WSP(bf16_t, WS_WMIX), kb * 64, nb * 32, nb * 32, scr, F.lane); }
}
__device__ __forceinline__ void transpose_w13(Frame& F, int r, float* scr) {
    const int e = r / (2 * I_W1E); r -= e * (2 * I_W1E); const int which = r / I_W1E; r -= which * I_W1E; const int nblk = FF / 32, kb = r / nblk, nb = r % nblk, n0 = nb * 32;
    transpose_item8<true>((which ? F.w3 : F.w1) + (size_t)e * D * FF, D, FF, WSP(unsigned char, WS_W13) + (size_t)e * 1024 * D, kb * 64, n0, glu_rowmap(n0, which), scr, F.lane);
}
__device__ __forceinline__ void transpose_w2(Frame& F, int r, float* scr) {
    const int e = r / I_W2E; r -= e * I_W2E; const int nblk = D / 32, kb = r / nblk, nb = r % nblk;
#if MOE_DOWN_FP8
    transpose_item8(F.w2 + (size_t)e * FF * D, FF, D, WSP(unsigned char, WS_W2) + (size_t)e * D * FF, kb * 64, nb * 32, nb * 32, scr, F.lane);
#else
    transpose_item(F.w2 + (size_t)e * FF * D, FF, D, WSP(bf16_t, WS_W2) + (size_t)e * D * FF, kb * 64, nb * 32, nb * 32, scr, F.lane);
#endif
}
__device__ __forceinline__ void p2_tail_transposes(Frame& F) {
    if (blockIdx.x < 128) return;
    float* scr = (float*)(F.lds + F.wave * 8704);
    const int gw2 = ((int)blockIdx.x - 128) * NWAVES + F.wave;
    for (int it = N_W13_P0 + gw2; it < I_W13; it += 128 * NWAVES) transpose_w13(F, it, scr);
}
__device__ __forceinline__ void p8_tail_transposes(Frame& F, int U, int c) {
    const int rem = U & 255; int nset, idx;
    if (rem == 0 || rem > 192) { nset = 256; idx = c; } else { if (c < rem) return; nset = 256 - rem; idx = c - rem; }
    float* scr = (float*)(F.lds + F.wave * 8704);
    for (int it = N_W2_P0 + idx * NWAVES + F.wave; it < I_W2; it += nset * NWAVES) transpose_w2(F, it, scr);
}
__device__ __forceinline__ void p0_prologue(Frame& F) {
    float* ssilu = (float*)F.lds;
    for (int i = F.tid; i < 2 * D; i += NTHR) ssilu[i] = silu(F.c[i]);
    __syncthreads();
    float* scr = (float*)(F.lds + 16384 + F.wave * 8704);
    const int gw = F.vcu * NWAVES + F.wave, NGW = F.G * NWAVES;
    for (int it = gw; it < 192 * MODKC; it += NGW) {
        const int cg = it % 192, kc = it / 192; const int col = cg * 64 + F.lane; float a0 = 0.f, a1 = 0.f;
        const float* wp = F.w_cond + (size_t)(kc * 128) * (6 * D) + col;
#pragma unroll 16
        for (int k = 0; k < 128; ++k) { const float w = __builtin_nontemporal_load(wp + (size_t)k * (6 * D)); a0 += ssilu[kc * 128 + k] * w; a1 += ssilu[D + kc * 128 + k] * w; }
        float* part = WSP(float, WS_MODPART);
        part[(size_t)(kc * 2 + 0) * (6 * D) + col] = a0; part[(size_t)(kc * 2 + 1) * (6 * D) + col] = a1;
    }
    for (int it = gw; it < I_DENSE + N_W13_P0 + N_W2_P0; it += NGW) { if (it < I_DENSE) transpose_dense(F, it, scr); else if (it < I_DENSE + N_W13_P0) transpose_w13(F, it - I_DENSE, scr); else transpose_w2(F, it - I_DENSE - N_W13_P0, scr); }
    for (int idx = gw * 64 + F.lane; idx < NTOK * 16; idx += NGW * 64) { const int row = idx >> 4, f = idx & 15;
        const float inv = powf(500000.f, -(float)f / 16.f); const float ang = (float)F.pos[row] * inv; float sn, cs; sincosf(ang, &sn, &cs);
        float* rp = WSP(float, WS_ROPE); rp[row * 32 + f] = cs; rp[row * 32 + 16 + f] = sn; }
    for (int idx = gw * 64 + F.lane; idx < 36 * D; idx += NGW * 64) { const int o = idx / D, k = idx % D;
        WSP(float, WS_WRT)[idx] = (o < 4) ? F.w_grp[k * 4 + o] : F.w_er[k * 32 + (o - 4)]; }
}

__device__ __forceinline__ void p1_ln(Frame& F) {
    float* sm = (float*)F.lds;
    const int r0 = F.vcu * 32, b = r0 / T;
    const float* part = WSP(float, WS_MODPART);
    {
        float v[8];
#pragma unroll
        for (int q = 0; q < 8; ++q) v[q] = F.b_cond[F.tid + 512 * q];
#pragma unroll
        for (int kc = 0; kc < MODKC; ++kc)
#pragma unroll
            for (int q = 0; q < 8; ++q) v[q] += part[(size_t)(kc * 2 + b) * (6 * D) + F.tid + 512 * q];
#pragma unroll
        for (int q = 0; q < 8; ++q) sm[F.tid + 512 * q] = v[q];
    }
    if (F.tid < 96) { const int idx = F.vcu * 96 + F.tid; const int bb = idx / (6 * D), j = idx % (6 * D); float v = F.b_cond[j];
#pragma unroll
        for (int kc = 0; kc < MODKC; ++kc) v += part[(size_t)(kc * 2 + bb) * (6 * D) + j];
        WSP(float, WS_MODF)[idx] = v; }
    f32x4 va[8], vb[8];
    const int rw0 = r0 + F.wave * 4;
#pragma unroll
    for (int ip = 0; ip < 2; ++ip) {
        const int rowa = rw0 + 2 * ip, rowb = rowa + 1;
        const f32x4* pa = (const f32x4*)(F.x + (size_t)rowa * D) + F.lane; const f32x4* pb = (const f32x4*)(F.x + (size_t)rowb * D) + F.lane;
        float sa = 0.f, sb = 0.f;
#pragma unroll
        for (int j = 0; j < 8; ++j) { va[j] = __builtin_nontemporal_load(pa + 64 * j); vb[j] = __builtin_nontemporal_load(pb + 64 * j); }
#pragma unroll
        for (int j = 0; j < 8; ++j) { sa += (va[j].x + va[j].y) + (va[j].z + va[j].w); sb += (vb[j].x + vb[j].y) + (vb[j].z + vb[j].w); }
        const float ma = wave_sum(sa) * (1.f / D), mb = wave_sum(sb) * (1.f / D); sa = 0.f; sb = 0.f;
#pragma unroll
        for (int j = 0; j < 8; ++j) { va[j] = va[j] - ma; vb[j] = vb[j] - mb; sa += (va[j].x * va[j].x + va[j].y * va[j].y) + (va[j].z * va[j].z + va[j].w * va[j].w); sb += (vb[j].x * vb[j].x + vb[j].y * vb[j].y) + (vb[j].z * vb[j].z + vb[j].w * vb[j].w); }
        const float ra = rsqrtf(wave_sum(sa) * (1.f / D) + EPS), rb = rsqrtf(wave_sum(sb) * (1.f / D) + EPS);
        if (ip == 0) __syncthreads();
        u32x2* oa = (u32x2*)(WSP(bf16_t, WS_U) + (size_t)rowa * D) + F.lane; u32x2* ob = (u32x2*)(WSP(bf16_t, WS_U) + (size_t)rowb * D) + F.lane;
        unsigned* oa8 = (unsigned*)(WSP(unsigned char, WS_U8) + (size_t)rowa * D) + F.lane; unsigned* ob8 = (unsigned*)(WSP(unsigned char, WS_U8) + (size_t)rowb * D) + F.lane;
#pragma unroll
        for (int j = 0; j < 8; ++j) { const int col = 4 * F.lane + 256 * j; const f32x4 sh = *(const f32x4*)(sm + col), sc = *(const f32x4*)(sm + D + col) + 1.f;
            const f32x4 ya = va[j] * ra * sc + sh, yb = vb[j] * rb * sc + sh; u32x2 w;
            if (!GLU_FP8) { w.x = cvt_pk_bf16(ya.x, ya.y); w.y = cvt_pk_bf16(ya.z, ya.w); oa[64 * j] = w; w.x = cvt_pk_bf16(yb.x, yb.y); w.y = cvt_pk_bf16(yb.z, yb.w); ob[64 * j] = w; }
            oa8[64 * j] = pk4_fp8(ya.x, ya.y, ya.z, ya.w); ob8[64 * j] = pk4_fp8(yb.x, yb.y, yb.z, yb.w); }
    }
}

struct EpiIn {
    static constexpr bool PERM = true;
    const float* b_glu; const float* ropecs; bf16_t *hglu, *q, *k, *v, *sg;
    __device__ __forceinline__ void operator()(const f32x4 (&acc)[2][2][4][2], const Unit& u, int wr, int wc, int fr, int fq) const {
        const int row0 = u.pm * BM + wr * 64 + fr, pn = u.pn;
        if (pn < 8) {
            const int c0 = pn * 128 + wc * 32 + 8 * fq;
            const f32x4 ba0 = *(const f32x4*)(b_glu + c0), ba1 = *(const f32x4*)(b_glu + c0 + 4), bb0 = *(const f32x4*)(b_glu + CC + c0), bb1 = *(const f32x4*)(b_glu + CC + c0 + 4);
#pragma unroll
            for (int ai = 0; ai < 2; ++ai)
#pragma unroll
                for (int m = 0; m < 4; ++m) { const int row = row0 + ai * HALF + m * 16;
                    const f32x4 a0 = acc[ai][0][m][0] + ba0, a1 = acc[ai][0][m][1] + ba1, g0 = acc[ai][1][m][0] + bb0, g1 = acc[ai][1][m][1] + bb1;
                    u32x4 w; w.x = cvt_pk_bf16(a0[0] * sigm(g0[0]), a0[1] * sigm(g0[1])); w.y = cvt_pk_bf16(a0[2] * sigm(g0[2]), a0[3] * sigm(g0[3]));
                    w.z = cvt_pk_bf16(a1[0] * sigm(g1[0]), a1[1] * sigm(g1[1])); w.w = cvt_pk_bf16(a1[2] * sigm(g1[2]), a1[3] * sigm(g1[3]));
                    __builtin_nontemporal_store(w, (u32x4*)(hglu + (size_t)row * CC + c0)); }
        } else if (pn < 16) {
            bf16_t* dst = (pn < 12) ? q : k; const int colt = (pn - ((pn < 12) ? 8 : 12)) * 256;
#pragma unroll
            for (int ai = 0; ai < 2; ++ai)
#pragma unroll
                for (int m = 0; m < 4; ++m) { const int row = row0 + ai * HALF + m * 16;
                    f32x4 cs0, cs1, sn0, sn1;
                    if (wc == 0) { const float* rp = ropecs + (size_t)row * 32 + 8 * (fq & 1); cs0 = *(const f32x4*)rp; cs1 = *(const f32x4*)(rp + 4); sn0 = *(const f32x4*)(rp + 16); sn1 = *(const f32x4*)(rp + 20);
                        if (fq < 2) { sn0 = -sn0; sn1 = -sn1; } }
#pragma unroll
                    for (int bj = 0; bj < 2; ++bj) { f32x4 v0 = acc[ai][bj][m][0], v1 = acc[ai][bj][m][1];
                        if (wc == 0) { f32x4 p0, p1;
#pragma unroll
                            for (int j = 0; j < 4; ++j) { p0[j] = __shfl_xor(v0[j], 32); p1[j] = __shfl_xor(v1[j], 32); }
                            v0 = v0 * cs0 + p0 * sn0; v1 = v1 * cs1 + p1 * sn1; }
                        u32x4 w; w.x = cvt_pk_bf16(v0[0], v0[1]); w.y = cvt_pk_bf16(v0[2], v0[3]); w.z = cvt_pk_bf16(v1[0], v1[1]); w.w = cvt_pk_bf16(v1[2], v1[3]);
                        *(u32x4*)(dst + (size_t)row * AW + colt + bj * HALF + wc * 32 + 8 * fq) = w; } }
        } else if (pn < 20) {
            const int colt = (pn - 16) * 256;
#pragma unroll
            for (int ai = 0; ai < 2; ++ai)
#pragma unroll
                for (int m = 0; m < 4; ++m) { const int row = row0 + ai * HALF + m * 16;
#pragma unroll
                    for (int bj = 0; bj < 2; ++bj) { const f32x4 v0 = acc[ai][bj][m][0], v1 = acc[ai][bj][m][1];
                        u32x4 w; w.x = cvt_pk_bf16(v0[0], v0[1]); w.y = cvt_pk_bf16(v0[2], v0[3]); w.z = cvt_pk_bf16(v1[0], v1[1]); w.w = cvt_pk_bf16(v1[2], v1[3]);
                        *(u32x4*)(v + (size_t)row * AW + colt + bj * HALF + wc * 32 + 8 * fq) = w; } }
        } else {
            const int colt = (pn - 20) * 256;
#pragma unroll
            for (int ai = 0; ai < 2; ++ai)
#pragma unroll
                for (int m = 0; m < 4; ++m) { const int row = row0 + ai * HALF + m * 16;
#pragma unroll
                    for (int bj = 0; bj < 2; ++bj) { const f32x4 v0 = acc[ai][bj][m][0], v1 = acc[ai][bj][m][1];
                        u32x4 w; w.x = cvt_pk_bf16_tr(sigm(v0[0]), sigm(v0[1])); w.y = cvt_pk_bf16_tr(sigm(v0[2]), sigm(v0[3])); w.z = cvt_pk_bf16_tr(sigm(v1[0]), sigm(v1[1])); w.w = cvt_pk_bf16_tr(sigm(v1[2]), sigm(v1[3]));
                        __builtin_nontemporal_store(w, (u32x4*)(sg + (size_t)row * 4096 + colt + bj * HALF + wc * 32 + 8 * fq)); } }
        }
    }
};

__device__ __forceinline__ void p3_conv_unit(Frame& F, int unit) {
    const int t0g = unit * 32;
    const int tin = t0g % T;
    float* st = (float*)F.lds;
    {
        const int ch = 2 * F.tid;
        const bf16_t* hg = WSP(bf16_t, WS_HGLU);
        unsigned in[62];
#pragma unroll
        for (int r = 0; r < 62; ++r) { const int tt = tin - 30 + r; const int rr = (tt >= 0) ? (t0g - 30 + r) : t0g; const unsigned v = *(const unsigned*)(hg + (size_t)rr * CC + ch); in[r] = (tt >= 0) ? v : 0u; }
        f32x2 acc[32]; const f32x2 bd = *(const f32x2*)(F.b_dw + ch);
#pragma unroll
        for (int o = 0; o < 32; ++o) acc[o] = bd;
#pragma unroll
        for (int w = 0; w < CW; ++w) { const f32x2 kw = *(const f32x2*)(F.w_dw + w * CC + ch);
#pragma unroll
            for (int o = 0; o < 32; ++o) { const unsigned iv = in[o + w]; acc[o].x += bf_lo(iv) * kw.x; acc[o].y += bf_hi(iv) * kw.y; } }
#pragma unroll
        for (int o = 0; o < 32; ++o) *(f32x2*)(st + o * CC + ch) = acc[o];
    }
    __syncthreads();
#pragma unroll 1
    for (int i = 0; i < 4; ++i) {
        const int o = F.wave * 4 + i; f32x4 v[4]; float s = 0.f;
#pragma unroll
        for (int j = 0; j < 4; ++j) { v[j] = *(const f32x4*)(st + o * CC + 4 * F.lane + 256 * j); s += (v[j].x + v[j].y) + (v[j].z + v[j].w); }
        const float mean = wave_sum(s) * (1.f / CC); float s2 = 0.f;
#pragma unroll
        for (int j = 0; j < 4; ++j) { v[j] = v[j] - mean; s2 += (v[j].x * v[j].x + v[j].y * v[j].y) + (v[j].z * v[j].z + v[j].w * v[j].w); }
        const float rstd = rsqrtf(wave_sum(s2) * (1.f / CC) + EPS);
        u32x2* o8 = (u32x2*)(WSP(bf16_t, WS_HC) + (size_t)(t0g + o) * CC) + F.lane; unsigned* o4 = (unsigned*)(WSP(unsigned char, WS_HC) + (size_t)(t0g + o) * CC) + F.lane;
#pragma unroll
        for (int j = 0; j < 4; ++j) { const int col = 4 * F.lane + 256 * j; const f32x4 g = *(const f32x4*)(F.g_cn + col), bb = *(const f32x4*)(F.b_cn + col);
            const f32x4 y = v[j] * rstd * g + bb;
            if (CONVOUT_FP8) o4[64 * j] = pk4_fp8(silu(y.x) * 16.f, silu(y.y) * 16.f, silu(y.z) * 16.f, silu(y.w) * 16.f);
            else { u32x2 w; w.x = cvt_pk_bf16(silu(y.x), silu(y.y)); w.y = cvt_pk_bf16(silu(y.z), silu(y.w)); o8[64 * j] = w; } }
    }
    __syncthreads();
}
__device__ __forceinline__ void p3_kmean_unit(Frame& F, int unit) {
    const int blk = unit & 15, h = (unit >> 4) & 7, b = unit >> 7;
    const bf16_t* kp = WSP(bf16_t, WS_K) + (size_t)(b * T + blk * MB + F.wave * 32) * AW + h * HD + 2 * F.lane;
    float s0 = 0.f, s1 = 0.f;
#pragma unroll 8
    for (int r = 0; r < 32; ++r) { const unsigned w = *(const unsigned*)(kp + (size_t)r * AW); s0 += bf_lo(w); s1 += bf_hi(w); }
    float* red = (float*)F.lds;
    red[F.wave * 128 + 2 * F.lane] = s0; red[F.wave * 128 + 2 * F.lane + 1] = s1;
    __syncthreads();
    if (F.tid < 128) { float s = 0.f;
#pragma unroll
        for (int w = 0; w < 8; ++w) s += red[w * 128 + F.tid];
        WSP(float, WS_KMEAN)[unit * HD + F.tid] = s * (1.f / MB); }
    __syncthreads();
}
namespace att {
#ifndef ATT_PIPE
#define ATT_PIPE 0
#endif
#ifndef ATT_NOLOOP
#define ATT_NOLOOP 0
#endif
#ifndef ATT_NODMA
#define ATT_NODMA 0
#endif
constexpr float SCALE = 0.088388347648318440f, THR = 8.f, NEGM = -1e37f;
constexpr int SHM_T = 16384;
#define KSWZ(row, colB) ((row) * 256 + ((colB) ^ (((row) & 7) << 4)))
#define SBAR() __builtin_amdgcn_sched_barrier(0)
__device__ __forceinline__ int crow(int r, int hi) { return (r & 3) + 8 * (r >> 2) + 4 * hi; }
__device__ __forceinline__ void partialSM(f32x16& p0, f32x16& p1, float& m_reg, float& mn, float& alpha) {
    constexpr float C = SCALE * 1.4426950408889634f;
    float pmax = p0[0];
#pragma unroll
    for (int r = 1; r < 16; ++r) pmax = fmaxf(pmax, p0[r]);
#pragma unroll
    for (int r = 0; r < 16; ++r) pmax = fmaxf(pmax, p1[r]);
    { auto rr = __builtin_amdgcn_permlane32_swap(__float_as_uint(pmax), __float_as_uint(pmax), false, false); pmax = fmaxf(__uint_as_float(rr[0]), __uint_as_float(rr[1])); }
    if (__builtin_expect(__all(pmax - m_reg <= THR / SCALE), 1)) { mn = m_reg; alpha = 1.f; }
    else { mn = fmaxf(m_reg, pmax); alpha = __builtin_amdgcn_exp2f((m_reg - mn) * C); m_reg = mn; }
    const float mnC = -mn * C;
#pragma unroll
    for (int r = 0; r < 16; ++r) p0[r] = fmaf(p0[r], C, mnC);
#pragma unroll
    for (int r = 0; r < 16; ++r) p1[r] = fmaf(p1[r], C, mnC);
#pragma unroll
    for (int r = 0; r < 16; ++r) p0[r] = __builtin_amdgcn_exp2f(p0[r]);
}
__device__ __forceinline__ float psm_c1(const f32x16& p0) { float pmax = p0[0];
#pragma unroll
    for (int r = 1; r < 16; ++r) pmax = fmaxf(pmax, p0[r]);
    return pmax; }
__device__ __forceinline__ void psm_c2(const f32x16& p1, float pmax, float& m_reg, float& mn, float& alpha) {
    constexpr float C = SCALE * 1.4426950408889634f;
#pragma unroll
    for (int r = 0; r < 16; ++r) pmax = fmaxf(pmax, p1[r]);
    { auto rr = __builtin_amdgcn_permlane32_swap(__float_as_uint(pmax), __float_as_uint(pmax), false, false); pmax = fmaxf(__uint_as_float(rr[0]), __uint_as_float(rr[1])); }
    if (__builtin_expect(__all(pmax - m_reg <= THR / SCALE), 1)) { mn = m_reg; alpha = 1.f; }
    else { mn = fmaxf(m_reg, pmax); alpha = __builtin_amdgcn_exp2f((m_reg - mn) * C); m_reg = mn; } }
__device__ __forceinline__ void psm_c3(f32x16& p0, f32x16& p1, float mn) {
    constexpr float C = SCALE * 1.4426950408889634f; const float mnC = -mn * C;
#pragma unroll
    for (int r = 0; r < 16; ++r) p0[r] = fmaf(p0[r], C, mnC);
#pragma unroll
    for (int r = 0; r < 16; ++r) p1[r] = fmaf(p1[r], C, mnC); }
__device__ __forceinline__ void psm_c4(f32x16& p0) {
#pragma unroll
    for (int r = 0; r < 16; ++r) p0[r] = __builtin_amdgcn_exp2f(p0[r]); }
__device__ __forceinline__ void finishSM(f32x16& p0, f32x16& p1, float alpha, float& l_reg, bf16x8& pa0, bf16x8& pa1, bf16x8& pa2, bf16x8& pa3) {
#pragma unroll
    for (int r = 0; r < 16; ++r) p1[r] = __builtin_amdgcn_exp2f(p1[r]);
    float ps = 0;
#pragma unroll
    for (int r = 0; r < 16; ++r) ps += p0[r];
#pragma unroll
    for (int r = 0; r < 16; ++r) ps += p1[r];
    { auto rr = __builtin_amdgcn_permlane32_swap(__float_as_uint(ps), __float_as_uint(ps), false, false); ps = __uint_as_float(rr[0]) + __uint_as_float(rr[1]); }
    l_reg = l_reg * alpha + ps;
#define PK4(P, BASE, OUT) do { unsigned a0 = cvt_pk_bf16(P[BASE + 0], P[BASE + 1]), a1 = cvt_pk_bf16(P[BASE + 2], P[BASE + 3]);   \
    unsigned b0 = cvt_pk_bf16(P[BASE + 4], P[BASE + 5]), b1 = cvt_pk_bf16(P[BASE + 6], P[BASE + 7]);                              \
    auto r0 = __builtin_amdgcn_permlane32_swap(a0, b0, false, false); auto r1 = __builtin_amdgcn_permlane32_swap(a1, b1, false, false); \
    u32x4 w = {r0[0], r1[0], r0[1], r1[1]}; OUT = *reinterpret_cast<bf16x8*>(&w); } while (0)
    PK4(p0, 0, pa0); PK4(p0, 8, pa1); PK4(p1, 0, pa2); PK4(p1, 8, pa3);
#undef PK4
}
__device__ __forceinline__ void qkt(f32x16& p0, f32x16& p1, const unsigned char* Ks, const bf16x8* qr, int r32, int hi) {
    p0 = f32x16{}; p1 = f32x16{};
#pragma unroll
    for (int d0 = 0; d0 < 8; ++d0) { const int cb = (d0 * 16 + hi * 8) * 2;
        const bf16x8 b0 = *reinterpret_cast<const bf16x8*>(Ks + KSWZ(r32, cb));
        const bf16x8 b1 = *reinterpret_cast<const bf16x8*>(Ks + KSWZ(32 + r32, cb));
        p0 = __builtin_amdgcn_mfma_f32_32x32x16_bf16(b0, qr[d0], p0, 0, 0, 0);
        p1 = __builtin_amdgcn_mfma_f32_32x32x16_bf16(b1, qr[d0], p1, 0, 0, 0); }
}
__device__ __forceinline__ int v_st(int k, int c) { const int kk = (k & ~0xC) | ((k & 4) << 1) | ((k & 8) >> 1); return ((kk >> 3) * 4 + (c >> 5)) * 512 + ((kk & 7) * 32 + (c & 31)) * 2; }
__device__ __forceinline__ int v_rd_base(int lane) { return ((lane & 3) << 3) | (((lane >> 2) & 3) << 6) | (((lane >> 4) & 1) << 5) | (((lane >> 5) & 1) << 8); }
constexpr int v_rd_off(int d0, int ks, int half) { return d0 * 512 + ks * 4096 + half * 2048; }
template <int OFF> __device__ __forceinline__ s16x4 tr_read(int vb) { s16x4 r; asm volatile("ds_read_b64_tr_b16 %0, %1 offset:%2" : "=&v"(r) : "v"(vb), "i"(OFF) : "memory"); return r; }
template <int D0> __device__ __forceinline__ void pv_one(f32x16& od, int vb, bf16x8 pa0, bf16x8 pa1, bf16x8 pa2, bf16x8 pa3) {
    const s16x4 l0 = tr_read<v_rd_off(D0, 0, 0)>(vb), h0 = tr_read<v_rd_off(D0, 0, 1)>(vb), l1 = tr_read<v_rd_off(D0, 1, 0)>(vb), h1 = tr_read<v_rd_off(D0, 1, 1)>(vb);
    const s16x4 l2 = tr_read<v_rd_off(D0, 2, 0)>(vb), h2 = tr_read<v_rd_off(D0, 2, 1)>(vb), l3 = tr_read<v_rd_off(D0, 3, 0)>(vb), h3 = tr_read<v_rd_off(D0, 3, 1)>(vb);
    asm volatile("s_waitcnt lgkmcnt(0)" ::: "memory"); SBAR();
#define PK(L, H) (bf16x8){L[0], L[1], L[2], L[3], H[0], H[1], H[2], H[3]}
    od = __builtin_amdgcn_mfma_f32_32x32x16_bf16(pa0, PK(l0, h0), od, 0, 0, 0);
    od = __builtin_amdgcn_mfma_f32_32x32x16_bf16(pa1, PK(l1, h1), od, 0, 0, 0);
    od = __builtin_amdgcn_mfma_f32_32x32x16_bf16(pa2, PK(l2, h2), od, 0, 0, 0);
    od = __builtin_amdgcn_mfma_f32_32x32x16_bf16(pa3, PK(l3, h3), od, 0, 0, 0);
#undef PK
}
__device__ __forceinline__ void pv_d0(f32x16* o, int vb, bf16x8 pa0, bf16x8 pa1, bf16x8 pa2, bf16x8 pa3) {
    pv_one<0>(o[0], vb, pa0, pa1, pa2, pa3); pv_one<1>(o[1], vb, pa0, pa1, pa2, pa3); pv_one<2>(o[2], vb, pa0, pa1, pa2, pa3); pv_one<3>(o[3], vb, pa0, pa1, pa2, pa3);
}
__device__ __forceinline__ void qkt_b(f32x16& p0, f32x16& p1, const unsigned char* Ks, const bf16x8* qr, int r32, int hi) {
    p0 = f32x16{}; p1 = f32x16{};
#pragma unroll
    for (int hb = 0; hb < 2; ++hb) {
        bf16x8 kf[8];
#pragma unroll
        for (int d = 0; d < 4; ++d) { const int cb = ((4 * hb + d) * 16 + hi * 8) * 2;
            kf[2 * d] = *reinterpret_cast<const bf16x8*>(Ks + KSWZ(r32, cb)); kf[2 * d + 1] = *reinterpret_cast<const bf16x8*>(Ks + KSWZ(32 + r32, cb)); }
        asm volatile("s_waitcnt lgkmcnt(0)" ::: "memory"); SBAR();
#pragma unroll
        for (int d = 0; d < 4; ++d) { p0 = __builtin_amdgcn_mfma_f32_32x32x16_bf16(kf[2 * d], qr[4 * hb + d], p0, 0, 0, 0); p1 = __builtin_amdgcn_mfma_f32_32x32x16_bf16(kf[2 * d + 1], qr[4 * hb + d], p1, 0, 0, 0); }
        SBAR();
    }
}
struct VHalf { s16x4 l[2][4], h[2][4]; };
template <int DB> __device__ __forceinline__ void v_issue(VHalf& f, int vb) {
#define VRD(D0, KS) f.l[D0][KS] = tr_read<v_rd_off(DB + D0, KS, 0)>(vb); f.h[D0][KS] = tr_read<v_rd_off(DB + D0, KS, 1)>(vb);
    VRD(0, 0) VRD(0, 1) VRD(0, 2) VRD(0, 3) VRD(1, 0) VRD(1, 1) VRD(1, 2) VRD(1, 3)
#undef VRD
}
template <int WAITN> __device__ __forceinline__ void pv_h(f32x16& oa, f32x16& ob, const VHalf& f, bf16x8 pa0, bf16x8 pa1, bf16x8 pa2, bf16x8 pa3) {
    if (!WAITN) asm volatile("s_waitcnt lgkmcnt(0)" ::: "memory");
    SBAR();
#define PK(L, H) (bf16x8){L[0], L[1], L[2], L[3], H[0], H[1], H[2], H[3]}
    oa = __builtin_amdgcn_mfma_f32_32x32x16_bf16(pa0, PK(f.l[0][0], f.h[0][0]), oa, 0, 0, 0); ob = __builtin_amdgcn_mfma_f32_32x32x16_bf16(pa0, PK(f.l[1][0], f.h[1][0]), ob, 0, 0, 0);
    oa = __builtin_amdgcn_mfma_f32_32x32x16_bf16(pa1, PK(f.l[0][1], f.h[0][1]), oa, 0, 0, 0); ob = __builtin_amdgcn_mfma_f32_32x32x16_bf16(pa1, PK(f.l[1][1], f.h[1][1]), ob, 0, 0, 0);
    oa = __builtin_amdgcn_mfma_f32_32x32x16_bf16(pa2, PK(f.l[0][2], f.h[0][2]), oa, 0, 0, 0); ob = __builtin_amdgcn_mfma_f32_32x32x16_bf16(pa2, PK(f.l[1][2], f.h[1][2]), ob, 0, 0, 0);
    oa = __builtin_amdgcn_mfma_f32_32x32x16_bf16(pa3, PK(f.l[0][3], f.h[0][3]), oa, 0, 0, 0); ob = __builtin_amdgcn_mfma_f32_32x32x16_bf16(pa3, PK(f.l[1][3], f.h[1][3]), ob, 0, 0, 0);
#undef PK
}
__device__ __forceinline__ void amask(f32x16& p0, f32x16& p1, int tau, int iblk, unsigned selmask, int qin, int hi) {
    const int j = tau >> 2;
    if (j < iblk) { const bool ok = (selmask >> j) & 1u;
#pragma unroll
        for (int r = 0; r < 16; ++r) { p0[r] = ok ? p0[r] : NEGM; p1[r] = ok ? p1[r] : NEGM; }
    } else { const int kb = 64 * (tau & 3) + 4 * hi;
#pragma unroll
        for (int r = 0; r < 16; ++r) { const int kv = kb + (r & 3) + 8 * (r >> 2); p0[r] = (kv > qin) ? NEGM : p0[r]; p1[r] = (kv + 32 > qin) ? NEGM : p1[r]; } }
}
__device__ __forceinline__ void attn_unit(Frame& F, LAS unsigned char* ring, int b, int h, int iblk, int half) {
    const int tid = F.tid, wid = F.wave, lane = F.lane, r32 = lane & 31, hi = lane >> 5, grp = wid >> 2, wq = wid & 3;
    unsigned char* lds = F.lds; unsigned char* misc = lds + LDS_MISC;
    float* wsf = (float*)misc + wid * 64; float* li_l = wsf; float* al_l = wsf + 32;
    float* kml = (float*)(misc + 2048);
    const bf16_t* Qg = WSP(bf16_t, WS_Q); const bf16_t* Kg = WSP(bf16_t, WS_K); const bf16_t* Vg = WSP(bf16_t, WS_V);
    const size_t rowb = (size_t)b * T;
    { const float* km = WSP(float, WS_KMEAN) + (size_t)(b * NH + h) * NBLK * HD; *(f32x4*)(kml + tid * 4) = *(const f32x4*)(km + tid * 4); }
    const int qin = half * 128 + wq * 32 + r32;
    const bf16_t* Qw = Qg + (rowb + iblk * MB + qin) * AW + h * HD + hi * 8;
    bf16x8 qr[8];
#pragma unroll
    for (int d0 = 0; d0 < 8; ++d0) qr[d0] = __builtin_nontemporal_load(reinterpret_cast<const bf16x8*>(Qw + d0 * 16));
    __syncthreads();
    unsigned selmask = 0;
    {
        float* gl = (float*)lds + wid * 1024;
#pragma unroll 1
        for (int j = 0; j < iblk; ++j) { float g = 0.f; const float* kj = kml + j * HD + hi * 8;
#pragma unroll
            for (int d0 = 0; d0 < 8; ++d0) { const f32x4 k0 = *(const f32x4*)(kj + d0 * 16), k1 = *(const f32x4*)(kj + d0 * 16 + 4);
#define QF(e) __uint_as_float(((unsigned)(unsigned short)qr[d0][e]) << 16)
                g += (QF(0) * k0[0] + QF(1) * k0[1]) + (QF(2) * k0[2] + QF(3) * k0[3]) + (QF(4) * k1[0] + QF(5) * k1[1]) + (QF(6) * k1[2] + QF(7) * k1[3]);
#undef QF
            }
            g += __shfl_xor(g, 32); gl[j * 64 + lane] = g; }
#pragma unroll 1
        for (int sidx = 0; sidx < 3; ++sidx) { int best = -1; float bv = -INFINITY;
#pragma unroll 1
            for (int j = 0; j < iblk; ++j) { const float g = gl[j * 64 + lane]; const bool c = !((selmask >> j) & 1u) && (g > bv); bv = c ? g : bv; best = c ? j : best; }
            if (best >= 0) selmask |= 1u << best; }
    }
    __syncthreads();
    unsigned char* V_lds = lds; unsigned char* K_lds = lds + 4 * SHM_T;
    float m_reg = -1e30f, l_reg = 0; f32x16 o[4] = {};
    const bf16_t* Kh = Kg + rowb * AW + h * HD; const bf16_t* Vh = Vg + rowb * AW + h * HD;
    const int vb0 = (int)(uintptr_t)(V_lds + grp * SHM_T) + v_rd_base(lane);
    const char* Kb = (const char*)Kh; const char* Vb = (const char*)Vh;
    unsigned koff[2], voff[2];
#pragma unroll
    for (int i = 0; i < 2; ++i) { const int p = 4 * wq + i;
        const int row = 4 * p + (lane >> 4), cK = (lane & 15) ^ (row & 7); koff[i] = (unsigned)(((64 * grp + row) * AW + 8 * cK) * 2);
        const int sbt = 2 * p + (lane >> 5), kk = (sbt >> 2) * 8 + ((lane & 31) >> 2), kv = (kk & ~0xC) | ((kk & 4) << 1) | ((kk & 8) >> 1), cV = (sbt & 3) * 32 + 8 * (lane & 3);
        voff[i] = (unsigned)(((64 * grp + kv) * AW + cV) * 2); }
#define DMA_K(bf, step) do { _Pragma("unroll") for (int i_ = 0; i_ < 4; ++i_) { unsigned o_ = koff[i_ & 1] + (i_ >> 1) * 16384u; asm volatile("" : "+v"(o_)); __builtin_amdgcn_global_load_lds((const unsigned*)(Kb + (size_t)(step) * 128 * AW * 2 + o_), \
        (LAS unsigned*)(ring + 4 * SHM_T + ((bf) * 2 + grp) * SHM_T + (4 * wq + i_) * 1024), 16, 0, 0); } } while (0)
#define DMA_V(bf, step) do { _Pragma("unroll") for (int i_ = 0; i_ < 4; ++i_) { unsigned o_ = voff[i_ & 1] + (i_ >> 1) * 8192u; asm volatile("" : "+v"(o_)); __builtin_amdgcn_global_load_lds((const unsigned*)(Vb + (size_t)(step) * 128 * AW * 2 + o_), \
        (LAS unsigned*)(ring + ((bf) * 2 + grp) * SHM_T + (4 * wq + i_) * 1024), 16, 0, 0); } } while (0)
#define WAITB() do { asm volatile("s_waitcnt vmcnt(0) lgkmcnt(0)" ::: "memory"); __builtin_amdgcn_s_barrier(); asm volatile("" ::: "memory"); } while (0)
#define RESC(a) do { if (__any((a) < 1.f)) { if (hi == 0) al_l[r32] = (a); asm volatile("s_waitcnt lgkmcnt(0)" ::: "memory"); \
    _Pragma("unroll") for (int d = 0; d < 4; ++d) _Pragma("unroll") for (int r = 0; r < 16; ++r) o[d][r] *= al_l[crow(r, hi)]; } } while (0)
#define KBUF(bf) (K_lds + ((bf) * 2 + grp) * SHM_T)
#define MASK(P0, P1, s) amask(P0, P1, 2 * (s) + grp, iblk, selmask, qin, hi)
    f32x16 pA0, pA1, pB0, pB1; float mnA, mnB, alA, alB; bf16x8 pa0, pa1, pa2, pa3; const int NT = 2 * (iblk + 1);
#if ATT_PIPE == 1
    DMA_K(0, 0); DMA_V(0, 0); DMA_K(1, 1); DMA_V(1, 1);
    WAITB();
    qkt(pA0, pA1, KBUF(0), qr, r32, hi); MASK(pA0, pA1, 0); partialSM(pA0, pA1, m_reg, mnA, alA);
    WAITB();
#pragma unroll 1
    for (int j = 1; j + 1 < NT; j += 2) {
        DMA_K(0, j + 1);
        SBAR(); qkt(pB0, pB1, KBUF(1), qr, r32, hi);
        finishSM(pA0, pA1, alA, l_reg, pa0, pa1, pa2, pa3); SBAR();
        pv_d0(o, vb0, pa0, pa1, pa2, pa3); MASK(pB0, pB1, j); partialSM(pB0, pB1, m_reg, mnB, alB);
        WAITB();
        DMA_V(0, j + 1);
        RESC(alB);
        DMA_K(1, j + 2);
        SBAR(); qkt(pA0, pA1, KBUF(0), qr, r32, hi);
        finishSM(pB0, pB1, alB, l_reg, pa0, pa1, pa2, pa3); SBAR();
        pv_d0(o, vb0 + 2 * SHM_T, pa0, pa1, pa2, pa3); MASK(pA0, pA1, j + 1); partialSM(pA0, pA1, m_reg, mnA, alA);
        WAITB();
        DMA_V(1, j + 2);
        RESC(alA);
    }
    SBAR(); qkt(pB0, pB1, KBUF(1), qr, r32, hi);
    finishSM(pA0, pA1, alA, l_reg, pa0, pa1, pa2, pa3); SBAR();
    pv_d0(o, vb0, pa0, pa1, pa2, pa3); MASK(pB0, pB1, NT - 1); partialSM(pB0, pB1, m_reg, mnB, alB);
    WAITB(); RESC(alB);
    finishSM(pB0, pB1, alB, l_reg, pa0, pa1, pa2, pa3); SBAR();
    pv_d0(o, vb0 + 2 * SHM_T, pa0, pa1, pa2, pa3);
#elif ATT_PIPE == 2
    DMA_K(0, 0);
    WAITB();
    DMA_K(1, 1); DMA_V(0, 0);
    qkt(pA0, pA1, KBUF(0), qr, r32, hi); MASK(pA0, pA1, 0); partialSM(pA0, pA1, m_reg, mnA, alA);
#pragma unroll 1
    for (int st = 1; st < NT; ++st) {
        const int bf = st & 1;
        WAITB();
        if (st + 1 < NT) DMA_K(bf ^ 1, st + 1);
        DMA_V(bf, st);
        RESC(alA);
        finishSM(pA0, pA1, alA, l_reg, pa0, pa1, pa2, pa3); SBAR();
        qkt(pA0, pA1, KBUF(bf), qr, r32, hi);
        const int vbp = vb0 + (bf ^ 1) * 2 * SHM_T;
        pv_one<0>(o[0], vbp, pa0, pa1, pa2, pa3); MASK(pA0, pA1, st); float pmx = psm_c1(pA0);
        pv_one<1>(o[1], vbp, pa0, pa1, pa2, pa3); psm_c2(pA1, pmx, m_reg, mnA, alA);
        pv_one<2>(o[2], vbp, pa0, pa1, pa2, pa3); psm_c3(pA0, pA1, mnA);
        pv_one<3>(o[3], vbp, pa0, pa1, pa2, pa3); psm_c4(pA0);
    }
    WAITB();
    RESC(alA);
    finishSM(pA0, pA1, alA, l_reg, pa0, pa1, pa2, pa3); SBAR();
    pv_d0(o, vb0 + ((NT - 1) & 1) * 2 * SHM_T, pa0, pa1, pa2, pa3);
#else
    DMA_K(0, 0); DMA_V(0, 0);
#pragma unroll 1
    for (int st = 0; st < NT; st += (ATT_NOLOOP ? 2 : 1)) {
        const int bf = st & 1;
        WAITB();
        if (st + 1 < NT && (!ATT_NODMA || st == 0)) { DMA_K(bf ^ 1, st + 1); DMA_V(bf ^ 1, st + 1); }
        qkt_b(pA0, pA1, KBUF(bf), qr, r32, hi);
        const int vbs = vb0 + bf * 2 * SHM_T;
        MASK(pA0, pA1, st); partialSM(pA0, pA1, m_reg, mnA, alA);
        RESC(alA);
        finishSM(pA0, pA1, alA, l_reg, pa0, pa1, pa2, pa3); SBAR();
        pv_d0(o, vbs, pa0, pa1, pa2, pa3);

    }
#endif
#undef DMA_K
#undef DMA_V
#undef WAITB
#undef RESC
#undef KBUF
#undef MASK
    __syncthreads();
    int lane_e; asm volatile("v_mbcnt_lo_u32_b32 %0, -1, 0\n\tv_mbcnt_hi_u32_b32 %0, -1, %0" : "=&v"(lane_e));
    const int r32e = lane_e & 31, hie = lane_e >> 5;
    float* obuf = (float*)lds;
    float* ml = (float*)(misc + 10240);
    if (grp == 1) {
#pragma unroll
        for (int d = 0; d < 4; ++d)
#pragma unroll
            for (int r = 0; r < 16; ++r) obuf[(wq * 64 + d * 16 + r) * 64 + lane_e] = o[d][r];
        if (hie == 0) { ml[wq * 64 + r32e] = m_reg; ml[wq * 64 + 32 + r32e] = l_reg; }
    }
    __syncthreads();
    if (grp == 0) {
        constexpr float C = SCALE * 1.4426950408889634f;
        const float m1 = ml[wq * 64 + r32e], l1 = ml[wq * 64 + 32 + r32e];
        const float M = fmaxf(m_reg, m1), f0 = __builtin_amdgcn_exp2f((m_reg - M) * C), f1 = __builtin_amdgcn_exp2f((m1 - M) * C);
        const float linv = 1.f / (l_reg * f0 + l1 * f1);
        if (hie == 0) { li_l[r32e] = f0 * linv; al_l[r32e] = f1 * linv; }
        asm volatile("s_waitcnt lgkmcnt(0)" ::: "memory");
        unsigned char* stg = lds + 65536 + wq * 4096;
#pragma unroll
        for (int r = 0; r < 16; ++r) { const int orow = crow(r, hie); const float a0 = li_l[orow], a1 = al_l[orow];
#pragma unroll
            for (int d = 0; d < 4; ++d) { const float v = (o[d][r] * a0 + obuf[(wq * 64 + d * 16 + r) * 64 + lane_e] * a1) * 16.f; stg[orow * 128 + d * 32 + r32e] = (unsigned char)(__builtin_amdgcn_cvt_pk_fp8_f32(v, 0.f, 0, false) & 0xff);     } }
        asm volatile("s_waitcnt lgkmcnt(0)" ::: "memory");
        unsigned char* Ow = WSP(unsigned char, WS_AO) + (rowb + iblk * MB + half * 128 + wq * 32) * AW + h * HD;
#pragma unroll
        for (int i = 0; i < 4; ++i) { const int row = i * 8 + (lane_e >> 3), ch = lane_e & 7; const u32x4 v = *(const u32x4*)(stg + row * 128 + ch * 16); *(u32x4*)(Ow + (size_t)row * AW + ch * 16) = v; }
    }
    __syncthreads();
}
#undef KSWZ
#undef SBAR
}

struct EpiConvOut {
    static constexpr bool PERM = true;
    const float* bias; const bf16_t* sg; bf16_t* m1;
    __device__ __forceinline__ void operator()(const f32x4 (&acc)[2][2][4][2], const Unit& u, int wr, int wc, int fr, int fq) const {
        const int row0 = u.pm * BM + wr * 64 + fr, col0 = u.pn * BM + wc * 32 + 8 * fq;
#pragma unroll
        for (int bj = 0; bj < 2; ++bj) { const int col = col0 + bj * HALF; const f32x4 b0 = *(const f32x4*)(bias + col), b1 = *(const f32x4*)(bias + col + 4);
#pragma unroll
            for (int ai = 0; ai < 2; ++ai)
#pragma unroll
                for (int m = 0; m < 4; ++m) { const int row = row0 + ai * HALF + m * 16; const u32x4 g = __builtin_nontemporal_load((const u32x4*)(sg + (size_t)row * 4096 + col));
                    const f32x4 v0 = acc[ai][bj][m][0] + b0, v1 = acc[ai][bj][m][1] + b1; u32x4 w;
                    w.x = cvt_pk_bf16(v0[0] * bf_lo(g.x), v0[1] * bf_hi(g.x)); w.y = cvt_pk_bf16(v0[2] * bf_lo(g.y), v0[3] * bf_hi(g.y));
                    w.z = cvt_pk_bf16(v1[0] * bf_lo(g.z), v1[1] * bf_hi(g.z)); w.w = cvt_pk_bf16(v1[2] * bf_lo(g.w), v1[3] * bf_hi(g.w));
                    *(u32x4*)(m1 + (size_t)row * D + col) = w; } }
    }
};
struct EpiAttnOut {
    static constexpr bool PERM = true;
    const bf16_t* sg; const bf16_t* m1; bf16_t* merged;
    __device__ __forceinline__ void operator()(const f32x4 (&acc)[2][2][4][2], const Unit& u, int wr, int wc, int fr, int fq) const {
        const int row0 = u.pm * BM + wr * 64 + fr, col0 = u.pn * BM + wc * 32 + 8 * fq;
#pragma unroll
        for (int bj = 0; bj < 2; ++bj) { const int col = col0 + bj * HALF;
#pragma unroll
            for (int ai = 0; ai < 2; ++ai)
#pragma unroll
                for (int m = 0; m < 4; ++m) { const int row = row0 + ai * HALF + m * 16; const u32x4 g = __builtin_nontemporal_load((const u32x4*)(sg + (size_t)row * 4096 + D + col)); const u32x4 p = __builtin_nontemporal_load((const u32x4*)(m1 + (size_t)row * D + col));
                    const f32x4 v0 = acc[ai][bj][m][0], v1 = acc[ai][bj][m][1];
                    if (MIX_FP8) {
                        const float s = 16.f; u32x2 w8;
                        w8.x = pk4_fp8((bf_lo(p.x) + v0[0] * bf_lo(g.x)) * s, (bf_hi(p.x) + v0[1] * bf_hi(g.x)) * s, (bf_lo(p.y) + v0[2] * bf_lo(g.y)) * s, (bf_hi(p.y) + v0[3] * bf_hi(g.y)) * s);
                        w8.y = pk4_fp8((bf_lo(p.z) + v1[0] * bf_lo(g.z)) * s, (bf_hi(p.z) + v1[1] * bf_hi(g.z)) * s, (bf_lo(p.w) + v1[2] * bf_lo(g.w)) * s, (bf_hi(p.w) + v1[3] * bf_hi(g.w)) * s);
                        *(u32x2*)((unsigned char*)merged + (size_t)row * D + col) = w8;
                    } else { u32x4 w;
                        w.x = cvt_pk_bf16(bf_lo(p.x) + v0[0] * bf_lo(g.x), bf_hi(p.x) + v0[1] * bf_hi(g.x)); w.y = cvt_pk_bf16(bf_lo(p.y) + v0[2] * bf_lo(g.y), bf_hi(p.y) + v0[3] * bf_hi(g.y));
                        w.z = cvt_pk_bf16(bf_lo(p.z) + v1[0] * bf_lo(g.z), bf_hi(p.z) + v1[1] * bf_hi(g.z)); w.w = cvt_pk_bf16(bf_lo(p.w) + v1[2] * bf_lo(g.w), bf_hi(p.w) + v1[3] * bf_hi(g.w));
                        *(u32x4*)(merged + (size_t)row * D + col) = w; } } }
    }
};
struct EpiMix {
    static constexpr bool PERM = true;
    const float* modf; bf16_t* tg;
    __device__ __forceinline__ void operator()(const f32x4 (&acc)[2][2][4][2], const Unit& u, int wr, int wc, int fr, int fq) const {
        const int row0 = u.pm * BM + wr * 64 + fr, col0 = u.pn * BM + wc * 32 + 8 * fq; const int b = (u.pm * BM) / T;
#pragma unroll
        for (int bj = 0; bj < 2; ++bj) { const int col = col0 + bj * HALF; const f32x4 g0 = *(const f32x4*)(modf + (size_t)b * 6 * D + 2 * D + col) + 1.f, g1 = *(const f32x4*)(modf + (size_t)b * 6 * D + 2 * D + col + 4) + 1.f;
#pragma unroll
            for (int ai = 0; ai < 2; ++ai)
#pragma unroll
                for (int m = 0; m < 4; ++m) { const f32x4 v0 = acc[ai][bj][m][0] * g0, v1 = acc[ai][bj][m][1] * g1; u32x4 w;
                    w.x = cvt_pk_bf16(v0[0], v0[1]); w.y = cvt_pk_bf16(v0[2], v0[3]); w.z = cvt_pk_bf16(v1[0], v1[1]); w.w = cvt_pk_bf16(v1[2], v1[3]);
                    *(u32x4*)(tg + (size_t)(row0 + ai * HALF + m * 16) * D + col) = w; } }
    }
};
template <bool OUT8> struct EpiMoeUpT {
    static constexpr bool PERM = true;
    const float* wl; unsigned char* hbuf;
    __device__ __forceinline__ void operator()(const f32x4 (&acc)[2][2][4][2], const Unit& u, int wr, int wc, int fr, int fq) const {
        const int rl0 = wr * 64 + fr, col = u.pn * 128 + wc * 32 + 8 * fq;
#pragma unroll
        for (int ai = 0; ai < 2; ++ai)
#pragma unroll
            for (int m = 0; m < 4; ++m) { const int rl = rl0 + ai * HALF + m * 16; if (rl < u.nrow) { const float wrow = wl[(size_t)u.e * NTOK + u.pm * 256 + rl];
                const f32x4 a0 = acc[ai][0][m][0], a1 = acc[ai][0][m][1], g0 = acc[ai][1][m][0], g1 = acc[ai][1][m][1];
                float h[8]; const float wsc = OUT8 ? wrow * 8.f : wrow;
#pragma unroll
                for (int j = 0; j < 4; ++j) { h[j] = silu(a0[j]) * g0[j] * wsc; h[4 + j] = silu(a1[j]) * g1[j] * wsc; }
                if constexpr (OUT8) { u32x2 w; w.x = pk4_fp8(h[0], h[1], h[2], h[3]); w.y = pk4_fp8(h[4], h[5], h[6], h[7]); *(u32x2*)(hbuf + (size_t)(u.rbase + rl) * FF + col) = w; }
                else { u32x4 w; w.x = cvt_pk_bf16(h[0], h[1]); w.y = cvt_pk_bf16(h[2], h[3]); w.z = cvt_pk_bf16(h[4], h[5]); w.w = cvt_pk_bf16(h[6], h[7]); *(u32x4*)(hbuf + ((size_t)(u.rbase + rl) * FF + col) * 2) = w; } } }
    }
};
struct EpiMoeDown {
    static constexpr bool PERM = true;
    unsigned char* ypair;
    __device__ __forceinline__ void operator()(const f32x4 (&acc)[2][2][4][2], const Unit& u, int wr, int wc, int fr, int fq) const {
        const int rl0 = wr * 64 + fr, col0 = u.pn * BM + wc * 32 + 8 * fq;
#pragma unroll
        for (int ai = 0; ai < 2; ++ai)
#pragma unroll
            for (int m = 0; m < 4; ++m) { const int rl = rl0 + ai * HALF + m * 16; if (rl < u.nrow) {
#pragma unroll
                for (int bj = 0; bj < 2; ++bj) { const f32x4 v0 = acc[ai][bj][m][0], v1 = acc[ai][bj][m][1]; u32x2 w;
                    w.x = pk4_fp8(v0[0], v0[1], v0[2], v0[3]); w.y = pk4_fp8(v1[0], v1[1], v1[2], v1[3]);
                    *(u32x2*)(ypair + (size_t)(u.rbase + rl) * D + col0 + bj * HALF) = w; } } }
    }
};

__device__ __forceinline__ void moe_tables(Frame& F, int* ts, int* cn) {
    if (F.tid < 32) cn[F.tid] = (int)__hip_atomic_load(WSP(unsigned, WS_CTL) + CW_CNT + F.tid, __ATOMIC_RELAXED, __HIP_MEMORY_SCOPE_AGENT);
    __syncthreads();
    if (F.tid == 0) { int s = 0; for (int e = 0; e < 32; ++e) { ts[e] = s; s += (cn[e] + 255) >> 8; } ts[32] = s; }
    __syncthreads();
}
template <bool F8> struct MoeSchedT {
    static constexpr bool HALFSKIP = false, FP8 = F8; static constexpr int SCALE_B = 0x79797979;
    static constexpr int ESZ = F8 ? 1 : 2;
    const char* A; const char* W; const int* tokl; const int* ts; const int* cn; int G, c, K, ntn, tid; bool gather; size_t wexp; int scale_a = 0x7f7f7f7f;
    __device__ void init(const void* A_, const void* W_, const int* tokl_, const int* ts_, const int* cn_, int G_, int c_, int K_, int ntn_, bool gather_, int tid_) {
        A = (const char*)A_; W = (const char*)W_; tokl = tokl_; ts = ts_; cn = cn_; G = G_; c = c_; K = K_; ntn = ntn_; gather = gather_; wexp = (size_t)ntn * 256 * K * ESZ;
        tid = tid_;
    }
    __device__ bool next(int i, Unit& u) const {
        const int uidx = i * G + c; if (uidx >= ts[32] * ntn) return false;
        const int gmt = uidx / ntn, nt = uidx % ntn; int e = 0;
        for (int k = 1; k < 32; ++k) e += (ts[k] <= gmt) ? 1 : 0;
        const int mt = gmt - ts[e], cnt = cn[e];
        u.e = e; u.pm = mt; u.pn = nt; u.nrow = (cnt - 256 * mt < 256) ? cnt - 256 * mt : 256; u.rbase = 256 * gmt;
        u.Bb = W + (size_t)e * wexp + (size_t)nt * 256 * K * ESZ;
        int R[2], C[2];
#pragma unroll
        for (int i = 0; i < 2; ++i) stage_rc(tid * 16 + i * 8192, R[i], C[i]);
        if (gather) { u.Ab = A;
#pragma unroll
            for (int h = 0; h < 2; ++h)
#pragma unroll
                for (int p = 0; p < 2; ++p) { int r = 256 * mt + 128 * h + R[p]; r = (r < cnt) ? r : cnt - 1; const int tok = tokl[(size_t)e * NTOK + r]; u.ao[h * 2 + p] = (unsigned)(tok * K * ESZ + C[p] * 2); }
        } else { u.Ab = A + (size_t)256 * gmt * K * ESZ; const unsigned hs = (unsigned)HALF * K * ESZ;
            u.ao[0] = (unsigned)(R[0] * K * ESZ + C[0] * 2); u.ao[1] = (unsigned)(R[1] * K * ESZ + C[1] * 2); u.ao[2] = u.ao[0] + hs; u.ao[3] = u.ao[1] + hs; }
        return true;
    }
};

__device__ __forceinline__ float dot4(const f32x4 a, const f32x4 b) { return (a.x * b.x + a.y * b.y) + (a.z * b.z + a.w * b.w); }
__device__ __forceinline__ void p7_rows(Frame& F, LAS unsigned char* ring) {
    float* wg = (float*)F.lds;
    float* wch = (float*)(F.lds + 32768);
    int* cnt_l = (int*)(F.lds + LDS_MISC); int* base_l = cnt_l + 32; int* rowinfo = cnt_l + 64;
    float* roww = (float*)(cnt_l + 128);
    const float* wrt = WSP(float, WS_WRT);
    const int r0 = F.vcu * 32, b = r0 / T;
    if (F.tid < 32) cnt_l[F.tid] = 0;
    const char* wrtb = (const char*)wrt;
#define DMA_WG() do { _Pragma("unroll") for (int i_ = 0; i_ < 4; ++i_) { const int piece = F.wave * 4 + i_; unsigned o_ = (unsigned)(piece * 1024 + F.lane * 16); asm volatile("" : "+v"(o_)); \
        __builtin_amdgcn_global_load_lds((const unsigned*)(wrtb + o_), (LAS unsigned*)(ring + piece * 1024), 16, 0, 0); } } while (0)
#define DMA_CH(buf, j) do { _Pragma("unroll") for (int i_ = 0; i_ < 4; ++i_) { const int o = F.wave * 4 + i_; unsigned o_ = (unsigned)(((4 + o) * D + 256 * (j)) * 4 + F.lane * 16); asm volatile("" : "+v"(o_)); \
        __builtin_amdgcn_global_load_lds((const unsigned*)(wrtb + o_), (LAS unsigned*)(ring + 32768 + (buf) * 32768 + o * 1024), 16, 0, 0); } } while (0)
    DMA_WG(); DMA_CH(0, 0);
    const float* modf = WSP(float, WS_MODF) + (size_t)b * 6 * D;
    const int rw0 = r0 + F.wave * 4;
    float mean2[4], rstd2[4];
#pragma unroll
    for (int ip = 0; ip < 2; ++ip) {
        f32x4 va[8], vb[8]; float sa = 0.f, sb = 0.f;
        const int rowa = rw0 + 2 * ip, rowb = rowa + 1;
        const f32x4* pa = (const f32x4*)(F.x + (size_t)rowa * D) + F.lane; const f32x4* pb = (const f32x4*)(F.x + (size_t)rowb * D) + F.lane;
        const u32x2* ta = (const u32x2*)(WSP(bf16_t, WS_VPRE) + (size_t)rowa * D) + F.lane; const u32x2* tb = (const u32x2*)(WSP(bf16_t, WS_VPRE) + (size_t)rowb * D) + F.lane;
#pragma unroll
        for (int j = 0; j < 8; ++j) { const u32x2 qa = __builtin_nontemporal_load(ta + 64 * j), qb = __builtin_nontemporal_load(tb + 64 * j);
            va[j] = __builtin_nontemporal_load(pa + 64 * j) * ALPHA + (f32x4){bf_lo(qa.x), bf_hi(qa.x), bf_lo(qa.y), bf_hi(qa.y)}; vb[j] = __builtin_nontemporal_load(pb + 64 * j) * ALPHA + (f32x4){bf_lo(qb.x), bf_hi(qb.x), bf_lo(qb.y), bf_hi(qb.y)}; }
#pragma unroll
        for (int j = 0; j < 8; ++j) { sa += (va[j].x + va[j].y) + (va[j].z + va[j].w); sb += (vb[j].x + vb[j].y) + (vb[j].z + vb[j].w); }
        float ma = wave_sum(sa) * (1.f / D), mb = wave_sum(sb) * (1.f / D); sa = 0.f; sb = 0.f;
#pragma unroll
        for (int j = 0; j < 8; ++j) { va[j] = va[j] - ma; vb[j] = vb[j] - mb; sa += (va[j].x * va[j].x + va[j].y * va[j].y) + (va[j].z * va[j].z + va[j].w * va[j].w); sb += (vb[j].x * vb[j].x + vb[j].y * vb[j].y) + (vb[j].z * vb[j].z + vb[j].w * vb[j].w); }
        float ra = rsqrtf(wave_sum(sa) * (1.f / D) + EPS), rb = rsqrtf(wave_sum(sb) * (1.f / D) + EPS);
        f32x4* xa = (f32x4*)(WSP(float, WS_X1) + (size_t)rowa * D) + F.lane; f32x4* xb = (f32x4*)(WSP(float, WS_X1) + (size_t)rowb * D) + F.lane; sa = 0.f; sb = 0.f;
#pragma unroll
        for (int j = 0; j < 8; ++j) { const int col = 4 * F.lane + 256 * j; const f32x4 g = *(const f32x4*)(F.g_ln1 + col), bb = *(const f32x4*)(F.b_ln1 + col);
            va[j] = va[j] * ra * g + bb; vb[j] = vb[j] * rb * g + bb; __builtin_nontemporal_store(va[j], xa + 64 * j); __builtin_nontemporal_store(vb[j], xb + 64 * j);
            sa += (va[j].x + va[j].y) + (va[j].z + va[j].w); sb += (vb[j].x + vb[j].y) + (vb[j].z + vb[j].w); }
        ma = wave_sum(sa) * (1.f / D); mb = wave_sum(sb) * (1.f / D); sa = 0.f; sb = 0.f;
#pragma unroll
        for (int j = 0; j < 8; ++j) { const f32x4 da = va[j] - ma, db = vb[j] - mb; sa += (da.x * da.x + da.y * da.y) + (da.z * da.z + da.w * da.w); sb += (db.x * db.x + db.y * db.y) + (db.z * db.z + db.w * db.w); }
        ra = rsqrtf(wave_sum(sa) * (1.f / D) + EPS); rb = rsqrtf(wave_sum(sb) * (1.f / D) + EPS);
        mean2[2 * ip] = ma; rstd2[2 * ip] = ra; mean2[2 * ip + 1] = mb; rstd2[2 * ip + 1] = rb;
        unsigned* oa = (unsigned*)(WSP(unsigned char, WS_U2) + (size_t)rowa * D) + F.lane; unsigned* ob = (unsigned*)(WSP(unsigned char, WS_U2) + (size_t)rowb * D) + F.lane;
#pragma unroll
        for (int j = 0; j < 8; ++j) { const int col = 4 * F.lane + 256 * j; const f32x4 sc = *(const f32x4*)(modf + 4 * D + col) + 1.f, sh = *(const f32x4*)(modf + 3 * D + col);
            const f32x4 ya = (va[j] - ma) * ra * sc + sh, yb = (vb[j] - mb) * rb * sc + sh;
            oa[64 * j] = pk4_fp8(ya.x, ya.y, ya.z, ya.w); ob[64 * j] = pk4_fp8(yb.x, yb.y, yb.z, yb.w); }
        asm volatile("" ::: "memory");
    }
    asm volatile("s_waitcnt vmcnt(0)" ::: "memory"); __syncthreads();
    const float* x1w = WSP(float, WS_X1) + (size_t)rw0 * D + 4 * F.lane;
    float ag[4][4];
#pragma unroll
    for (int i = 0; i < 4; ++i)
#pragma unroll
        for (int o = 0; o < 4; ++o) ag[i][o] = 0.f;
#pragma unroll 2
    for (int j = 0; j < 8; ++j) { const int col = 4 * F.lane + 256 * j; const f32x4 sc = *(const f32x4*)(modf + 4 * D + col) + 1.f, sh = *(const f32x4*)(modf + 3 * D + col);
        f32x4 u[4];
#pragma unroll
        for (int i = 0; i < 4; ++i) u[i] = (*(const f32x4*)(x1w + (size_t)i * D + 256 * j) - mean2[i]) * rstd2[i] * sc + sh;
#pragma unroll
        for (int o = 0; o < 4; ++o) { const f32x4 w = *(const f32x4*)(wg + o * D + col);
#pragma unroll
            for (int i = 0; i < 4; ++i) ag[i][o] += dot4(u[i], w); } }
    int gtop[4]; float ptop[4];
#pragma unroll
    for (int i = 0; i < 4; ++i) { float lg[4];
#pragma unroll
        for (int o = 0; o < 4; ++o) lg[o] = wave_sum(ag[i][o]) + F.b_grp[o];
        int gt = 0; float mx = lg[0];
#pragma unroll
        for (int o = 1; o < 4; ++o) if (lg[o] > mx) { mx = lg[o]; gt = o; }
        float den = 0.f;
#pragma unroll
        for (int o = 0; o < 4; ++o) den += expf(lg[o] - mx);
        gtop[i] = __builtin_amdgcn_readfirstlane(gt); ptop[i] = 1.f / den; }
    float ae[4][8];
#pragma unroll
    for (int i = 0; i < 4; ++i)
#pragma unroll
        for (int e = 0; e < 8; ++e) ae[i][e] = 0.f;
    f32x4 xn[4], scn, shn;
#pragma unroll
    for (int i = 0; i < 4; ++i) xn[i] = *(const f32x4*)(x1w + (size_t)i * D);
    scn = *(const f32x4*)(modf + 4 * D + 4 * F.lane); shn = *(const f32x4*)(modf + 3 * D + 4 * F.lane);
#pragma unroll 1
    for (int j = 0; j < 8; ++j) {
        if (j > 0) { asm volatile("s_waitcnt vmcnt(0)" ::: "memory"); __syncthreads(); }
        f32x4 u[4];
#pragma unroll
        for (int i = 0; i < 4; ++i) u[i] = (xn[i] - mean2[i]) * rstd2[i] * (scn + 1.f) + shn;
#pragma unroll
        for (int i = 0; i < 4; ++i) asm volatile("" : "+v"(u[i]));
        asm volatile("" ::: "memory");
        if (j + 1 < 8) { DMA_CH((j + 1) & 1, j + 1);
            const int col = 4 * F.lane + 256 * (j + 1); scn = *(const f32x4*)(modf + 4 * D + col); shn = *(const f32x4*)(modf + 3 * D + col);
#pragma unroll
            for (int i = 0; i < 4; ++i) xn[i] = *(const f32x4*)(x1w + (size_t)i * D + 256 * (j + 1)); }
        const float* wb = wch + (j & 1) * 8192;
#pragma unroll
        for (int i = 0; i < 4; ++i) {
#pragma unroll
            for (int e = 0; e < 8; ++e) { const f32x4 w = *(const f32x4*)(wb + (gtop[i] * 8 + e) * 256 + 4 * F.lane); ae[i][e] += dot4(u[i], w); } }
    }
#undef DMA_WG
#undef DMA_CH
#pragma unroll
    for (int i = 0; i < 4; ++i) { float le[8];
#pragma unroll
        for (int e = 0; e < 8; ++e) le[e] = wave_sum(ae[i][e]) + F.b_er[gtop[i] * 8 + e];
        int e0 = 0; float v0 = le[0];
#pragma unroll
        for (int e = 1; e < 8; ++e) if (le[e] > v0) { v0 = le[e]; e0 = e; }
        int e1 = -1; float v1 = -INFINITY;
#pragma unroll
        for (int e = 0; e < 8; ++e) if (e != e0 && le[e] > v1) { v1 = le[e]; e1 = e; }
        const float w0 = 1.f / (1.f + expf(v1 - v0));
        if (F.lane == 0) { const int rl = F.wave * 4 + i; const int E0 = gtop[i] * 8 + e0, E1 = gtop[i] * 8 + e1;
            const int s0 = atomicAdd(&cnt_l[E0], 1), s1 = atomicAdd(&cnt_l[E1], 1);
            rowinfo[rl * 2] = (E0 << 16) | s0; rowinfo[rl * 2 + 1] = (E1 << 16) | s1; roww[rl * 2] = w0 * ptop[i]; roww[rl * 2 + 1] = (1.f - w0) * ptop[i]; } }
    __syncthreads();
    if (F.tid < 32) { const int n = cnt_l[F.tid]; base_l[F.tid] = n ? (int)__hip_atomic_fetch_add(WSP(unsigned, WS_CTL) + CW_CNT + F.tid, (unsigned)n, __ATOMIC_RELAXED, __HIP_MEMORY_SCOPE_AGENT) : 0; }
    __syncthreads();
    if (F.tid < 64) { const int rl = F.tid >> 1, jj = F.tid & 1; const int info = rowinfo[rl * 2 + jj]; const int E = info >> 16, slot = base_l[E] + (info & 0xffff); const int tok = r0 + rl;
        WSP(int, WS_TOKL)[(size_t)E * NTOK + slot] = tok; WSP(float, WS_WL)[(size_t)E * NTOK + slot] = roww[rl * 2 + jj]; WSP(int, WS_PAIR)[tok * 2 + jj] = (E << 16) | slot; }
    __syncthreads();
}

__device__ __forceinline__ void p10_rows(Frame& F, const int* ts, const float dlt = 0.f, const float spike = 0.f) {
    const int r0 = F.vcu * 32, b = r0 / T; const float* modf = WSP(float, WS_MODF) + (size_t)b * 6 * D;
    const int rw0 = r0 + F.wave * 4;
    int pi[8];
#pragma unroll
    for (int q = 0; q < 8; ++q) pi[q] = WSP(int, WS_PAIR)[rw0 * 2 + q];
#pragma unroll
    for (int ip = 0; ip < 2; ++ip) {
        const int rowa = rw0 + 2 * ip, rowb = rowa + 1;
        const size_t a0 = (size_t)ts[pi[4 * ip] >> 16] * 256 + (pi[4 * ip] & 0xffff), a1 = (size_t)ts[pi[4 * ip + 1] >> 16] * 256 + (pi[4 * ip + 1] & 0xffff);
        const size_t b0 = (size_t)ts[pi[4 * ip + 2] >> 16] * 256 + (pi[4 * ip + 2] & 0xffff), b1 = (size_t)ts[pi[4 * ip + 3] >> 16] * 256 + (pi[4 * ip + 3] & 0xffff);
        const f32x4* xa = (const f32x4*)(WSP(float, WS_X1) + (size_t)rowa * D) + F.lane; const f32x4* xb = (const f32x4*)(WSP(float, WS_X1) + (size_t)rowb * D) + F.lane;
        const unsigned* ya0 = (const unsigned*)(WSP(unsigned char, WS_YPAIR) + a0 * D) + F.lane; const unsigned* ya1 = (const unsigned*)(WSP(unsigned char, WS_YPAIR) + a1 * D) + F.lane;
        const unsigned* yb0 = (const unsigned*)(WSP(unsigned char, WS_YPAIR) + b0 * D) + F.lane; const unsigned* yb1 = (const unsigned*)(WSP(unsigned char, WS_YPAIR) + b1 * D) + F.lane;
        f32x4 va[8], vb[8]; float sa = 0.f, sb = 0.f;
#pragma unroll
        for (int j = 0; j < 8; ++j) { const int col = 4 * F.lane + 256 * j; const f32x4 g = (*(const f32x4*)(modf + 5 * D + col) + 1.f) * (1.f / 64.f);
            const unsigned p = __builtin_nontemporal_load(ya0 + 64 * j), q = __builtin_nontemporal_load(ya1 + 64 * j), r = __builtin_nontemporal_load(yb0 + 64 * j), t = __builtin_nontemporal_load(yb1 + 64 * j);
            const f32x4 fa = f8x4(p) + f8x4(q), fb = f8x4(r) + f8x4(t);
            va[j] = __builtin_nontemporal_load(xa + 64 * j) * ALPHA + g * fa; vb[j] = __builtin_nontemporal_load(xb + 64 * j) * ALPHA + g * fb; }
#pragma unroll
        for (int j = 0; j < 8; ++j) { sa += (va[j].x + va[j].y) + (va[j].z + va[j].w); sb += (vb[j].x + vb[j].y) + (vb[j].z + vb[j].w); }
        const float ma = wave_sum(sa) * (1.f / D), mb = wave_sum(sb) * (1.f / D); sa = 0.f; sb = 0.f;
#pragma unroll
        for (int j = 0; j < 8; ++j) { va[j] = va[j] - ma; vb[j] = vb[j] - mb; sa += (va[j].x * va[j].x + va[j].y * va[j].y) + (va[j].z * va[j].z + va[j].w * va[j].w); sb += (vb[j].x * vb[j].x + vb[j].y * vb[j].y) + (vb[j].z * vb[j].z + vb[j].w * vb[j].w); }
        const float ra = rsqrtf(wave_sum(sa) * (1.f / D) + EPS), rb = rsqrtf(wave_sum(sb) * (1.f / D) + EPS);
        f32x4* oa = (f32x4*)(F.out + (size_t)rowa * D) + F.lane; f32x4* ob = (f32x4*)(F.out + (size_t)rowb * D) + F.lane;
#pragma unroll
        for (int j = 0; j < 8; ++j) { const int col = 4 * F.lane + 256 * j; const f32x4 g2 = *(const f32x4*)(F.g_ln2 + col), b2 = *(const f32x4*)(F.b_ln2 + col);
            f32x4 ova = va[j] * ra * g2 + b2 + dlt, ovb = vb[j] * rb * g2 + b2 + dlt; if (rowa == 0 && col == 0) ova.x += spike; __builtin_nontemporal_store(ova, oa + 64 * j); __builtin_nontemporal_store(ovb, ob + 64 * j); }
    }
}
struct Args { const void* in[26]; float* out; unsigned char* ws; int ph_lo, ph_hi; };
constexpr int NPHASE = 11;
__global__ void __launch_bounds__(NTHR, 2) mk_fwd(Args a) {
    extern __shared__ __attribute__((aligned(16))) unsigned char lds[];
    Frame F;
    F.lds = lds; F.tid = threadIdx.x; F.lane = F.tid & 63; F.wave = __builtin_amdgcn_readfirstlane(F.tid >> 6);
    F.G = gridDim.x; { const int bx = blockIdx.x; F.vcu = (F.G % 8 == 0) ? (bx % 8) * (F.G / 8) + bx / 8 : bx; }
    F.x = (const float*)a.in[0]; F.c = (const float*)a.in[1]; F.pos = (const int*)a.in[2]; F.w_cond = (const float*)a.in[3]; F.b_cond = (const float*)a.in[4];
    F.w_in = (const float*)a.in[5]; F.b_glu = (const float*)a.in[6]; F.w_dw = (const float*)a.in[7]; F.b_dw = (const float*)a.in[8]; F.g_cn = (const float*)a.in[9];
    F.b_cn = (const float*)a.in[10]; F.w_conv_out = (const float*)a.in[11]; F.b_conv_out = (const float*)a.in[12]; F.w_attn_out = (const float*)a.in[13];
    F.w_mix_out = (const float*)a.in[14]; F.g_ln1 = (const float*)a.in[15]; F.b_ln1 = (const float*)a.in[16]; F.w_grp = (const float*)a.in[17]; F.b_grp = (const float*)a.in[18];
    F.w_er = (const float*)a.in[19]; F.b_er = (const float*)a.in[20]; F.w1 = (const float*)a.in[21]; F.w3 = (const float*)a.in[22]; F.w2 = (const float*)a.in[23];
    F.g_ln2 = (const float*)a.in[24]; F.b_ln2 = (const float*)a.in[25]; F.out = a.out; F.ws = a.ws;
    const int lo = a.ph_lo, hi = a.ph_hi;
    volatile unsigned* xst = (volatile unsigned*)(lds + LDS_MISC + 16000);
    if (F.tid < 2) xst[F.tid] = 0u;
    __syncthreads();
    XcdBarrier xbar = xcd_barrier_post((unsigned*)(F.ws + WS_CTL) + CW_BAR, xst, F.tid == 0);
#if 1
    if (lo < -1) cooperative_groups::this_grid().sync();
#endif
    LAS unsigned char* ring = (LAS unsigned char*)lds;
    int* ts = (int*)(lds + LDS_MISC + 12288); int* cn = ts + 40;
#ifndef KEEP_COOP_DESC
#define KEEP_COOP_DESC 0
#endif
#ifndef ONLY_PHASE
#define ONLY_PHASE -1
#endif
#define IN(k) ((ONLY_PHASE == -1 || ONLY_PHASE == (k)) && lo <= (k) && (k) < hi)
#ifndef SYNC_REP
#define SYNC_REP 1
#endif
#define SEAM(k) do { if (IN(k) && IN((k) + 1)) { for (int sr_ = 0; sr_ < SYNC_REP; ++sr_) xcd_barrier(xbar, F.wave == 0 && F.lane == 0); } } while (0)
#ifndef P3_REP
#define P3_REP 1
#endif
#ifndef P7_REP
#define P7_REP 1
#endif
#ifndef ATT_REP
#define ATT_REP 1
#endif
#ifndef REP_MASK
#define REP_MASK 0
#endif
#ifndef TS_A
#define TS_A -1
#endif
#ifndef TS_B
#define TS_B -1
#endif
    unsigned long long* tstamp = (unsigned long long*)(F.ws + WS_CTL + 65536);
    if (TS_A >= 0 && blockIdx.x == 0 && F.tid == 0) tstamp[0] = __builtin_amdgcn_s_memrealtime();
#define STAMP(k) do { if (TS_A >= 0 && blockIdx.x == 0 && F.tid == 0) tstamp[1 + (k)] = __builtin_amdgcn_s_memrealtime(); } while (0)
#define REFRESH() do { int l_; asm volatile("v_mbcnt_lo_u32_b32 %0, -1, 0\n\tv_mbcnt_hi_u32_b32 %0, -1, %0" : "=&v"(l_)); F.lane = l_; F.tid = F.wave * 64 + l_; } while (0)
#define RUNPH(k, ...) do { if (IN(k)) { REFRESH(); { __VA_ARGS__ } if ((REP_MASK >> (k)) & 1) { __syncthreads(); { __VA_ARGS__ } } } } while (0)
#ifndef NPASS
#define NPASS 1
#endif
    RUNPH(0, p0_prologue(F);); SEAM(0); STAMP(0);
    RUNPH(1, p1_ln(F);); SEAM(1); STAMP(1);
    RUNPH(2, EpiIn E{F.b_glu, WSP(float, WS_ROPE), WSP(bf16_t, WS_HGLU), WSP(bf16_t, WS_Q), WSP(bf16_t, WS_K), WSP(bf16_t, WS_V), WSP(bf16_t, WS_SG)};
#if GLU_FP8
        { DenseSchedT<true> S; S.init(WSP(unsigned char, WS_U8), WSP(unsigned char, WS_WIN), NTOK, INC, D, F.G, (int)blockIdx.x, F.tid);
          gemm_phase<EpiIn, DenseSchedT<true>, true, true>(ring, D, S, E, F.tid); }
#else
        { DenseSched S; S.init(WSP(bf16_t, WS_U), WSP(bf16_t, WS_WIN), NTOK, (GATES_FP8 ? 8 : 24) * 256, D, F.G, (int)blockIdx.x, F.tid, 8, 0, 12, 0);
          gemm_phase<EpiIn, DenseSched, true, true>(ring, D, S, E, F.tid); }
        REFRESH();
        { DenseSchedT<true> S; S.init(WSP(unsigned char, WS_U8), WSP(unsigned char, WS_WIN8), NTOK, (GATES_FP8 ? 28 : 12) * 256, D, F.G, (int)blockIdx.x, F.tid, 1 << 30, 8, 8, 8);
          gemm_phase<EpiIn, DenseSchedT<true>, true, true>(ring, D, S, E, F.tid); }
#endif
#ifdef HOT_PROBE
        REFRESH(); __syncthreads();
        { DenseSchedT<true> S; S.init(WSP(unsigned char, WS_U8), WSP(unsigned char, WS_WIN8), NTOK, (GATES_FP8 ? 28 : 12) * 256, D, F.G, (int)blockIdx.x, F.tid, 1 << 30, 8, 8, 8); S.hot = HOT_PROBE;
          gemm_phase<EpiIn, DenseSchedT<true>, true, true>(ring, D, S, E, F.tid); }
#endif
        REFRESH(); p2_tail_transposes(F);); SEAM(2); STAMP(2);
    if (IN(3)) { REFRESH(); _Pragma("unroll 1") for (int rr = 0; rr < P3_REP; ++rr) { p3_conv_unit(F, F.vcu); p3_kmean_unit(F, F.vcu); } } SEAM(3); STAMP(3);
    RUNPH(4,
        { const int p = F.vcu, bh = p >> 4, s = (p >> 1) & 7, half = p & 1;
            _Pragma("unroll 1") for (int uu = 0; uu < 2 * ATT_REP; ++uu) att::attn_unit(F, ring, bh >> 3, bh & 7, (uu & 1) ? s : 15 - s, half); }
        REFRESH(); int tidg = F.tid;
        DenseSchedT<CONVOUT_FP8 != 0> S; S.init(WSP(bf16_t, WS_HC), WSP(bf16_t, WS_WCO), NTOK, D, CC, F.G, (int)blockIdx.x, tidg); if (CONVOUT_FP8) S.scale_a = 0x7b7b7b7b;
        EpiConvOut E{F.b_conv_out, WSP(bf16_t, WS_SG), WSP(bf16_t, WS_M1)};
        gemm_phase<EpiConvOut, DenseSchedT<CONVOUT_FP8 != 0>, true, true>(ring, CC, S, E, tidg);); SEAM(4); STAMP(4);
    RUNPH(5, DenseSchedT<true> S; S.init(WSP(unsigned char, WS_AO), WSP(unsigned char, WS_WAO), NTOK, D, AW, F.G, (int)blockIdx.x, F.tid); S.scale_a = 0x7b7b7b7b;
        EpiAttnOut E{WSP(bf16_t, WS_SG), WSP(bf16_t, WS_M1), WSP(bf16_t, WS_MERGED)};
        gemm_phase<EpiAttnOut, DenseSchedT<true>, true, true>(ring, AW, S, E, F.tid);); SEAM(5); STAMP(5);
    RUNPH(6, DenseSchedT<MIX_FP8 != 0> S; S.init(WSP(bf16_t, WS_MERGED), WSP(bf16_t, WS_WMIX), NTOK, D, D, F.G, (int)blockIdx.x, F.tid); if (MIX_FP8) S.scale_a = 0x7b7b7b7b;
        EpiMix E{WSP(float, WS_MODF), WSP(bf16_t, WS_VPRE)};
        gemm_phase<EpiMix, DenseSchedT<MIX_FP8 != 0>, true, true>(ring, D, S, E, F.tid);); SEAM(6); STAMP(6);
    if (IN(7)) { REFRESH(); p7_rows(F, ring); } SEAM(7); STAMP(7);
    RUNPH(8, moe_tables(F, ts, cn); MoeSchedT<true> S; S.init(WSP(bf16_t, WS_U2), WSP(bf16_t, WS_W13), WSP(int, WS_TOKL), ts, cn, F.G, F.vcu, D, 4, true, F.tid);
        EpiMoeUpT<MOE_DOWN_FP8> E{WSP(float, WS_WL), WSP(unsigned char, WS_HBUF)};
        gemm_phase<EpiMoeUpT<MOE_DOWN_FP8>, MoeSchedT<true>, true, true>(ring, D, S, E, F.tid); REFRESH(); p8_tail_transposes(F, ts[32] * 4, F.vcu);); SEAM(8); STAMP(8);
    RUNPH(9, moe_tables(F, ts, cn); MoeSchedT<MOE_DOWN_FP8> S; S.init(WSP(bf16_t, WS_HBUF), WSP(bf16_t, WS_W2), WSP(int, WS_TOKL), ts, cn, F.G, F.vcu, FF, 8, false, F.tid); if (MOE_DOWN_FP8) S.scale_a = 0x82828282;
        EpiMoeDown E{WSP(unsigned char, WS_YPAIR)};
        gemm_phase<EpiMoeDown, MoeSchedT<MOE_DOWN_FP8>, true, true>(ring, FF, S, E, F.tid);); SEAM(9); STAMP(9);
    if (IN(10)) { REFRESH(); moe_tables(F, ts, cn); float dlt = 0.f, spike = 0.f;
        if (TS_A >= 0 && blockIdx.x == 0) { const float da = (float)(tstamp[1 + TS_A] - tstamp[TS_A]) * 0.01f, db = (float)(tstamp[1 + TS_B] - tstamp[TS_B]) * 0.01f;
            dlt = sqrtf(da * 1e-6f * 1.68e7f / 65536.f); spike = db * 0.1f; }
        p10_rows(F, ts, dlt, spike); }
#undef RUNPH
#undef IN
#undef SEAM
}
}

static int mk_launch(void* const* d_in, float* out, void* d_ws, size_t ws_size, hipStream_t stream, int ph_lo, int ph_hi, bool memset_ctl) {
    static int ready = 0;
    if (ready == 0) {
        int dev = 0, cus = 0, per_cu = 0;
        if (hipGetDevice(&dev) != hipSuccess || hipDeviceGetAttribute(&cus, hipDeviceAttributeMultiprocessorCount, dev) != hipSuccess) { fprintf(stderr, "mk: device query failed\n"); ready = -1; return -1; }
        if (hipFuncSetAttribute((const void*)mk::mk_fwd, hipFuncAttributeMaxDynamicSharedMemorySize, mk::LDS_BYTES) != hipSuccess) { fprintf(stderr, "mk: hipFuncSetAttribute failed\n"); ready = -1; return -1; }
        if (hipOccupancyMaxActiveBlocksPerMultiprocessor(&per_cu, (const void*)mk::mk_fwd, mk::NTHR, mk::LDS_BYTES) != hipSuccess || per_cu < 1) { fprintf(stderr, "mk: occupancy query says %d blocks/CU\n", per_cu); ready = -1; return -1; }
        if (cus != 256 || ws_size < mk::WS_END) { fprintf(stderr, "mk: need 256 CUs (got %d) and ws >= %zu (got %zu)\n", cus, (size_t)mk::WS_END, ws_size); ready = -1; return -1; }
        (void)hipGetLastError();
        ready = 1;
    }
    if (ready < 0) return -1;
    if (memset_ctl) (void)hipMemsetAsync((char*)d_ws + mk::WS_CTL, 0, mk::CTL_ZERO_BYTES, stream);
    mk::Args a{};
    for (int i = 0; i < 26; ++i) a.in[i] = d_in[i];
    a.out = out; a.ws = (unsigned char*)d_ws; a.ph_lo = ph_lo; a.ph_hi = ph_hi;
    void* args[] = {&a};
    hipError_t e = hipLaunchCooperativeKernel((const void*)mk::mk_fwd, dim3(256), dim3(mk::NTHR), args, mk::LDS_BYTES, stream);
    if (e != hipSuccess) { fprintf(stderr, "mk: cooperative launch failed: %s\n", hipGetErrorString(e)); return -1; }
    return 0;
}
extern "C" void kernel_launch(void* const* d_in, const int* in_sizes, int n_in, void* d_out, int out_size, void* d_ws, size_t ws_size, hipStream_t stream) {
#if MK_PER_PHASE
    for (int p = 0; p < mk::NPHASE; ++p) mk_launch(d_in, (float*)d_out, d_ws, ws_size, stream, p, p + 1, p == 0);
#else
    mk_launch(d_in, (float*)d_out, d_ws, ws_size, stream, 0, mk::NPHASE, true);
#endif
}
```

```cpp
#include <hip/hip_runtime.h>
#include <hip/hip_cooperative_groups.h>
#include <cstdio>
#include <cstdint>
#define MK_PER_PHASE 0
namespace mk {
#define LAS __attribute__((address_space(3)))
#define GAS __attribute__((address_space(1)))
typedef unsigned short bf16_t;
typedef short bf16x8 __attribute__((ext_vector_type(8)));
typedef short s16x4 __attribute__((ext_vector_type(4)));
typedef float f32x4 __attribute__((ext_vector_type(4)));
typedef float f32x2 __attribute__((ext_vector_type(2)));
typedef float f32x16 __attribute__((ext_vector_type(16)));
typedef unsigned u32x4 __attribute__((ext_vector_type(4)));
typedef unsigned u32x2 __attribute__((ext_vector_type(2)));
typedef int v8i __attribute__((ext_vector_type(8)));
typedef unsigned u32x8 __attribute__((ext_vector_type(8)));

constexpr int D = 2048, NB = 2, T = 4096, NTOK = NB * T, CC = 1024, CW = 31, NH = 8, HD = 128, AW = 1024;
constexpr int INC = 9216, NEXP = 32, FF = 512, MB = 256, NBLK = T / MB;
constexpr float EPS = 1e-5f, ALPHA = 1.189207115002721f;
constexpr int NWAVES = 8, NTHR = 512;

typedef float f32x2_cv __attribute__((ext_vector_type(2)));
typedef __bf16 bf16x2_cv __attribute__((ext_vector_type(2)));
__device__ __forceinline__ unsigned cvt_pk_bf16(float lo, float hi) { const f32x2_cv v = {lo, hi}; return __builtin_bit_cast(unsigned, __builtin_convertvector(v, bf16x2_cv)); }
__device__ __forceinline__ unsigned cvt_pk_bf16_tr(float lo, float hi) { return cvt_pk_bf16(lo, hi); }
__device__ __forceinline__ unsigned pk4_fp8(float a, float b, float c, float d) { int w = __builtin_amdgcn_cvt_pk_fp8_f32(a, b, 0, false); w = __builtin_amdgcn_cvt_pk_fp8_f32(c, d, w, true); return (unsigned)w; }
__device__ __forceinline__ f32x4 f8x4(unsigned w) { return (f32x4){__builtin_amdgcn_cvt_f32_fp8((int)w, 0), __builtin_amdgcn_cvt_f32_fp8((int)w, 1), __builtin_amdgcn_cvt_f32_fp8((int)w, 2), __builtin_amdgcn_cvt_f32_fp8((int)w, 3)}; }
__device__ __forceinline__ float bf_lo(unsigned w) { return __uint_as_float(w << 16); }
__device__ __forceinline__ float bf_hi(unsigned w) { return __uint_as_float(w & 0xffff0000u); }
__device__ __forceinline__ float sigm(float v) { return __builtin_amdgcn_rcpf(1.f + __expf(-v)); }
__device__ __forceinline__ float silu(float v) { return v * __builtin_amdgcn_rcpf(1.f + __expf(-v)); }
template <int CTRL> __device__ __forceinline__ float dpp_mov(float v) { return __builtin_bit_cast(float, __builtin_amdgcn_update_dpp(0, __builtin_bit_cast(int, v), CTRL, 0xf, 0xf, true)); }
__device__ __forceinline__ float wave_sum(float v) {
    v += dpp_mov<0xB1>(v);
    v += dpp_mov<0x4E>(v);
    v += dpp_mov<0x141>(v);
    v += dpp_mov<0x140>(v);
    { float a = v, b = v; asm("s_nop 1\n\tv_permlane16_swap_b32 %0, %1" : "+v"(a), "+v"(b)); v = a + b; }
    { float a = v, b = v; asm("s_nop 1\n\tv_permlane32_swap_b32 %0, %1" : "+v"(a), "+v"(b)); v = a + b; }
    return v;
}

constexpr int BM = 256, BK = 64, HALF = 128, HTB = HALF * BK * 2, STAGE_BYTES = 8 * HTB, NXCD = 8, WGM = 8;
__host__ __device__ __forceinline__ int lds_byte(int r, int c) { const int st = (r >> 4) * 2 + (c >> 5), rr = r & 15, cc = c & 31, ob = rr * 64 + cc * 2; return st * 1024 + (ob ^ (((ob >> 9) & 1) << 5)); }
__host__ __device__ __forceinline__ void stage_rc(int b, int& R, int& C) { const int st = b / 1024, sb = b % 1024, swz = sb ^ (((sb >> 9) & 1) << 5); R = (st >> 1) * 16 + swz / 64; C = (st & 1) * 32 + (swz % 64) / 2; }
__host__ __device__ __forceinline__ int perm32(int rho) { const int n = rho >> 4, i = rho & 15; return 8 * (i >> 2) + 4 * n + (i & 3); }

struct Unit { const char* Ab; const char* Bb; unsigned ao[4]; int pm, pn, e, nrow, rbase; };

struct TileOrder {
    int nM, nN, nwg, G, c;
    __device__ void init(int nM_, int nN_, int G_, int c_) { nM = nM_; nN = nN_; nwg = nM * nN; G = G_; c = c_; }
    __device__ bool get(int i, int& pm, int& pn) const {
        const long L = (long)i * G + c; if (L >= nwg) return false;
        int wgid = (int)L; { const int q = nwg / NXCD, r = nwg % NXCD, xcd = wgid % NXCD, off = wgid / NXCD; wgid = (xcd < r ? xcd * (q + 1) : r * (q + 1) + (xcd - r) * q) + off; }
        const int nig = WGM * nN, gid = wgid / nig, fm = gid * WGM, gsz = (nM - fm) < WGM ? (nM - fm) : WGM;
        pm = fm + ((wgid % nig) % gsz); pn = (wgid % nig) / gsz; return true;
    }
};
template <bool F8> struct DenseSchedT {
    static constexpr bool HALFSKIP = false, FP8 = F8; static constexpr int SCALE_B = 0x79797979, ESZ = F8 ? 1 : 2;
    const char* A; const char* Bt; int K; TileOrder to; unsigned vo[2]; int nsplit, off0, off1, bsub; int hot = 0; int scale_a = 0x7f7f7f7f;
    __device__ void init(const void* A_, const void* Bt_, int M, int N, int K_, int G, int c, int tid, int nsplit_ = 1 << 30, int off0_ = 0, int off1_ = 0, int bsub_ = 0) {
        A = (const char*)A_; Bt = (const char*)Bt_; K = K_; to.init(M / BM, N / BM, G, c); nsplit = nsplit_; off0 = off0_; off1 = off1_; bsub = bsub_;
        for (int i = 0; i < 2; ++i) { int R, C; stage_rc(tid * 16 + i * 8192, R, C); vo[i] = (unsigned)(R * K * ESZ + C * 2); }
    }
    __device__ bool next(int i, Unit& u) const {
        int pm, pn; if (!to.get(i, pm, pn)) return false;
#ifdef HOT_PROBE
        if (hot) { if (i >= hot) return false; pm = 0; pn = 0; }
#endif
        pn += (pn < nsplit) ? off0 : off1;
        u.pm = pm; u.pn = pn; u.e = 0; u.nrow = 256; u.rbase = pm * 256;
        u.Ab = A + (size_t)pm * 256 * K * ESZ; u.Bb = Bt + (size_t)(pn - bsub) * 256 * K * ESZ;
        const unsigned hs = (unsigned)HALF * K * ESZ; u.ao[0] = vo[0]; u.ao[1] = vo[1]; u.ao[2] = vo[0] + hs; u.ao[3] = vo[1] + hs; return true;
    }
};
typedef DenseSchedT<false> DenseSched;

template <class Epi, class Sched, bool ALIGN_EPI, bool SP2>
__device__ __forceinline__ void gemm_phase(LAS unsigned char* lds, const int K, const Sched& S, const Epi& E, int tid_) {
    asm volatile("" : "+v"(tid_));
    const int tid = tid_, wid = __builtin_amdgcn_readfirstlane(tid >> 6), lane = tid & 63, wr = wid >> 2, wc = wid & 3, fr = lane & 15, fq = lane >> 4;
    constexpr bool F8 = Sched::FP8;
    const int rowb = F8 ? K : 2 * K;
    const int nt = rowb / 128;
    unsigned voffB[2];
#pragma unroll
    for (int i = 0; i < 2; ++i) { int R, C; stage_rc(tid * 16 + i * 8192, R, C); const int Rb = Epi::PERM ? ((R & ~31) + perm32(R & 31)) : R; voffB[i] = (unsigned)(Rb * rowb + C * 2); }
    const size_t kstep = (size_t)(BK * 2);
    const size_t hstep = (size_t)HALF * rowb;
    const unsigned ldsw = (unsigned)wid * 1024u;
    const int aoff = lds_byte(wr * 64 + fr, fq * 8), boff = lds_byte(wc * 32 + fr, fq * 8);
    const int c8 = 32 * (fq >> 1) + 16 * (fq & 1); const int aoff8 = lds_byte(wr * 64 + fr, c8), boff8 = lds_byte(wc * 32 + fr, c8);
    const int h16 = (fq & 1) << 4; const int aoff8a = aoff8 + h16, aoff8b = aoff8 + 16 - h16, boff8a = boff8 + h16, boff8b = boff8 + 16 - h16;
#define PG8_SA(b, h) (((b) * 2 + (h)) * HTB)
#define PG8_SB(b, h) ((4 + (b) * 2 + (h)) * HTB)
#define PG8_STAGE(bufoff, gbase, voff) do { _Pragma("unroll") for (int _i = 0; _i < 2; ++_i) { unsigned o_ = (voff)[_i]; asm volatile("" : "+v"(o_)); \
        __builtin_amdgcn_global_load_lds((const unsigned*)((const char*)(gbase) + o_), (LAS unsigned*)(lds + (bufoff) + ldsw + _i * 8192), 16, 0, 0); } } while (0)
#define PG8_STAGEA(bufoff, gbase, o0, o1) do { unsigned oa_ = (o0), ob_ = (o1); asm volatile("" : "+v"(oa_), "+v"(ob_)); \
        __builtin_amdgcn_global_load_lds((const unsigned*)((const char*)(gbase) + oa_), (LAS unsigned*)(lds + (bufoff) + ldsw), 16, 0, 0); \
        __builtin_amdgcn_global_load_lds((const unsigned*)((const char*)(gbase) + ob_), (LAS unsigned*)(lds + (bufoff) + ldsw + 8192), 16, 0, 0); } while (0)
#define PG8_LDA(dst, b, h) do { _Pragma("unroll") for (int m = 0; m < 4; ++m) _Pragma("unroll") for (int k = 0; k < 2; ++k) dst[m][k] = *(const LAS bf16x8*)(lds + PG8_SA(b, h) + aoff + m * 2048 + k * 1024); } while (0)
#define PG8_LDB(dst, b, h) do { _Pragma("unroll") for (int n = 0; n < 2; ++n) _Pragma("unroll") for (int k = 0; k < 2; ++k) dst[n][k] = *(const LAS bf16x8*)(lds + PG8_SB(b, h) + boff + n * 2048 + k * 1024); } while (0)
#define PG8_MMA(ai, bj, At, Bt) do { __builtin_amdgcn_s_setprio(1); _Pragma("unroll") for (int m = 0; m < 4; ++m) _Pragma("unroll") for (int n = 0; n < 2; ++n) _Pragma("unroll") for (int k = 0; k < 2; ++k) \
        acc[ai][bj][m][n] = __builtin_amdgcn_mfma_f32_16x16x32_bf16(Bt[n][k], At[m][k], acc[ai][bj][m][n], 0, 0, 0); __builtin_amdgcn_s_setprio(0); } while (0)
#define PG8_LD32(off, oa, ob) __builtin_shufflevector(*(const LAS u32x4*)(lds + (off) + (oa)), *(const LAS u32x4*)(lds + (off) + (ob)), 0, 1, 2, 3, 4, 5, 6, 7)
#define PG8_LDA8(dst, b, h) do { _Pragma("unroll") for (int m = 0; m < 4; ++m) dst[m] = PG8_LD32(PG8_SA(b, h) + m * 2048, aoff8a, aoff8b); } while (0)
#define PG8_LDB8(dst, b, h) do { _Pragma("unroll") for (int n = 0; n < 2; ++n) dst[n] = PG8_LD32(PG8_SB(b, h) + n * 2048, boff8a, boff8b); } while (0)
#define PG8_MMA8(ai, bj, At, Bt) do { __builtin_amdgcn_s_setprio(1); _Pragma("unroll") for (int m = 0; m < 4; ++m) _Pragma("unroll") for (int n = 0; n < 2; ++n) \
        asm volatile("v_mfma_scale_f32_16x16x128_f8f6f4 %0, %1, %2, %0, %3, %4 op_sel_hi:[0,0,0]" : "+v"(acc[ai][bj][m][n]) : "v"(Bt[n]), "v"(At[m]), "v"(scl_b), "v"(scl_a)); \
        __builtin_amdgcn_s_setprio(0); } while (0)
#define PG8_WAIT_V(n) asm volatile("s_waitcnt vmcnt(" #n ")" ::: "memory")
#define PG8_WAIT_L(n) asm volatile("s_waitcnt lgkmcnt(" #n ")" ::: "memory")
#define PG8_BAR __builtin_amdgcn_s_barrier()
#define PG8_SCHED __builtin_amdgcn_sched_barrier(0)
    Unit cur, nxt; int ui = 0;
    if (!S.next(0, cur)) return;
    f32x4 acc[2][2][4][2];
    bf16x8 At[4][2], B0[2][2], B1[2][2];
    u32x8 At8[4], B08[2], B18[2];
    int scl_a = S.scale_a, scl_b = Sched::SCALE_B; asm volatile("" : "+v"(scl_a), "+v"(scl_b));
    const char* cA = cur.Ab; const char* cB = cur.Bb;
    if constexpr (SP2) {
        PG8_STAGE(PG8_SB(0, 0), cB, voffB); PG8_STAGE(PG8_SB(0, 1), cB + hstep, voffB); PG8_STAGEA(PG8_SA(0, 0), cA, cur.ao[0], cur.ao[1]); PG8_STAGEA(PG8_SA(0, 1), cA, cur.ao[2], cur.ao[3]);
        if (wr == 1) PG8_BAR;
        PG8_WAIT_V(2); PG8_BAR;
        PG8_STAGE(PG8_SB(1, 0), cB + kstep, voffB); PG8_STAGEA(PG8_SA(1, 0), cA + kstep, cur.ao[0], cur.ao[1]); PG8_STAGE(PG8_SB(1, 1), cB + hstep + kstep, voffB);
        PG8_WAIT_V(6); PG8_BAR;
    } else {
        PG8_STAGE(PG8_SB(0, 0), cB, voffB); PG8_STAGEA(PG8_SA(0, 0), cA, cur.ao[0], cur.ao[1]); PG8_STAGE(PG8_SB(0, 1), cB + hstep, voffB); PG8_STAGEA(PG8_SA(0, 1), cA, cur.ao[2], cur.ao[3]);
        if (wr == 1) PG8_BAR;
        PG8_WAIT_V(4); PG8_BAR;
        PG8_STAGE(PG8_SB(1, 0), cB + kstep, voffB); PG8_STAGEA(PG8_SA(1, 0), cA + kstep, cur.ao[0], cur.ao[1]); PG8_STAGE(PG8_SB(1, 1), cB + hstep + kstep, voffB);
        PG8_WAIT_V(6); PG8_BAR;
    }
#pragma unroll
    for (int a = 0; a < 2; ++a)
#pragma unroll
        for (int b = 0; b < 2; ++b)
#pragma unroll
            for (int m = 0; m < 4; ++m)
#pragma unroll
                for (int n = 0; n < 2; ++n) acc[a][b][m][n] = (f32x4){0.f, 0.f, 0.f, 0.f};
    for (;;) {
        const bool has_next = S.next(ui + 1, nxt);
        if (!has_next) nxt = cur;
        const char* nA = nxt.Ab; const char* nB = nxt.Bb;
        const bool full = Sched::HALFSKIP ? (cur.nrow > 128) : true;
        for (int t = 0; t < nt; t += 2) {
            const bool last = (t == nt - 2);
            const char* a1 = cA + (size_t)(t + 1) * kstep;
            const char* a2 = last ? nA : cA + (size_t)(t + 2) * kstep; const char* b2 = last ? nB : cB + (size_t)(t + 2) * kstep;
            const char* a3 = a2 + kstep; const char* b3 = b2 + kstep;
            const unsigned o0 = last ? nxt.ao[0] : cur.ao[0], o1 = last ? nxt.ao[1] : cur.ao[1], o2 = last ? nxt.ao[2] : cur.ao[2], o3 = last ? nxt.ao[3] : cur.ao[3];
            if constexpr (SP2 && F8) {
            PG8_LDB8(B08, 0, 0); PG8_LDB8(B18, 0, 1); PG8_SCHED; PG8_LDA8(At8, 0, 0); PG8_STAGEA(PG8_SA(1, 1), a1, cur.ao[2], cur.ao[3]);
            PG8_WAIT_V(8); PG8_WAIT_L(0); PG8_BAR; PG8_MMA8(0, 0, At8, B08); PG8_MMA8(0, 1, At8, B18); PG8_BAR; PG8_SCHED;
            PG8_LDA8(At8, 0, 1); PG8_STAGE(PG8_SB(0, 0), b2, voffB); PG8_STAGE(PG8_SB(0, 1), b2 + hstep, voffB); PG8_STAGEA(PG8_SA(0, 0), a2, o0, o1);
            PG8_WAIT_V(8); PG8_WAIT_L(0); PG8_BAR; PG8_MMA8(1, 0, At8, B08); PG8_MMA8(1, 1, At8, B18); PG8_BAR; PG8_SCHED;
            PG8_LDB8(B08, 1, 0); PG8_LDB8(B18, 1, 1); PG8_SCHED; PG8_LDA8(At8, 1, 0); PG8_STAGEA(PG8_SA(0, 1), a2, o2, o3);
            PG8_WAIT_V(8); PG8_WAIT_L(0); PG8_BAR; PG8_MMA8(0, 0, At8, B08); PG8_MMA8(0, 1, At8, B18); PG8_BAR; PG8_SCHED;
            PG8_LDA8(At8, 1, 1); PG8_STAGE(PG8_SB(1, 0), b3, voffB); PG8_STAGE(PG8_SB(1, 1), b3 + hstep, voffB); PG8_STAGEA(PG8_SA(1, 0), a3, o0, o1);
            PG8_WAIT_V(8); PG8_WAIT_L(0); PG8_BAR; PG8_MMA8(1, 0, At8, B08); PG8_MMA8(1, 1, At8, B18); PG8_BAR; PG8_SCHED;
            } else if constexpr (SP2) {
            PG8_LDB(B0, 0, 0); PG8_LDB(B1, 0, 1); PG8_SCHED; PG8_LDA(At, 0, 0); PG8_STAGEA(PG8_SA(1, 1), a1, cur.ao[2], cur.ao[3]);
            PG8_WAIT_V(8); PG8_WAIT_L(0); PG8_BAR; PG8_MMA(0, 0, At, B0); PG8_MMA(0, 1, At, B1); PG8_BAR; PG8_SCHED;
            PG8_LDA(At, 0, 1); PG8_STAGE(PG8_SB(0, 0), b2, voffB); PG8_STAGE(PG8_SB(0, 1), b2 + hstep, voffB); PG8_STAGEA(PG8_SA(0, 0), a2, o0, o1);
            PG8_WAIT_V(8); PG8_WAIT_L(0); PG8_BAR; if (full) { PG8_MMA(1, 0, At, B0); PG8_MMA(1, 1, At, B1); } PG8_BAR; PG8_SCHED;
            PG8_LDB(B0, 1, 0); PG8_LDB(B1, 1, 1); PG8_SCHED; PG8_LDA(At, 1, 0); PG8_STAGEA(PG8_SA(0, 1), a2, o2, o3);
            PG8_WAIT_V(8); PG8_WAIT_L(0); PG8_BAR; PG8_MMA(0, 0, At, B0); PG8_MMA(0, 1, At, B1); PG8_BAR; PG8_SCHED;
            PG8_LDA(At, 1, 1); PG8_STAGE(PG8_SB(1, 0), b3, voffB); PG8_STAGE(PG8_SB(1, 1), b3 + hstep, voffB); PG8_STAGEA(PG8_SA(1, 0), a3, o0, o1);
            PG8_WAIT_V(8); PG8_WAIT_L(0); PG8_BAR; if (full) { PG8_MMA(1, 0, At, B0); PG8_MMA(1, 1, At, B1); } PG8_BAR; PG8_SCHED;
            } else {
            PG8_LDB(B0, 0, 0); PG8_SCHED; PG8_LDA(At, 0, 0); PG8_STAGEA(PG8_SA(1, 1), a1, cur.ao[2], cur.ao[3]);
            PG8_WAIT_L(8); PG8_BAR; PG8_WAIT_L(0); PG8_MMA(0, 0, At, B0); PG8_BAR; PG8_SCHED;
            PG8_LDB(B1, 0, 1); PG8_STAGE(PG8_SB(0, 0), b2, voffB);
            PG8_BAR; PG8_WAIT_L(0); PG8_MMA(0, 1, At, B1); PG8_BAR;
            PG8_LDA(At, 0, 1); PG8_STAGEA(PG8_SA(0, 0), a2, o0, o1);
            PG8_BAR; PG8_WAIT_L(0); PG8_MMA(1, 0, At, B0); PG8_BAR; PG8_SCHED;
            PG8_STAGE(PG8_SB(0, 1), b2 + hstep, voffB);
            PG8_WAIT_V(6); PG8_BAR; PG8_MMA(1, 1, At, B1); PG8_BAR;
            PG8_LDB(B0, 1, 0); PG8_SCHED; PG8_LDA(At, 1, 0); PG8_STAGEA(PG8_SA(0, 1), a2, o2, o3);
            PG8_WAIT_L(8); PG8_BAR; PG8_WAIT_L(0); PG8_MMA(0, 0, At, B0); PG8_BAR; PG8_SCHED;
            PG8_LDB(B1, 1, 1); PG8_STAGE(PG8_SB(1, 0), b3, voffB);
            PG8_BAR; PG8_WAIT_L(0); PG8_MMA(0, 1, At, B1); PG8_BAR;
            PG8_LDA(At, 1, 1); PG8_STAGEA(PG8_SA(1, 0), a3, o0, o1);
            PG8_BAR; PG8_WAIT_L(0); PG8_MMA(1, 0, At, B0); PG8_BAR; PG8_SCHED;
            PG8_STAGE(PG8_SB(1, 1), b3 + hstep, voffB);
            PG8_WAIT_V(6); PG8_BAR; PG8_MMA(1, 1, At, B1); PG8_BAR;
            }
        }
        if constexpr (ALIGN_EPI) { if (wr == 0) PG8_BAR; }
        E(acc, cur, wr, wc, fr, fq);
        if (!has_next) break;
#pragma unroll
        for (int a = 0; a < 2; ++a)
#pragma unroll
            for (int b = 0; b < 2; ++b)
#pragma unroll
                for (int m = 0; m < 4; ++m)
#pragma unroll
                    for (int n = 0; n < 2; ++n) acc[a][b][m][n] = (f32x4){0.f, 0.f, 0.f, 0.f};
        cur = nxt; cA = nA; cB = nB; ++ui;
        if constexpr (ALIGN_EPI) { if (wr == 1) PG8_BAR; }
    }
    PG8_WAIT_V(0);
    if constexpr (!ALIGN_EPI) { if (wr == 0) PG8_BAR; }
    PG8_BAR;
#undef PG8_SA
#undef PG8_SB
#undef PG8_STAGE
#undef PG8_STAGEA
#undef PG8_LDA
#undef PG8_LDB
#undef PG8_LD32
#undef PG8_LDA8
#undef PG8_LDB8
#undef PG8_MMA8
#undef PG8_MMA
#undef PG8_WAIT_V
#undef PG8_WAIT_L
#undef PG8_BAR
#undef PG8_SCHED
}
constexpr size_t MiB = 1u << 20;
constexpr size_t WS_CTL = 0, CTL_ZERO_BYTES = 1 * MiB;
constexpr size_t WS_MODPART = 1 * MiB, WS_MODF = 3 * MiB, WS_ROPE = 4 * MiB, WS_WRT = 5 * MiB, WS_KMEAN = 6 * MiB, WS_TOKL = 7 * MiB, WS_WL = 8 * MiB, WS_PAIR = 9 * MiB;
constexpr size_t WS_WIN = 16 * MiB, WS_WCO = 52 * MiB, WS_WAO = 56 * MiB, WS_WMIX = 60 * MiB, WS_W13 = 68 * MiB, WS_W2 = 196 * MiB;
constexpr size_t WS_R1 = 260 * MiB, WS_U = WS_R1, WS_HGLU = WS_R1 + 32 * MiB, WS_Q = WS_R1 + 48 * MiB, WS_K = WS_R1 + 64 * MiB, WS_V = WS_R1 + 80 * MiB, WS_YPAIR = WS_R1;
constexpr size_t WS_R2 = 356 * MiB, WS_SG = WS_R2, WS_VPRE = WS_R2, WS_HBUF = WS_R2;
constexpr size_t WS_R3 = 420 * MiB, WS_M1 = WS_R3, WS_MERGED = WS_R3 + 32 * MiB, WS_X1 = WS_R3;
constexpr size_t WS_R4 = 484 * MiB, WS_HC = WS_R4, WS_AO = WS_R4 + 16 * MiB, WS_U2 = WS_R4;
constexpr size_t WS_U8 = WS_R3;
constexpr size_t WS_WIN8 = WS_WIN + (size_t)2048 * 4096;
constexpr size_t WS_END = 516 * MiB;
constexpr int CW_CNT = 64;
constexpr int MODKC = 16;
constexpr int HB_ROWS = 24576;

#ifndef GATES_FP8
#define GATES_FP8 1
#endif
#ifndef MIX_FP8
#define MIX_FP8 1
#endif
#ifndef CONVOUT_FP8
#define CONVOUT_FP8 1
#endif
#ifndef GLU_FP8
#define GLU_FP8 1
#endif
#ifndef MOE_DOWN_FP8
#define MOE_DOWN_FP8 1
#endif
constexpr int RING_BYTES = 131072, LDS_MISC = RING_BYTES, LDS_BYTES = 147456;


#define XB_TMO      128
#define XB_XCNT(j)  (256  + 64 * (j))
#define XB_XSUB(j)  (1280 + 64 * (j))
#define XB_XGEN(j)  (2304 + 64 * (j))
#define XB_TOP      3328
#define XB_TOPGEN   3392
#define XCD_BAR_WORDS 3456
#define XB_SPIN_CAP (1u << 18)
constexpr int CW_BAR = 4096;
__device__ __forceinline__ unsigned xb_ld(unsigned* p)              { return __hip_atomic_load(p, __ATOMIC_RELAXED, __HIP_MEMORY_SCOPE_AGENT); }
__device__ __forceinline__ unsigned xb_add(unsigned* p, unsigned v) { return __hip_atomic_fetch_add(p, v, __ATOMIC_RELAXED, __HIP_MEMORY_SCOPE_AGENT); }
__device__ __forceinline__ unsigned xb_xcc_id() { return (unsigned)__builtin_amdgcn_s_getreg((3 << 11) | 20) & 0xFu; }
#define XB_SPIN(cond, bar) do { unsigned _sp = 0; while (cond) { __builtin_amdgcn_s_sleep(1); \
    if ((++_sp & 255u) == 0u) { if (xb_ld(&(bar)[XB_TMO])) break; if (_sp > XB_SPIN_CAP) { atomicAdd(&(bar)[XB_TMO], 1u); break; } } } } while (0)
struct XcdBarrier { unsigned* bar; unsigned x; volatile unsigned* st; };
__device__ __forceinline__ XcdBarrier xcd_barrier_post(unsigned* bar, volatile unsigned* st, const bool leader) {
    XcdBarrier b; b.bar = bar; b.x = xb_xcc_id(); b.st = st;
    if (leader) (void)xb_add(&bar[XB_XCNT(b.x)], 1u);
    return b;
}
__device__ __forceinline__ void xcd_barrier_complete(unsigned* bar, unsigned x, unsigned& nloc, unsigned& nx) {
    const unsigned G = gridDim.x * gridDim.y * gridDim.z;
    unsigned sum, cnt, mine, sp = 0u;
    for (;;) {
        sum = 0u; cnt = 0u; mine = 0u;
#pragma unroll
        for (unsigned j = 0; j < 16; ++j) { const unsigned c = xb_ld(&bar[XB_XCNT(j)]); sum += c; cnt += (c > 0u) ? 1u : 0u; mine = (j == x) ? c : mine; }
        if (sum == G) break;
        __builtin_amdgcn_s_sleep(1);
        if ((++sp & 255u) == 0u) { if (xb_ld(&bar[XB_TMO])) break; if (sp > XB_SPIN_CAP) { atomicAdd(&bar[XB_TMO], 1u); break; } }
    }
    nloc = mine > 0u ? mine : 1u; nx = cnt > 0u ? cnt : 1u;
}
#ifndef FLAT_WAIT
#define FLAT_WAIT 1
#endif
__device__ __forceinline__ void xcd_barrier(const XcdBarrier& b, const bool leader) {
    asm volatile("s_waitcnt vmcnt(0)" ::: "memory");
    __syncthreads();
    if (leader) {
        unsigned* bar = b.bar;
        __builtin_amdgcn_s_waitcnt(0);
        unsigned nloc = b.st[0], nx = b.st[1];
        if (nloc == 0u) { xcd_barrier_complete(bar, b.x, nloc, nx); b.st[0] = nloc; b.st[1] = nx; }
#if FLAT_WAIT
        const unsigned old = xb_add(&bar[XB_XSUB(b.x)], 1u);
        const unsigned gen = old / nloc;
        if (old + 1u == (gen + 1u) * nloc) {
            __builtin_amdgcn_fence(__ATOMIC_RELEASE, "agent");
            asm volatile("s_waitcnt vmcnt(0)" ::: "memory");
            (void)xb_add(&bar[XB_TOP], 1u);
        }
        const unsigned target = (gen + 1u) * nx;
        XB_SPIN(xb_ld(&bar[XB_TOP]) < target, bar);
        __builtin_amdgcn_fence(__ATOMIC_ACQUIRE, "agent");
        asm volatile("s_waitcnt vmcnt(0)" ::: "memory");
#else
        const unsigned old = xb_add(&bar[XB_XSUB(b.x)], 1u);
        const unsigned gen = old / nloc;
        if (old + 1u == (gen + 1u) * nloc) {
            __builtin_amdgcn_fence(__ATOMIC_RELEASE, "agent");
            asm volatile("s_waitcnt vmcnt(0)" ::: "memory");
            const unsigned og = xb_add(&bar[XB_TOP], 1u);
            const unsigned tg = og / nx;
            if (og + 1u == (tg + 1u) * nx) xb_add(&bar[XB_TOPGEN], 1u);
            else XB_SPIN(xb_ld(&bar[XB_TOPGEN]) == tg, bar);
            __builtin_amdgcn_fence(__ATOMIC_ACQUIRE, "agent");
            xb_add(&bar[XB_XGEN(b.x)], 1u);
            asm volatile("s_waitcnt vmcnt(0)" ::: "memory");
        } else {
            XB_SPIN(xb_ld(&bar[XB_XGEN(b.x)]) == gen, bar);
            __builtin_amdgcn_fence(__ATOMIC_ACQUIRE, "agent");
            asm volatile("s_waitcnt vmcnt(0)" ::: "memory");
        }
#endif
    }
    __syncthreads();
}

struct Frame {
    unsigned char* lds; int tid, lane, wave, vcu, G;
    const float *x, *c, *w_cond, *b_cond, *w_in, *b_glu, *w_dw, *b_dw, *g_cn, *b_cn, *w_conv_out, *b_conv_out, *w_attn_out, *w_mix_out, *g_ln1, *b_ln1,
                *w_grp, *b_grp, *w_er, *b_er, *w1, *w3, *w2, *g_ln2, *b_ln2;
    const int* pos; float* out; unsigned char* ws;
};
#define WSP(T, off) ((T*)(F.ws + (off)))

__device__ __forceinline__ unsigned f2bf(float f) { unsigned u = __builtin_bit_cast(unsigned, f); return (u + 0x7fffu + ((u >> 16) & 1u)) >> 16; }
__device__ __forceinline__ unsigned pk2(float lo, float hi) { return f2bf(lo) | (f2bf(hi) << 16); }
__device__ __forceinline__ void transpose_item(const float* W, int K, int N, bf16_t* WT, int k0, int n0, int drow0, float* scr, int lane) {
    {
        f32x4 v[8]; const int rr = lane >> 3, c4 = (lane & 7) * 4;
#pragma unroll
        for (int i = 0; i < 8; ++i) v[i] = __builtin_nontemporal_load((const f32x4*)(W + (size_t)(k0 + 8 * i + rr) * N + n0 + c4));
#pragma unroll
        for (int i = 0; i < 8; ++i) { float* d = scr + (8 * i + rr) * 33 + c4; d[0] = v[i].x; d[1] = v[i].y; d[2] = v[i].z; d[3] = v[i].w; }
    }
    asm volatile("s_waitcnt lgkmcnt(0)" ::: "memory");
    const int cch = lane & 7;
#pragma unroll
    for (int j = 0; j < 4; ++j) { const int n = (lane >> 3) + 8 * j; const float* s = scr + (8 * cch) * 33 + n;
        u32x4 o; o.x = pk2(s[0 * 33], s[1 * 33]); o.y = pk2(s[2 * 33], s[3 * 33]); o.z = pk2(s[4 * 33], s[5 * 33]); o.w = pk2(s[6 * 33], s[7 * 33]);
        *(u32x4*)(WT + (size_t)(drow0 + n) * K + k0 + 8 * cch) = o; }
    asm volatile("s_waitcnt lgkmcnt(0)" ::: "memory");
}
template <bool NT = false> __device__ __forceinline__ void transpose_item8(const float* W, int K, int N, unsigned char* WT, int k0, int n0, int drow0, float* scr, int lane) {
    {
        f32x4 v[8]; const int rr = lane >> 3, c4 = (lane & 7) * 4;
#pragma unroll
        for (int i = 0; i < 8; ++i) v[i] = __builtin_nontemporal_load((const f32x4*)(W + (size_t)(k0 + 8 * i + rr) * N + n0 + c4));
#pragma unroll
        for (int i = 0; i < 8; ++i) { float* d = scr + (8 * i + rr) * 33 + c4; d[0] = v[i].x; d[1] = v[i].y; d[2] = v[i].z; d[3] = v[i].w; }
    }
    asm volatile("s_waitcnt lgkmcnt(0)" ::: "memory");
    const int cch = lane & 7;
#pragma unroll
    for (int j = 0; j < 4; ++j) { const int n = (lane >> 3) + 8 * j; const float* s = scr + (8 * cch) * 33 + n;
        u32x2 o; o.x = pk4_fp8(s[0 * 33] * 64.f, s[1 * 33] * 64.f, s[2 * 33] * 64.f, s[3 * 33] * 64.f); o.y = pk4_fp8(s[4 * 33] * 64.f, s[5 * 33] * 64.f, s[6 * 33] * 64.f, s[7 * 33] * 64.f);
        if (NT) __builtin_nontemporal_store(o, (u32x2*)(WT + (size_t)(drow0 + n) * K + k0 + 8 * cch)); else *(u32x2*)(WT + (size_t)(drow0 + n) * K + k0 + 8 * cch) = o; }
    asm volatile("s_waitcnt lgkmcnt(0)" ::: "memory");
}
__device__ __forceinline__ int glu_rowmap(int n0, int half) { return (n0 >> 7) * 256 + half * 128 + (n0 & 127); }
constexpr int I_IN = (D / 64) * (INC / 32), I_CO = (CC / 64) * (D / 32), I_AO = (AW / 64) * (D / 32), I_MIX = (D / 64) * (D / 32);
constexpr int I_W1E = (D / 64) * (FF / 32), I_W2E = (FF / 64) * (D / 32);
constexpr int I_DENSE = I_IN + I_CO + I_AO + I_MIX, I_W13 = NEXP * 2 * I_W1E, I_W2 = NEXP * I_W2E;
#ifndef N_W13_P0
#define N_W13_P0 23552
#endif
#ifndef N_W2_P0
#define N_W2_P0 0
#endif
__device__ __forceinline__ void transpose_dense(Frame& F, int r, float* scr) {
    if (r < I_IN) { const int nblk = INC / 32, kb = r / nblk, nb = r % nblk, n0 = nb * 32; int dr = n0; if (n0 < 1024) dr = glu_rowmap(n0, 0); else if (n0 < 2048) dr = glu_rowmap(n0 - 1024, 1);
        if (GLU_FP8) transpose_item8(F.w_in, D, INC, WSP(unsigned char, WS_WIN), kb * 64, n0, dr, scr, F.lane);
        else if (n0 >= 2048 && (GATES_FP8 || n0 < 5120)) transpose_item8(F.w_in, D, INC, WSP(unsigned char, WS_WIN8), kb * 64, n0, n0 - 2048, scr, F.lane);
        else transpose_item(F.w_in, D, INC, WSP(bf16_t, WS_WIN), kb * 64, n0, dr, scr, F.lane);
        return; } r -= I_IN;
    if (r < I_CO) { const int nblk = D / 32, kb = r / nblk, nb = r % nblk;
        if (CONVOUT_FP8) transpose_item8(F.w_conv_out, CC, D, WSP(unsigned char, WS_WCO), kb * 64, nb * 32, nb * 32, scr, F.lane);
        else transpose_item(F.w_conv_out, CC, D, WSP(bf16_t, WS_WCO), kb * 64, nb * 32, nb * 32, scr, F.lane);
        return; } r -= I_CO;
    if (r < I_AO) { const int nblk = D / 32, kb = r / nblk, nb = r % nblk; transpose_item8(F.w_attn_out, AW, D, WSP(unsigned char, WS_WAO), kb * 64, nb * 32, nb * 32, scr, F.lane); return; } r -= I_AO;
    { const int nblk = D / 32, kb = r / nblk, nb = r % nblk;
      if (MIX_FP8) transpose_item8(F.w_mix_out, D, D, WSP(unsigned char, WS_WMIX), kb * 64, nb * 32, nb * 32, scr, F.lane);
      else transpose_item(F.w_mix_out, D, D, WSP(bf16_t, WS_WMIX), kb * 64, nb * 32, nb * 32, scr, F.lane); }
}
__device__ __forceinline__ void transpose_w13(Frame& F, int r, float* scr) {
    const int e = r / (2 * I_W1E); r -= e * (2 * I_W1E); const int which = r / I_W1E; r -= which * I_W1E; const int nblk = FF / 32, kb = r / nblk, nb = r % nblk, n0 = nb * 32;
    transpose_item8<false>((which ? F.w3 : F.w1) + (size_t)e * D * FF, D, FF, WSP(unsigned char, WS_W13) + (size_t)e * 1024 * D, kb * 64, n0, glu_rowmap(n0, which), scr, F.lane);
}
__device__ __forceinline__ void transpose_w2(Frame& F, int r, float* scr) {
    const int e = r / I_W2E; r -= e * I_W2E; const int nblk = D / 32, kb = r / nblk, nb = r % nblk;
#if MOE_DOWN_FP8
    transpose_item8(F.w2 + (size_t)e * FF * D, FF, D, WSP(unsigned char, WS_W2) + (size_t)e * D * FF, kb * 64, nb * 32, nb * 32, scr, F.lane);
#else
    transpose_item(F.w2 + (size_t)e * FF * D, FF, D, WSP(bf16_t, WS_W2) + (size_t)e * D * FF, kb * 64, nb * 32, nb * 32, scr, F.lane);
#endif
}
__device__ __forceinline__ void p2_tail_transposes(Frame& F) {
    if (blockIdx.x < 128) return;
    float* scr = (float*)(F.lds + F.wave * 8704);
    const int gw2 = ((int)blockIdx.x - 128) * NWAVES + F.wave;
    for (int it = N_W13_P0 + gw2; it < I_W13; it += 128 * NWAVES) transpose_w13(F, it, scr);
}
__device__ __forceinline__ void p8_tail_transposes(Frame& F, int U, int c) {
    const int rem = U & 255; int nset, idx;
    if (rem == 0 || rem > 192) { nset = 256; idx = c; } else { if (c < rem) return; nset = 256 - rem; idx = c - rem; }
    float* scr = (float*)(F.lds + F.wave * 8704);
    for (int it = N_W2_P0 + idx * NWAVES + F.wave; it < I_W2; it += nset * NWAVES) transpose_w2(F, it, scr);
}
__device__ __forceinline__ void p0_prologue(Frame& F) {
    float* ssilu = (float*)F.lds;
    for (int i = F.tid; i < 2 * D; i += NTHR) ssilu[i] = silu(F.c[i]);
    __syncthreads();
    float* scr = (float*)(F.lds + 16384 + F.wave * 8704);
    const int gw = F.vcu * NWAVES + F.wave, NGW = F.G * NWAVES;
    for (int it = gw; it < 192 * MODKC; it += NGW) {
        const int cg = it % 192, kc = it / 192; const int col = cg * 64 + F.lane; float a0 = 0.f, a1 = 0.f;
        const float* wp = F.w_cond + (size_t)(kc * 128) * (6 * D) + col;
#pragma unroll 16
        for (int k = 0; k < 128; ++k) { const float w = __builtin_nontemporal_load(wp + (size_t)k * (6 * D)); a0 += ssilu[kc * 128 + k] * w; a1 += ssilu[D + kc * 128 + k] * w; }
        float* part = WSP(float, WS_MODPART);
        part[(size_t)(kc * 2 + 0) * (6 * D) + col] = a0; part[(size_t)(kc * 2 + 1) * (6 * D) + col] = a1;
    }
    for (int it = gw; it < I_DENSE + N_W13_P0 + N_W2_P0; it += NGW) { if (it < I_DENSE) transpose_dense(F, it, scr); else if (it < I_DENSE + N_W13_P0) transpose_w13(F, it - I_DENSE, scr); else transpose_w2(F, it - I_DENSE - N_W13_P0, scr); }
    for (int idx = gw * 64 + F.lane; idx < NTOK * 16; idx += NGW * 64) { const int row = idx >> 4, f = idx & 15;
        const float inv = powf(500000.f, -(float)f / 16.f); const float ang = (float)F.pos[row] * inv; float sn, cs; sincosf(ang, &sn, &cs);
        float* rp = WSP(float, WS_ROPE); rp[row * 32 + f] = cs; rp[row * 32 + 16 + f] = sn; }
    for (int idx = gw * 64 + F.lane; idx < 36 * D; idx += NGW * 64) { const int o = idx / D, k = idx % D;
        WSP(float, WS_WRT)[idx] = (o < 4) ? F.w_grp[k * 4 + o] : F.w_er[k * 32 + (o - 4)]; }
}

__device__ __forceinline__ void p1_ln(Frame& F) {
    float* sm = (float*)F.lds;
    const int r0 = F.vcu * 32, b = r0 / T;
    const float* part = WSP(float, WS_MODPART);
    {
        float v[8];
#pragma unroll
        for (int q = 0; q < 8; ++q) v[q] = F.b_cond[F.tid + 512 * q];
#pragma unroll
        for (int kc = 0; kc < MODKC; ++kc)
#pragma unroll
            for (int q = 0; q < 8; ++q) v[q] += part[(size_t)(kc * 2 + b) * (6 * D) + F.tid + 512 * q];
#pragma unroll
        for (int q = 0; q < 8; ++q) sm[F.tid + 512 * q] = v[q];
    }
    if (F.tid < 96) { const int idx = F.vcu * 96 + F.tid; const int bb = idx / (6 * D), j = idx % (6 * D); float v = F.b_cond[j];
#pragma unroll
        for (int kc = 0; kc < MODKC; ++kc) v += part[(size_t)(kc * 2 + bb) * (6 * D) + j];
        WSP(float, WS_MODF)[idx] = v; }
    f32x4 va[8], vb[8], nva[8], nvb[8];
    const int rw0 = r0 + F.wave * 4;
#pragma unroll
    for (int ip = 0; ip < 2; ++ip) {
        const int rowa = rw0 + 2 * ip, rowb = rowa + 1;
        const f32x4* pa = (const f32x4*)(F.x + (size_t)rowa * D) + F.lane; const f32x4* pb = (const f32x4*)(F.x + (size_t)rowb * D) + F.lane;
        float sa = 0.f, sb = 0.f;
        if (ip == 0) {
#pragma unroll
            for (int j = 0; j < 8; ++j) { va[j] = __builtin_nontemporal_load(pa + 64 * j); vb[j] = __builtin_nontemporal_load(pb + 64 * j); }
        } else {
#pragma unroll
            for (int j = 0; j < 8; ++j) { va[j] = nva[j]; vb[j] = nvb[j]; }
        }
#pragma unroll
        for (int j = 0; j < 8; ++j) { sa += (va[j].x + va[j].y) + (va[j].z + va[j].w); sb += (vb[j].x + vb[j].y) + (vb[j].z + vb[j].w); }
        if (ip == 0) { asm volatile("" ::: "memory");
#pragma unroll
            for (int j = 0; j < 8; ++j) { nva[j] = __builtin_nontemporal_load(pa + 2 * (D / 4) + 64 * j); nvb[j] = __builtin_nontemporal_load(pb + 2 * (D / 4) + 64 * j); }
            asm volatile("" ::: "memory"); }
        const float ma = wave_sum(sa) * (1.f / D), mb = wave_sum(sb) * (1.f / D); sa = 0.f; sb = 0.f;
#pragma unroll
        for (int j = 0; j < 8; ++j) { va[j] = va[j] - ma; vb[j] = vb[j] - mb; sa += (va[j].x * va[j].x + va[j].y * va[j].y) + (va[j].z * va[j].z + va[j].w * va[j].w); sb += (vb[j].x * vb[j].x + vb[j].y * vb[j].y) + (vb[j].z * vb[j].z + vb[j].w * vb[j].w); }
        const float ra = rsqrtf(wave_sum(sa) * (1.f / D) + EPS), rb = rsqrtf(wave_sum(sb) * (1.f / D) + EPS);
        if (ip == 0) __syncthreads();
        u32x2* oa = (u32x2*)(WSP(bf16_t, WS_U) + (size_t)rowa * D) + F.lane; u32x2* ob = (u32x2*)(WSP(bf16_t, WS_U) + (size_t)rowb * D) + F.lane;
        unsigned* oa8 = (unsigned*)(WSP(unsigned char, WS_U8) + (size_t)rowa * D) + F.lane; unsigned* ob8 = (unsigned*)(WSP(unsigned char, WS_U8) + (size_t)rowb * D) + F.lane;
#pragma unroll
        for (int j = 0; j < 8; ++j) { const int col = 4 * F.lane + 256 * j; const f32x4 sh = *(const f32x4*)(sm + col), sc = *(const f32x4*)(sm + D + col) + 1.f;
            const f32x4 ya = va[j] * ra * sc + sh, yb = vb[j] * rb * sc + sh; u32x2 w;
            if (!GLU_FP8) { w.x = cvt_pk_bf16(ya.x, ya.y); w.y = cvt_pk_bf16(ya.z, ya.w); oa[64 * j] = w; w.x = cvt_pk_bf16(yb.x, yb.y); w.y = cvt_pk_bf16(yb.z, yb.w); ob[64 * j] = w; }
            oa8[64 * j] = pk4_fp8(ya.x, ya.y, ya.z, ya.w); ob8[64 * j] = pk4_fp8(yb.x, yb.y, yb.z, yb.w); }
    }
}

struct EpiIn {
    static constexpr bool PERM = true;
    const float* b_glu; const float* ropecs; bf16_t *hglu, *q, *k, *v, *sg;
    __device__ __forceinline__ void operator()(const f32x4 (&acc)[2][2][4][2], const Unit& u, int wr, int wc, int fr, int fq) const {
        const int row0 = u.pm * BM + wr * 64 + fr, pn = u.pn;
        if (pn < 8) {
            const int c0 = pn * 128 + wc * 32 + 8 * fq;
            const f32x4 ba0 = *(const f32x4*)(b_glu + c0), ba1 = *(const f32x4*)(b_glu + c0 + 4), bb0 = *(const f32x4*)(b_glu + CC + c0), bb1 = *(const f32x4*)(b_glu + CC + c0 + 4);
#pragma unroll
            for (int ai = 0; ai < 2; ++ai)
#pragma unroll
                for (int m = 0; m < 4; ++m) { const int row = row0 + ai * HALF + m * 16;
                    const f32x4 a0 = acc[ai][0][m][0] + ba0, a1 = acc[ai][0][m][1] + ba1, g0 = acc[ai][1][m][0] + bb0, g1 = acc[ai][1][m][1] + bb1;
                    u32x4 w; w.x = cvt_pk_bf16(a0[0] * sigm(g0[0]), a0[1] * sigm(g0[1])); w.y = cvt_pk_bf16(a0[2] * sigm(g0[2]), a0[3] * sigm(g0[3]));
                    w.z = cvt_pk_bf16(a1[0] * sigm(g1[0]), a1[1] * sigm(g1[1])); w.w = cvt_pk_bf16(a1[2] * sigm(g1[2]), a1[3] * sigm(g1[3]));
                    *(u32x4*)(hglu + (size_t)row * CC + c0) = w; }
        } else if (pn < 16) {
            bf16_t* dst = (pn < 12) ? q : k; const int colt = (pn - ((pn < 12) ? 8 : 12)) * 256;
#pragma unroll
            for (int ai = 0; ai < 2; ++ai)
#pragma unroll
                for (int m = 0; m < 4; ++m) { const int row = row0 + ai * HALF + m * 16;
                    f32x4 cs0, cs1, sn0, sn1;
                    if (wc == 0) { const float* rp = ropecs + (size_t)row * 32 + 8 * (fq & 1); cs0 = *(const f32x4*)rp; cs1 = *(const f32x4*)(rp + 4); sn0 = *(const f32x4*)(rp + 16); sn1 = *(const f32x4*)(rp + 20);
                        if (fq < 2) { sn0 = -sn0; sn1 = -sn1; } }
#pragma unroll
                    for (int bj = 0; bj < 2; ++bj) { f32x4 v0 = acc[ai][bj][m][0], v1 = acc[ai][bj][m][1];
                        if (wc == 0) { f32x4 p0, p1;
#pragma unroll
                            for (int j = 0; j < 4; ++j) {
                                float a0 = v0[j], b0 = v0[j], a1 = v1[j], b1 = v1[j];
                                asm("s_nop 1\n\tv_permlane32_swap_b32 %0, %1" : "+v"(a0), "+v"(b0)); asm("s_nop 1\n\tv_permlane32_swap_b32 %0, %1" : "+v"(a1), "+v"(b1));
                                p0[j] = (fq < 2) ? b0 : a0; p1[j] = (fq < 2) ? b1 : a1; }
                            v0 = v0 * cs0 + p0 * sn0; v1 = v1 * cs1 + p1 * sn1; }
                        u32x4 w; w.x = cvt_pk_bf16(v0[0], v0[1]); w.y = cvt_pk_bf16(v0[2], v0[3]); w.z = cvt_pk_bf16(v1[0], v1[1]); w.w = cvt_pk_bf16(v1[2], v1[3]);
                        *(u32x4*)(dst + (size_t)row * AW + colt + bj * HALF + wc * 32 + 8 * fq) = w; } }
        } else if (pn < 20) {
            const int colt = (pn - 16) * 256;
#pragma unroll
            for (int ai = 0; ai < 2; ++ai)
#pragma unroll
                for (int m = 0; m < 4; ++m) { const int row = row0 + ai * HALF + m * 16;
#pragma unroll
                    for (int bj = 0; bj < 2; ++bj) { const f32x4 v0 = acc[ai][bj][m][0], v1 = acc[ai][bj][m][1];
                        u32x4 w; w.x = cvt_pk_bf16(v0[0], v0[1]); w.y = cvt_pk_bf16(v0[2], v0[3]); w.z = cvt_pk_bf16(v1[0], v1[1]); w.w = cvt_pk_bf16(v1[2], v1[3]);
                        *(u32x4*)(v + (size_t)row * AW + colt + bj * HALF + wc * 32 + 8 * fq) = w; } }
        } else {
            const int colt = (pn - 20) * 256;
#pragma unroll
            for (int ai = 0; ai < 2; ++ai)
#pragma unroll
                for (int m = 0; m < 4; ++m) { const int row = row0 + ai * HALF + m * 16;
#pragma unroll
                    for (int bj = 0; bj < 2; ++bj) { const f32x4 v0 = acc[ai][bj][m][0], v1 = acc[ai][bj][m][1];
                        u32x4 w; w.x = cvt_pk_bf16_tr(sigm(v0[0]), sigm(v0[1])); w.y = cvt_pk_bf16_tr(sigm(v0[2]), sigm(v0[3])); w.z = cvt_pk_bf16_tr(sigm(v1[0]), sigm(v1[1])); w.w = cvt_pk_bf16_tr(sigm(v1[2]), sigm(v1[3]));
                        *(u32x4*)(sg + (size_t)row * 4096 + colt + bj * HALF + wc * 32 + 8 * fq) = w; } }
        }
    }
};

__device__ __forceinline__ void p3_conv_unit(Frame& F, int unit) {
    const int t0g = unit * 32;
    const int tin = t0g % T;
    float* st = (float*)F.lds;
    {
        const int ch = 2 * F.tid;
        const bf16_t* hg = WSP(bf16_t, WS_HGLU);
        unsigned in[62];
#pragma unroll
        for (int r = 0; r < 62; ++r) { const int tt = tin - 30 + r; const int rr = (tt >= 0) ? (t0g - 30 + r) : t0g; const unsigned v = *(const unsigned*)(hg + (size_t)rr * CC + ch); in[r] = (tt >= 0) ? v : 0u; }
        f32x2 acc[32]; const f32x2 bd = *(const f32x2*)(F.b_dw + ch);
#pragma unroll
        for (int o = 0; o < 32; ++o) acc[o] = bd;
#pragma unroll
        for (int w = 0; w < CW; ++w) { const f32x2 kw = *(const f32x2*)(F.w_dw + w * CC + ch);
#pragma unroll
            for (int o = 0; o < 32; ++o) { const unsigned iv = in[o + w]; acc[o].x += bf_lo(iv) * kw.x; acc[o].y += bf_hi(iv) * kw.y; } }
#pragma unroll
        for (int o = 0; o < 32; ++o) *(f32x2*)(st + o * CC + ch) = acc[o];
    }
    __syncthreads();
#pragma unroll 1
    for (int i = 0; i < 4; ++i) {
        const int o = F.wave * 4 + i; f32x4 v[4]; float s = 0.f;
#pragma unroll
        for (int j = 0; j < 4; ++j) { v[j] = *(const f32x4*)(st + o * CC + 4 * F.lane + 256 * j); s += (v[j].x + v[j].y) + (v[j].z + v[j].w); }
        const float mean = wave_sum(s) * (1.f / CC); float s2 = 0.f;
#pragma unroll
        for (int j = 0; j < 4; ++j) { v[j] = v[j] - mean; s2 += (v[j].x * v[j].x + v[j].y * v[j].y) + (v[j].z * v[j].z + v[j].w * v[j].w); }
        const float rstd = rsqrtf(wave_sum(s2) * (1.f / CC) + EPS);
        u32x2* o8 = (u32x2*)(WSP(bf16_t, WS_HC) + (size_t)(t0g + o) * CC) + F.lane; unsigned* o4 = (unsigned*)(WSP(unsigned char, WS_HC) + (size_t)(t0g + o) * CC) + F.lane;
#pragma unroll
        for (int j = 0; j < 4; ++j) { const int col = 4 * F.lane + 256 * j; const f32x4 g = *(const f32x4*)(F.g_cn + col), bb = *(const f32x4*)(F.b_cn + col);
            const f32x4 y = v[j] * rstd * g + bb;
            if (CONVOUT_FP8) o4[64 * j] = pk4_fp8(silu(y.x) * 16.f, silu(y.y) * 16.f, silu(y.z) * 16.f, silu(y.w) * 16.f);
            else { u32x2 w; w.x = cvt_pk_bf16(silu(y.x), silu(y.y)); w.y = cvt_pk_bf16(silu(y.z), silu(y.w)); o8[64 * j] = w; } }
    }
    __syncthreads();
}
__device__ __forceinline__ void p3_kmean_unit(Frame& F, int unit) {
    const int blk = unit & 15, h = (unit >> 4) & 7, b = unit >> 7;
    const bf16_t* kp = WSP(bf16_t, WS_K) + (size_t)(b * T + blk * MB + F.wave * 32) * AW + h * HD + 2 * F.lane;
    float s0 = 0.f, s1 = 0.f;
#pragma unroll 8
    for (int r = 0; r < 32; ++r) { const unsigned w = *(const unsigned*)(kp + (size_t)r * AW); s0 += bf_lo(w); s1 += bf_hi(w); }
    float* red = (float*)F.lds;
    red[F.wave * 128 + 2 * F.lane] = s0; red[F.wave * 128 + 2 * F.lane + 1] = s1;
    __syncthreads();
    if (F.tid < 128) { float s = 0.f;
#pragma unroll
        for (int w = 0; w < 8; ++w) s += red[w * 128 + F.tid];
        WSP(float, WS_KMEAN)[unit * HD + F.tid] = s * (1.f / MB); }
    __syncthreads();
}
namespace att {
#ifndef ATT_PIPE
#define ATT_PIPE 0
#endif
#ifndef ATT_NOLOOP
#define ATT_NOLOOP 0
#endif
#ifndef ATT_NODMA
#define ATT_NODMA 0
#endif
constexpr float SCALE = 0.088388347648318440f, THR = 8.f, NEGM = -1e37f;
constexpr int SHM_T = 16384;
#define KSWZ(row, colB) ((row) * 256 + ((colB) ^ (((row) & 7) << 4)))
#define SBAR() __builtin_amdgcn_sched_barrier(0)
__device__ __forceinline__ int crow(int r, int hi) { return (r & 3) + 8 * (r >> 2) + 4 * hi; }
__device__ __forceinline__ void partialSM(f32x16& p0, f32x16& p1, float& m_reg, float& mn, float& alpha) {
    constexpr float C = SCALE * 1.4426950408889634f;
    float pmax = p0[0];
#pragma unroll
    for (int r = 1; r < 16; ++r) pmax = fmaxf(pmax, p0[r]);
#pragma unroll
    for (int r = 0; r < 16; ++r) pmax = fmaxf(pmax, p1[r]);
    { auto rr = __builtin_amdgcn_permlane32_swap(__float_as_uint(pmax), __float_as_uint(pmax), false, false); pmax = fmaxf(__uint_as_float(rr[0]), __uint_as_float(rr[1])); }
    if (__builtin_expect(__all(pmax - m_reg <= THR / SCALE), 1)) { mn = m_reg; alpha = 1.f; }
    else { mn = fmaxf(m_reg, pmax); alpha = __builtin_amdgcn_exp2f((m_reg - mn) * C); m_reg = mn; }
    const float mnC = -mn * C;
#pragma unroll
    for (int r = 0; r < 16; ++r) p0[r] = fmaf(p0[r], C, mnC);
#pragma unroll
    for (int r = 0; r < 16; ++r) p1[r] = fmaf(p1[r], C, mnC);
#pragma unroll
    for (int r = 0; r < 16; ++r) p0[r] = __builtin_amdgcn_exp2f(p0[r]);
}
__device__ __forceinline__ float psm_c1(const f32x16& p0) { float pmax = p0[0];
#pragma unroll
    for (int r = 1; r < 16; ++r) pmax = fmaxf(pmax, p0[r]);
    return pmax; }
__device__ __forceinline__ void psm_c2(const f32x16& p1, float pmax, float& m_reg, float& mn, float& alpha) {
    constexpr float C = SCALE * 1.4426950408889634f;
#pragma unroll
    for (int r = 0; r < 16; ++r) pmax = fmaxf(pmax, p1[r]);
    { auto rr = __builtin_amdgcn_permlane32_swap(__float_as_uint(pmax), __float_as_uint(pmax), false, false); pmax = fmaxf(__uint_as_float(rr[0]), __uint_as_float(rr[1])); }
    if (__builtin_expect(__all(pmax - m_reg <= THR / SCALE), 1)) { mn = m_reg; alpha = 1.f; }
    else { mn = fmaxf(m_reg, pmax); alpha = __builtin_amdgcn_exp2f((m_reg - mn) * C); m_reg = mn; } }
__device__ __forceinline__ void psm_c3(f32x16& p0, f32x16& p1, float mn) {
    constexpr float C = SCALE * 1.4426950408889634f; const float mnC = -mn * C;
#pragma unroll
    for (int r = 0; r < 16; ++r) p0[r] = fmaf(p0[r], C, mnC);
#pragma unroll
    for (int r = 0; r < 16; ++r) p1[r] = fmaf(p1[r], C, mnC); }
__device__ __forceinline__ void psm_c4(f32x16& p0) {
#pragma unroll
    for (int r = 0; r < 16; ++r) p0[r] = __builtin_amdgcn_exp2f(p0[r]); }
__device__ __forceinline__ void finishSM(f32x16& p0, f32x16& p1, float alpha, float& l_reg, bf16x8& pa0, bf16x8& pa1, bf16x8& pa2, bf16x8& pa3) {
#pragma unroll
    for (int r = 0; r < 16; ++r) p1[r] = __builtin_amdgcn_exp2f(p1[r]);
    float ps = 0;
#pragma unroll
    for (int r = 0; r < 16; ++r) ps += p0[r];
#pragma unroll
    for (int r = 0; r < 16; ++r) ps += p1[r];
    { auto rr = __builtin_amdgcn_permlane32_swap(__float_as_uint(ps), __float_as_uint(ps), false, false); ps = __uint_as_float(rr[0]) + __uint_as_float(rr[1]); }
    l_reg = l_reg * alpha + ps;
#define PK4(P, BASE, OUT) do { unsigned a0 = cvt_pk_bf16(P[BASE + 0], P[BASE + 1]), a1 = cvt_pk_bf16(P[BASE + 2], P[BASE + 3]);   \
    unsigned b0 = cvt_pk_bf16(P[BASE + 4], P[BASE + 5]), b1 = cvt_pk_bf16(P[BASE + 6], P[BASE + 7]);                              \
    auto r0 = __builtin_amdgcn_permlane32_swap(a0, b0, false, false); auto r1 = __builtin_amdgcn_permlane32_swap(a1, b1, false, false); \
    u32x4 w = {r0[0], r1[0], r0[1], r1[1]}; OUT = *reinterpret_cast<bf16x8*>(&w); } while (0)
    PK4(p0, 0, pa0); PK4(p0, 8, pa1); PK4(p1, 0, pa2); PK4(p1, 8, pa3);
#undef PK4
}
__device__ __forceinline__ void qkt(f32x16& p0, f32x16& p1, const unsigned char* Ks, const bf16x8* qr, int r32, int hi) {
    p0 = f32x16{}; p1 = f32x16{};
#pragma unroll
    for (int d0 = 0; d0 < 8; ++d0) { const int cb = (d0 * 16 + hi * 8) * 2;
        const bf16x8 b0 = *reinterpret_cast<const bf16x8*>(Ks + KSWZ(r32, cb));
        const bf16x8 b1 = *reinterpret_cast<const bf16x8*>(Ks + KSWZ(32 + r32, cb));
        p0 = __builtin_amdgcn_mfma_f32_32x32x16_bf16(b0, qr[d0], p0, 0, 0, 0);
        p1 = __builtin_amdgcn_mfma_f32_32x32x16_bf16(b1, qr[d0], p1, 0, 0, 0); }
}
__device__ __forceinline__ int v_st(int k, int c) { const int kk = (k & ~0xC) | ((k & 4) << 1) | ((k & 8) >> 1); return ((kk >> 3) * 4 + (c >> 5)) * 512 + ((kk & 7) * 32 + (c & 31)) * 2; }
__device__ __forceinline__ int v_rd_base(int lane) { return ((lane & 3) << 3) | (((lane >> 2) & 3) << 6) | (((lane >> 4) & 1) << 5) | (((lane >> 5) & 1) << 8); }
constexpr int v_rd_off(int d0, int ks, int half) { return d0 * 512 + ks * 4096 + half * 2048; }
template <int OFF> __device__ __forceinline__ s16x4 tr_read(int vb) { s16x4 r; asm volatile("ds_read_b64_tr_b16 %0, %1 offset:%2" : "=&v"(r) : "v"(vb), "i"(OFF) : "memory"); return r; }
template <int D0> __device__ __forceinline__ void pv_one(f32x16& od, int vb, bf16x8 pa0, bf16x8 pa1, bf16x8 pa2, bf16x8 pa3) {
    const s16x4 l0 = tr_read<v_rd_off(D0, 0, 0)>(vb), h0 = tr_read<v_rd_off(D0, 0, 1)>(vb), l1 = tr_read<v_rd_off(D0, 1, 0)>(vb), h1 = tr_read<v_rd_off(D0, 1, 1)>(vb);
    const s16x4 l2 = tr_read<v_rd_off(D0, 2, 0)>(vb), h2 = tr_read<v_rd_off(D0, 2, 1)>(vb), l3 = tr_read<v_rd_off(D0, 3, 0)>(vb), h3 = tr_read<v_rd_off(D0, 3, 1)>(vb);
    asm volatile("s_waitcnt lgkmcnt(0)" ::: "memory"); SBAR();
#define PK(L, H) (bf16x8){L[0], L[1], L[2], L[3], H[0], H[1], H[2], H[3]}
    od = __builtin_amdgcn_mfma_f32_32x32x16_bf16(pa0, PK(l0, h0), od, 0, 0, 0);
    od = __builtin_amdgcn_mfma_f32_32x32x16_bf16(pa1, PK(l1, h1), od, 0, 0, 0);
    od = __builtin_amdgcn_mfma_f32_32x32x16_bf16(pa2, PK(l2, h2), od, 0, 0, 0);
    od = __builtin_amdgcn_mfma_f32_32x32x16_bf16(pa3, PK(l3, h3), od, 0, 0, 0);
#undef PK
}
__device__ __forceinline__ void pv_d0(f32x16* o, int vb, bf16x8 pa0, bf16x8 pa1, bf16x8 pa2, bf16x8 pa3) {
    pv_one<0>(o[0], vb, pa0, pa1, pa2, pa3); pv_one<1>(o[1], vb, pa0, pa1, pa2, pa3); pv_one<2>(o[2], vb, pa0, pa1, pa2, pa3); pv_one<3>(o[3], vb, pa0, pa1, pa2, pa3);
}
__device__ __forceinline__ void qkt_b(f32x16& p0, f32x16& p1, const unsigned char* Ks, const bf16x8* qr, int r32, int hi) {
    p0 = f32x16{}; p1 = f32x16{};
#pragma unroll
    for (int hb = 0; hb < 2; ++hb) {
        bf16x8 kf[8];
#pragma unroll
        for (int d = 0; d < 4; ++d) { const int cb = ((4 * hb + d) * 16 + hi * 8) * 2;
            kf[2 * d] = *reinterpret_cast<const bf16x8*>(Ks + KSWZ(r32, cb)); kf[2 * d + 1] = *reinterpret_cast<const bf16x8*>(Ks + KSWZ(32 + r32, cb)); }
        asm volatile("s_waitcnt lgkmcnt(0)" ::: "memory"); SBAR();
#pragma unroll
        for (int d = 0; d < 4; ++d) { p0 = __builtin_amdgcn_mfma_f32_32x32x16_bf16(kf[2 * d], qr[4 * hb + d], p0, 0, 0, 0); p1 = __builtin_amdgcn_mfma_f32_32x32x16_bf16(kf[2 * d + 1], qr[4 * hb + d], p1, 0, 0, 0); }
        SBAR();
    }
}
struct VHalf { s16x4 l[2][4], h[2][4]; };
template <int DB> __device__ __forceinline__ void v_issue(VHalf& f, int vb) {
#define VRD(D0, KS) f.l[D0][KS] = tr_read<v_rd_off(DB + D0, KS, 0)>(vb); f.h[D0][KS] = tr_read<v_rd_off(DB + D0, KS, 1)>(vb);
    VRD(0, 0) VRD(0, 1) VRD(0, 2) VRD(0, 3) VRD(1, 0) VRD(1, 1) VRD(1, 2) VRD(1, 3)
#undef VRD
}
template <int WAITN> __device__ __forceinline__ void pv_h(f32x16& oa, f32x16& ob, const VHalf& f, bf16x8 pa0, bf16x8 pa1, bf16x8 pa2, bf16x8 pa3) {
    if (!WAITN) asm volatile("s_waitcnt lgkmcnt(0)" ::: "memory");
    SBAR();
#define PK(L, H) (bf16x8){L[0], L[1], L[2], L[3], H[0], H[1], H[2], H[3]}
    oa = __builtin_amdgcn_mfma_f32_32x32x16_bf16(pa0, PK(f.l[0][0], f.h[0][0]), oa, 0, 0, 0); ob = __builtin_amdgcn_mfma_f32_32x32x16_bf16(pa0, PK(f.l[1][0], f.h[1][0]), ob, 0, 0, 0);
    oa = __builtin_amdgcn_mfma_f32_32x32x16_bf16(pa1, PK(f.l[0][1], f.h[0][1]), oa, 0, 0, 0); ob = __builtin_amdgcn_mfma_f32_32x32x16_bf16(pa1, PK(f.l[1][1], f.h[1][1]), ob, 0, 0, 0);
    oa = __builtin_amdgcn_mfma_f32_32x32x16_bf16(pa2, PK(f.l[0][2], f.h[0][2]), oa, 0, 0, 0); ob = __builtin_amdgcn_mfma_f32_32x32x16_bf16(pa2, PK(f.l[1][2], f.h[1][2]), ob, 0, 0, 0);
    oa = __builtin_amdgcn_mfma_f32_32x32x16_bf16(pa3, PK(f.l[0][3], f.h[0][3]), oa, 0, 0, 0); ob = __builtin_amdgcn_mfma_f32_32x32x16_bf16(pa3, PK(f.l[1][3], f.h[1][3]), ob, 0, 0, 0);
#undef PK
}
__device__ __forceinline__ void amask(f32x16& p0, f32x16& p1, int tau, int iblk, unsigned selmask, int qin, int hi) {
    const int j = tau >> 2;
    if (j < iblk) { const bool ok = (selmask >> j) & 1u;
#pragma unroll
        for (int r = 0; r < 16; ++r) { p0[r] = ok ? p0[r] : NEGM; p1[r] = ok ? p1[r] : NEGM; }
    } else { const int kb = 64 * (tau & 3) + 4 * hi;
#pragma unroll
        for (int r = 0; r < 16; ++r) { const int kv = kb + (r & 3) + 8 * (r >> 2); p0[r] = (kv > qin) ? NEGM : p0[r]; p1[r] = (kv + 32 > qin) ? NEGM : p1[r]; } }
}
__device__ __forceinline__ void attn_unit(Frame& F, LAS unsigned char* ring, int b, int h, int iblk, int half) {
    const int tid = F.tid, wid = F.wave, lane = F.lane, r32 = lane & 31, hi = lane >> 5, grp = wid >> 2, wq = wid & 3;
    unsigned char* lds = F.lds; unsigned char* misc = lds + LDS_MISC;
    float* wsf = (float*)misc + wid * 64; float* li_l = wsf; float* al_l = wsf + 32;
    float* kml = (float*)(misc + 2048);
    const bf16_t* Qg = WSP(bf16_t, WS_Q); const bf16_t* Kg = WSP(bf16_t, WS_K); const bf16_t* Vg = WSP(bf16_t, WS_V);
    const size_t rowb = (size_t)b * T;
    { const float* km = WSP(float, WS_KMEAN) + (size_t)(b * NH + h) * NBLK * HD; *(f32x4*)(kml + tid * 4) = *(const f32x4*)(km + tid * 4); }
    const int qin = half * 128 + wq * 32 + r32;
    const bf16_t* Qw = Qg + (rowb + iblk * MB + qin) * AW + h * HD + hi * 8;
    bf16x8 qr[8];
#pragma unroll
    for (int d0 = 0; d0 < 8; ++d0) qr[d0] = __builtin_nontemporal_load(reinterpret_cast<const bf16x8*>(Qw + d0 * 16));
    __syncthreads();
    unsigned selmask = 0;
    {
        float* gl = (float*)lds + wid * 1024;
#pragma unroll 2
        for (int j = 0; j < iblk; ++j) { float g = 0.f; const float* kj = kml + j * HD + hi * 8;
#pragma unroll
            for (int d0 = 0; d0 < 8; ++d0) { const f32x4 k0 = *(const f32x4*)(kj + d0 * 16), k1 = *(const f32x4*)(kj + d0 * 16 + 4);
#define QF(e) __uint_as_float(((unsigned)(unsigned short)qr[d0][e]) << 16)
                g += (QF(0) * k0[0] + QF(1) * k0[1]) + (QF(2) * k0[2] + QF(3) * k0[3]) + (QF(4) * k1[0] + QF(5) * k1[1]) + (QF(6) * k1[2] + QF(7) * k1[3]);
#undef QF
            }
            { float a = g, b = g; asm("s_nop 1\n\tv_permlane32_swap_b32 %0, %1" : "+v"(a), "+v"(b)); g = a + b; }
            gl[j * 64 + lane] = g; }
        float gv[16];
#pragma unroll
        for (int j = 0; j < 16; ++j) { const float g = gl[j * 64 + lane]; gv[j] = (j < iblk) ? g : -INFINITY; }
#pragma unroll
        for (int sidx = 0; sidx < 3; ++sidx) { int best = -1; float bv = -INFINITY;
#pragma unroll
            for (int j = 0; j < 16; ++j) { const bool c = !((selmask >> j) & 1u) && (gv[j] > bv); bv = c ? gv[j] : bv; best = c ? j : best; }
            if (best >= 0) selmask |= 1u << best; }
    }
    __syncthreads();
    unsigned char* V_lds = lds; unsigned char* K_lds = lds + 4 * SHM_T;
    float m_reg = -1e30f, l_reg = 0; f32x16 o[4] = {};
    const bf16_t* Kh = Kg + rowb * AW + h * HD; const bf16_t* Vh = Vg + rowb * AW + h * HD;
    const int vb0 = (int)(uintptr_t)(V_lds + grp * SHM_T) + v_rd_base(lane);
    const char* Kb = (const char*)Kh; const char* Vb = (const char*)Vh;
    unsigned koff[2], voff[2];
#pragma unroll
    for (int i = 0; i < 2; ++i) { const int p = 4 * wq + i;
        const int row = 4 * p + (lane >> 4), cK = (lane & 15) ^ (row & 7); koff[i] = (unsigned)(((64 * grp + row) * AW + 8 * cK) * 2);
        const int sbt = 2 * p + (lane >> 5), kk = (sbt >> 2) * 8 + ((lane & 31) >> 2), kv = (kk & ~0xC) | ((kk & 4) << 1) | ((kk & 8) >> 1), cV = (sbt & 3) * 32 + 8 * (lane & 3);
        voff[i] = (unsigned)(((64 * grp + kv) * AW + cV) * 2); }
#define DMA_K(bf, step) do { _Pragma("unroll") for (int i_ = 0; i_ < 4; ++i_) { unsigned o_ = koff[i_ & 1] + (i_ >> 1) * 16384u; asm volatile("" : "+v"(o_)); __builtin_amdgcn_global_load_lds((const unsigned*)(Kb + (size_t)(step) * 128 * AW * 2 + o_), \
        (LAS unsigned*)(ring + 4 * SHM_T + ((bf) * 2 + grp) * SHM_T + (4 * wq + i_) * 1024), 16, 0, 0); } } while (0)
#define DMA_V(bf, step) do { _Pragma("unroll") for (int i_ = 0; i_ < 4; ++i_) { unsigned o_ = voff[i_ & 1] + (i_ >> 1) * 8192u; asm volatile("" : "+v"(o_)); __builtin_amdgcn_global_load_lds((const unsigned*)(Vb + (size_t)(step) * 128 * AW * 2 + o_), \
        (LAS unsigned*)(ring + ((bf) * 2 + grp) * SHM_T + (4 * wq + i_) * 1024), 16, 0, 0); } } while (0)
#define WAITB() do { asm volatile("s_waitcnt vmcnt(0) lgkmcnt(0)" ::: "memory"); __builtin_amdgcn_s_barrier(); asm volatile("" ::: "memory"); } while (0)
#define RESC(a) do { if (__any((a) < 1.f)) { if (hi == 0) al_l[r32] = (a); asm volatile("s_waitcnt lgkmcnt(0)" ::: "memory"); \
    _Pragma("unroll") for (int d = 0; d < 4; ++d) _Pragma("unroll") for (int r = 0; r < 16; ++r) o[d][r] *= al_l[crow(r, hi)]; } } while (0)
#define KBUF(bf) (K_lds + ((bf) * 2 + grp) * SHM_T)
#define MASK(P0, P1, s) amask(P0, P1, 2 * (s) + grp, iblk, selmask, qin, hi)
    f32x16 pA0, pA1, pB0, pB1; float mnA, mnB, alA, alB; bf16x8 pa0, pa1, pa2, pa3; const int NT = 2 * (iblk + 1);
#if ATT_PIPE == 1
    DMA_K(0, 0); DMA_V(0, 0); DMA_K(1, 1); DMA_V(1, 1);
    WAITB();
    qkt(pA0, pA1, KBUF(0), qr, r32, hi); MASK(pA0, pA1, 0); partialSM(pA0, pA1, m_reg, mnA, alA);
    WAITB();
#pragma unroll 1
    for (int j = 1; j + 1 < NT; j += 2) {
        DMA_K(0, j + 1);
        SBAR(); qkt(pB0, pB1, KBUF(1), qr, r32, hi);
        finishSM(pA0, pA1, alA, l_reg, pa0, pa1, pa2, pa3); SBAR();
        pv_d0(o, vb0, pa0, pa1, pa2, pa3); MASK(pB0, pB1, j); partialSM(pB0, pB1, m_reg, mnB, alB);
        WAITB();
        DMA_V(0, j + 1);
        RESC(alB);
        DMA_K(1, j + 2);
        SBAR(); qkt(pA0, pA1, KBUF(0), qr, r32, hi);
        finishSM(pB0, pB1, alB, l_reg, pa0, pa1, pa2, pa3); SBAR();
        pv_d0(o, vb0 + 2 * SHM_T, pa0, pa1, pa2, pa3); MASK(pA0, pA1, j + 1); partialSM(pA0, pA1, m_reg, mnA, alA);
        WAITB();
        DMA_V(1, j + 2);
        RESC(alA);
    }
    SBAR(); qkt(pB0, pB1, KBUF(1), qr, r32, hi);
    finishSM(pA0, pA1, alA, l_reg, pa0, pa1, pa2, pa3); SBAR();
    pv_d0(o, vb0, pa0, pa1, pa2, pa3); MASK(pB0, pB1, NT - 1); partialSM(pB0, pB1, m_reg, mnB, alB);
    WAITB(); RESC(alB);
    finishSM(pB0, pB1, alB, l_reg, pa0, pa1, pa2, pa3); SBAR();
    pv_d0(o, vb0 + 2 * SHM_T, pa0, pa1, pa2, pa3);
#elif ATT_PIPE == 2
    DMA_K(0, 0);
    WAITB();
    DMA_K(1, 1); DMA_V(0, 0);
    qkt(pA0, pA1, KBUF(0), qr, r32, hi); MASK(pA0, pA1, 0); partialSM(pA0, pA1, m_reg, mnA, alA);
#pragma unroll 1
    for (int st = 1; st < NT; ++st) {
        const int bf = st & 1;
        WAITB();
        if (st + 1 < NT) DMA_K(bf ^ 1, st + 1);
        DMA_V(bf, st);
        RESC(alA);
        finishSM(pA0, pA1, alA, l_reg, pa0, pa1, pa2, pa3); SBAR();
        qkt(pA0, pA1, KBUF(bf), qr, r32, hi);
        const int vbp = vb0 + (bf ^ 1) * 2 * SHM_T;
        pv_one<0>(o[0], vbp, pa0, pa1, pa2, pa3); MASK(pA0, pA1, st); float pmx = psm_c1(pA0);
        pv_one<1>(o[1], vbp, pa0, pa1, pa2, pa3); psm_c2(pA1, pmx, m_reg, mnA, alA);
        pv_one<2>(o[2], vbp, pa0, pa1, pa2, pa3); psm_c3(pA0, pA1, mnA);
        pv_one<3>(o[3], vbp, pa0, pa1, pa2, pa3); psm_c4(pA0);
    }
    WAITB();
    RESC(alA);
    finishSM(pA0, pA1, alA, l_reg, pa0, pa1, pa2, pa3); SBAR();
    pv_d0(o, vb0 + ((NT - 1) & 1) * 2 * SHM_T, pa0, pa1, pa2, pa3);
#else
    DMA_K(0, 0); DMA_V(0, 0);
#pragma unroll 1
    for (int st = 0; st < NT; st += (ATT_NOLOOP ? 2 : 1)) {
        const int bf = st & 1;
        WAITB();
        if (st + 1 < NT && (!ATT_NODMA || st == 0)) { DMA_K(bf ^ 1, st + 1); DMA_V(bf ^ 1, st + 1); }
        qkt_b(pA0, pA1, KBUF(bf), qr, r32, hi);
        const int vbs = vb0 + bf * 2 * SHM_T;
        MASK(pA0, pA1, st); partialSM(pA0, pA1, m_reg, mnA, alA);
        RESC(alA);
        finishSM(pA0, pA1, alA, l_reg, pa0, pa1, pa2, pa3); SBAR();
        pv_d0(o, vbs, pa0, pa1, pa2, pa3);

    }
#endif
#undef DMA_K
#undef DMA_V
#undef WAITB
#undef RESC
#undef KBUF
#undef MASK
    __syncthreads();
    int lane_e; asm volatile("v_mbcnt_lo_u32_b32 %0, -1, 0\n\tv_mbcnt_hi_u32_b32 %0, -1, %0" : "=&v"(lane_e));
    const int r32e = lane_e & 31, hie = lane_e >> 5;
    float* obuf = (float*)lds;
    float* ml = (float*)(misc + 10240);
    if (grp == 1) {
#pragma unroll
        for (int d = 0; d < 4; ++d)
#pragma unroll
            for (int r = 0; r < 16; ++r) obuf[(wq * 64 + d * 16 + r) * 64 + lane_e] = o[d][r];
        if (hie == 0) { ml[wq * 64 + r32e] = m_reg; ml[wq * 64 + 32 + r32e] = l_reg; }
    }
    __syncthreads();
    if (grp == 0) {
        constexpr float C = SCALE * 1.4426950408889634f;
        const float m1 = ml[wq * 64 + r32e], l1 = ml[wq * 64 + 32 + r32e];
        const float M = fmaxf(m_reg, m1), f0 = __builtin_amdgcn_exp2f((m_reg - M) * C), f1 = __builtin_amdgcn_exp2f((m1 - M) * C);
        const float linv = 1.f / (l_reg * f0 + l1 * f1);
        if (hie == 0) { li_l[r32e] = f0 * linv; al_l[r32e] = f1 * linv; }
        asm volatile("s_waitcnt lgkmcnt(0)" ::: "memory");
        unsigned char* stg = lds + 65536 + wq * 4096;
#pragma unroll
        for (int r = 0; r < 16; ++r) { const int orow = crow(r, hie); const float a0 = li_l[orow], a1 = al_l[orow];
#pragma unroll
            for (int d = 0; d < 4; ++d) { const float v = (o[d][r] * a0 + obuf[(wq * 64 + d * 16 + r) * 64 + lane_e] * a1) * 16.f; stg[orow * 128 + d * 32 + r32e] = (unsigned char)(__builtin_amdgcn_cvt_pk_fp8_f32(v, 0.f, 0, false) & 0xff);     } }
        asm volatile("s_waitcnt lgkmcnt(0)" ::: "memory");
        unsigned char* Ow = WSP(unsigned char, WS_AO) + (rowb + iblk * MB + half * 128 + wq * 32) * AW + h * HD;
#pragma unroll
        for (int i = 0; i < 4; ++i) { const int row = i * 8 + (lane_e >> 3), ch = lane_e & 7; const u32x4 v = *(const u32x4*)(stg + row * 128 + ch * 16); *(u32x4*)(Ow + (size_t)row * AW + ch * 16) = v; }
    }
    __syncthreads();
}
#undef KSWZ
#undef SBAR
}

struct EpiConvOut {
    static constexpr bool PERM = true;
    const float* bias; const bf16_t* sg; bf16_t* m1;
    __device__ __forceinline__ void operator()(const f32x4 (&acc)[2][2][4][2], const Unit& u, int wr, int wc, int fr, int fq) const {
        const int row0 = u.pm * BM + wr * 64 + fr, col0 = u.pn * BM + wc * 32 + 8 * fq;
#pragma unroll
        for (int bj = 0; bj < 2; ++bj) { const int col = col0 + bj * HALF; const f32x4 b0 = *(const f32x4*)(bias + col), b1 = *(const f32x4*)(bias + col + 4);
#pragma unroll
            for (int ai = 0; ai < 2; ++ai)
#pragma unroll
                for (int m = 0; m < 4; ++m) { const int row = row0 + ai * HALF + m * 16; const u32x4 g = *(const u32x4*)(sg + (size_t)row * 4096 + col);
                    const f32x4 v0 = acc[ai][bj][m][0] + b0, v1 = acc[ai][bj][m][1] + b1; u32x4 w;
                    w.x = cvt_pk_bf16(v0[0] * bf_lo(g.x), v0[1] * bf_hi(g.x)); w.y = cvt_pk_bf16(v0[2] * bf_lo(g.y), v0[3] * bf_hi(g.y));
                    w.z = cvt_pk_bf16(v1[0] * bf_lo(g.z), v1[1] * bf_hi(g.z)); w.w = cvt_pk_bf16(v1[2] * bf_lo(g.w), v1[3] * bf_hi(g.w));
                    *(u32x4*)(m1 + (size_t)row * D + col) = w; } }
    }
};
struct EpiAttnOut {
    static constexpr bool PERM = true;
    const bf16_t* sg; const bf16_t* m1; bf16_t* merged;
    __device__ __forceinline__ void operator()(const f32x4 (&acc)[2][2][4][2], const Unit& u, int wr, int wc, int fr, int fq) const {
        const int row0 = u.pm * BM + wr * 64 + fr, col0 = u.pn * BM + wc * 32 + 8 * fq;
#pragma unroll
        for (int bj = 0; bj < 2; ++bj) { const int col = col0 + bj * HALF;
#pragma unroll
            for (int ai = 0; ai < 2; ++ai)
#pragma unroll
                for (int m = 0; m < 4; ++m) { const int row = row0 + ai * HALF + m * 16; const u32x4 g = *(const u32x4*)(sg + (size_t)row * 4096 + D + col); const u32x4 p = __builtin_nontemporal_load((const u32x4*)(m1 + (size_t)row * D + col));
                    const f32x4 v0 = acc[ai][bj][m][0], v1 = acc[ai][bj][m][1];
                    if (MIX_FP8) {
                        const float s = 16.f; u32x2 w8;
                        w8.x = pk4_fp8((bf_lo(p.x) + v0[0] * bf_lo(g.x)) * s, (bf_hi(p.x) + v0[1] * bf_hi(g.x)) * s, (bf_lo(p.y) + v0[2] * bf_lo(g.y)) * s, (bf_hi(p.y) + v0[3] * bf_hi(g.y)) * s);
                        w8.y = pk4_fp8((bf_lo(p.z) + v1[0] * bf_lo(g.z)) * s, (bf_hi(p.z) + v1[1] * bf_hi(g.z)) * s, (bf_lo(p.w) + v1[2] * bf_lo(g.w)) * s, (bf_hi(p.w) + v1[3] * bf_hi(g.w)) * s);
                        *(u32x2*)((unsigned char*)merged + (size_t)row * D + col) = w8;
                    } else { u32x4 w;
                        w.x = cvt_pk_bf16(bf_lo(p.x) + v0[0] * bf_lo(g.x), bf_hi(p.x) + v0[1] * bf_hi(g.x)); w.y = cvt_pk_bf16(bf_lo(p.y) + v0[2] * bf_lo(g.y), bf_hi(p.y) + v0[3] * bf_hi(g.y));
                        w.z = cvt_pk_bf16(bf_lo(p.z) + v1[0] * bf_lo(g.z), bf_hi(p.z) + v1[1] * bf_hi(g.z)); w.w = cvt_pk_bf16(bf_lo(p.w) + v1[2] * bf_lo(g.w), bf_hi(p.w) + v1[3] * bf_hi(g.w));
                        *(u32x4*)(merged + (size_t)row * D + col) = w; } } }
    }
};
struct EpiMix {
    static constexpr bool PERM = true;
    const float* modf; bf16_t* tg;
    __device__ __forceinline__ void operator()(const f32x4 (&acc)[2][2][4][2], const Unit& u, int wr, int wc, int fr, int fq) const {
        const int row0 = u.pm * BM + wr * 64 + fr, col0 = u.pn * BM + wc * 32 + 8 * fq; const int b = (u.pm * BM) / T;
#pragma unroll
        for (int bj = 0; bj < 2; ++bj) { const int col = col0 + bj * HALF; const f32x4 g0 = *(const f32x4*)(modf + (size_t)b * 6 * D + 2 * D + col) + 1.f, g1 = *(const f32x4*)(modf + (size_t)b * 6 * D + 2 * D + col + 4) + 1.f;
#pragma unroll
            for (int ai = 0; ai < 2; ++ai)
#pragma unroll
                for (int m = 0; m < 4; ++m) { const f32x4 v0 = acc[ai][bj][m][0] * g0, v1 = acc[ai][bj][m][1] * g1; u32x4 w;
                    w.x = cvt_pk_bf16(v0[0], v0[1]); w.y = cvt_pk_bf16(v0[2], v0[3]); w.z = cvt_pk_bf16(v1[0], v1[1]); w.w = cvt_pk_bf16(v1[2], v1[3]);
                    *(u32x4*)(tg + (size_t)(row0 + ai * HALF + m * 16) * D + col) = w; } }
    }
};
template <bool OUT8> struct EpiMoeUpT {
    static constexpr bool PERM = true;
    const float* wl; unsigned char* hbuf;
    __device__ __forceinline__ void operator()(const f32x4 (&acc)[2][2][4][2], const Unit& u, int wr, int wc, int fr, int fq) const {
        const int rl0 = wr * 64 + fr, col = u.pn * 128 + wc * 32 + 8 * fq;
        float wrows[2][4];
#pragma unroll
        for (int ai = 0; ai < 2; ++ai)
#pragma unroll
            for (int m = 0; m < 4; ++m) { const int rl = rl0 + ai * HALF + m * 16; wrows[ai][m] = (rl < u.nrow) ? wl[(size_t)u.e * NTOK + u.pm * 256 + rl] : 0.f; }
#pragma unroll
        for (int ai = 0; ai < 2; ++ai)
#pragma unroll
            for (int m = 0; m < 4; ++m) { const int rl = rl0 + ai * HALF + m * 16; if (rl < u.nrow) { const float wrow = wrows[ai][m];
                const f32x4 a0 = acc[ai][0][m][0], a1 = acc[ai][0][m][1], g0 = acc[ai][1][m][0], g1 = acc[ai][1][m][1];
                float h[8]; const float wsc = OUT8 ? wrow * 8.f : wrow;
#pragma unroll
                for (int j = 0; j < 4; ++j) { h[j] = silu(a0[j]) * g0[j] * wsc; h[4 + j] = silu(a1[j]) * g1[j] * wsc; }
                if constexpr (OUT8) { u32x2 w; w.x = pk4_fp8(h[0], h[1], h[2], h[3]); w.y = pk4_fp8(h[4], h[5], h[6], h[7]); *(u32x2*)(hbuf + (size_t)(u.rbase + rl) * FF + col) = w; }
                else { u32x4 w; w.x = cvt_pk_bf16(h[0], h[1]); w.y = cvt_pk_bf16(h[2], h[3]); w.z = cvt_pk_bf16(h[4], h[5]); w.w = cvt_pk_bf16(h[6], h[7]); *(u32x4*)(hbuf + ((size_t)(u.rbase + rl) * FF + col) * 2) = w; } } }
    }
};
struct EpiMoeDown {
    static constexpr bool PERM = true;
    unsigned char* ypair;
    __device__ __forceinline__ void operator()(const f32x4 (&acc)[2][2][4][2], const Unit& u, int wr, int wc, int fr, int fq) const {
        const int rl0 = wr * 64 + fr, col0 = u.pn * BM + wc * 32 + 8 * fq;
#pragma unroll
        for (int ai = 0; ai < 2; ++ai)
#pragma unroll
            for (int m = 0; m < 4; ++m) { const int rl = rl0 + ai * HALF + m * 16; if (rl < u.nrow) {
#pragma unroll
                for (int bj = 0; bj < 2; ++bj) { const f32x4 v0 = acc[ai][bj][m][0], v1 = acc[ai][bj][m][1]; u32x2 w;
                    w.x = pk4_fp8(v0[0], v0[1], v0[2], v0[3]); w.y = pk4_fp8(v1[0], v1[1], v1[2], v1[3]);
                    *(u32x2*)(ypair + (size_t)(u.rbase + rl) * D + col0 + bj * HALF) = w; } } }
    }
};

__device__ __forceinline__ void moe_tables(Frame& F, int* ts, int* cn) {
    if (F.wave == 0) {
        int c = 0; if (F.lane < 32) c = (int)__hip_atomic_load(WSP(unsigned, WS_CTL) + CW_CNT + F.lane, __ATOMIC_RELAXED, __HIP_MEMORY_SCOPE_AGENT);
        const int t = (c + 255) >> 8; int s = t;
#pragma unroll
        for (int d = 1; d < 32; d <<= 1) { const int o = __shfl_up(s, d); s += (F.lane >= d) ? o : 0; }
        if (F.lane < 32) { cn[F.lane] = c; ts[F.lane] = s - t; }
        if (F.lane == 31) ts[32] = s;
    }
    __syncthreads();
}
template <bool F8> struct MoeSchedT {
    static constexpr bool HALFSKIP = false, FP8 = F8; static constexpr int SCALE_B = 0x79797979;
    static constexpr int ESZ = F8 ? 1 : 2;
    const char* A; const char* W; const int* tokl; const int* ts; const int* cn; int G, c, K, ntn, tid; bool gather; size_t wexp; int scale_a = 0x7f7f7f7f;
    __device__ void init(const void* A_, const void* W_, const int* tokl_, const int* ts_, const int* cn_, int G_, int c_, int K_, int ntn_, bool gather_, int tid_) {
        A = (const char*)A_; W = (const char*)W_; tokl = tokl_; ts = ts_; cn = cn_; G = G_; c = c_; K = K_; ntn = ntn_; gather = gather_; wexp = (size_t)ntn * 256 * K * ESZ;
        tid = tid_;
    }
    __device__ bool next(int i, Unit& u) const {
        const int uidx = i * G + c; if (uidx >= ts[32] * ntn) return false;
        const int gmt = uidx / ntn, nt = uidx % ntn; int e = 0;
        for (int k = 1; k < 32; ++k) e += (ts[k] <= gmt) ? 1 : 0;
        const int mt = gmt - ts[e], cnt = cn[e];
        u.e = e; u.pm = mt; u.pn = nt; u.nrow = (cnt - 256 * mt < 256) ? cnt - 256 * mt : 256; u.rbase = 256 * gmt;
        u.Bb = W + (size_t)e * wexp + (size_t)nt * 256 * K * ESZ;
        int R[2], C[2];
#pragma unroll
        for (int i = 0; i < 2; ++i) stage_rc(tid * 16 + i * 8192, R[i], C[i]);
        if (gather) { u.Ab = A;
#pragma unroll
            for (int h = 0; h < 2; ++h)
#pragma unroll
                for (int p = 0; p < 2; ++p) { int r = 256 * mt + 128 * h + R[p]; r = (r < cnt) ? r : cnt - 1; const int tok = tokl[(size_t)e * NTOK + r]; u.ao[h * 2 + p] = (unsigned)(tok * K * ESZ + C[p] * 2); }
        } else { u.Ab = A + (size_t)256 * gmt * K * ESZ; const unsigned hs = (unsigned)HALF * K * ESZ;
            u.ao[0] = (unsigned)(R[0] * K * ESZ + C[0] * 2); u.ao[1] = (unsigned)(R[1] * K * ESZ + C[1] * 2); u.ao[2] = u.ao[0] + hs; u.ao[3] = u.ao[1] + hs; }
        return true;
    }
};

__device__ __forceinline__ float dot4(const f32x4 a, const f32x4 b) { return (a.x * b.x + a.y * b.y) + (a.z * b.z + a.w * b.w); }
__device__ __forceinline__ void p7_rows(Frame& F, LAS unsigned char* ring) {
    int* cnt_l = (int*)(F.lds + LDS_MISC); int* base_l = cnt_l + 32; int* rowinfo = cnt_l + 64;
    float* roww = (float*)(cnt_l + 128);
    const float* wrt = WSP(float, WS_WRT);
    const int r0 = F.vcu * 32, b = r0 / T;
    if (F.tid < 32) cnt_l[F.tid] = 0;
    const char* wrtb = (const char*)wrt;
#define DMA_G(buf) do { _Pragma("unroll") for (int i_ = 0; i_ < 4; ++i_) { const int piece = F.wave * 4 + i_; unsigned o_ = (unsigned)(piece * 1024 + F.lane * 16); asm volatile("" : "+v"(o_)); \
        __builtin_amdgcn_global_load_lds((const unsigned*)(wrtb + o_), (LAS unsigned*)(ring + (buf) * 32768 + piece * 1024), 16, 0, 0); } } while (0)
#define DMA_E(buf, j) do { _Pragma("unroll") for (int i_ = 0; i_ < 4; ++i_) { const int o = F.wave * 4 + i_; unsigned o_ = (unsigned)(((4 + o) * D + 256 * (j)) * 4 + F.lane * 16); asm volatile("" : "+v"(o_)); \
        __builtin_amdgcn_global_load_lds((const unsigned*)(wrtb + o_), (LAS unsigned*)(ring + (buf) * 32768 + o * 1024), 16, 0, 0); } } while (0)
    DMA_G(0); DMA_E(1, 0);
    const float* modf = WSP(float, WS_MODF) + (size_t)b * 6 * D;
    const int rw0 = r0 + F.wave * 4;
    LAS unsigned char* u2s = ring + 65536 + F.wave * 8192;
    f32x4 nxa[8], nxb[8];
#pragma unroll
    for (int ip = 0; ip < 2; ++ip) {
        {
        f32x4 va[8], vb[8]; float sa = 0.f, sb = 0.f;
        const int rowa = rw0 + 2 * ip, rowb = rowa + 1;
        const f32x4* pa = (const f32x4*)(F.x + (size_t)rowa * D) + F.lane; const f32x4* pb = (const f32x4*)(F.x + (size_t)rowb * D) + F.lane;
        const u32x2* ta = (const u32x2*)(WSP(bf16_t, WS_VPRE) + (size_t)rowa * D) + F.lane; const u32x2* tb = (const u32x2*)(WSP(bf16_t, WS_VPRE) + (size_t)rowb * D) + F.lane;
        if (ip == 0) {
#pragma unroll
        for (int j = 0; j < 8; ++j) { const u32x2 qa = __builtin_nontemporal_load(ta + 64 * j), qb = __builtin_nontemporal_load(tb + 64 * j);
            va[j] = __builtin_nontemporal_load(pa + 64 * j) * ALPHA + (f32x4){bf_lo(qa.x), bf_hi(qa.x), bf_lo(qa.y), bf_hi(qa.y)}; vb[j] = __builtin_nontemporal_load(pb + 64 * j) * ALPHA + (f32x4){bf_lo(qb.x), bf_hi(qb.x), bf_lo(qb.y), bf_hi(qb.y)}; }
        asm volatile("" ::: "memory");
#pragma unroll
        for (int j = 0; j < 8; ++j) { nxa[j] = __builtin_nontemporal_load(pa + 2 * (D / 4) + 64 * j); nxb[j] = __builtin_nontemporal_load(pb + 2 * (D / 4) + 64 * j); }
        asm volatile("" ::: "memory");
        } else {
#pragma unroll
        for (int j = 0; j < 8; ++j) { const u32x2 qa = __builtin_nontemporal_load(ta + 64 * j), qb = __builtin_nontemporal_load(tb + 64 * j);
            va[j] = nxa[j] * ALPHA + (f32x4){bf_lo(qa.x), bf_hi(qa.x), bf_lo(qa.y), bf_hi(qa.y)}; vb[j] = nxb[j] * ALPHA + (f32x4){bf_lo(qb.x), bf_hi(qb.x), bf_lo(qb.y), bf_hi(qb.y)}; }
        }
#pragma unroll
        for (int j = 0; j < 8; ++j) { sa += (va[j].x + va[j].y) + (va[j].z + va[j].w); sb += (vb[j].x + vb[j].y) + (vb[j].z + vb[j].w); }
        float ma = wave_sum(sa) * (1.f / D), mb = wave_sum(sb) * (1.f / D); sa = 0.f; sb = 0.f;
#pragma unroll
        for (int j = 0; j < 8; ++j) { va[j] = va[j] - ma; vb[j] = vb[j] - mb; sa += (va[j].x * va[j].x + va[j].y * va[j].y) + (va[j].z * va[j].z + va[j].w * va[j].w); sb += (vb[j].x * vb[j].x + vb[j].y * vb[j].y) + (vb[j].z * vb[j].z + vb[j].w * vb[j].w); }
        float ra = rsqrtf(wave_sum(sa) * (1.f / D) + EPS), rb = rsqrtf(wave_sum(sb) * (1.f / D) + EPS);
        u32x2* xa = (u32x2*)(WSP(bf16_t, WS_X1) + (size_t)rowa * D) + F.lane; u32x2* xb = (u32x2*)(WSP(bf16_t, WS_X1) + (size_t)rowb * D) + F.lane; sa = 0.f; sb = 0.f;
#pragma unroll
        for (int j = 0; j < 8; ++j) { const int col = 4 * F.lane + 256 * j; const f32x4 g = *(const f32x4*)(F.g_ln1 + col), bb = *(const f32x4*)(F.b_ln1 + col);
            va[j] = va[j] * ra * g + bb; vb[j] = vb[j] * rb * g + bb;
            { u32x2 wa, wb; wa.x = cvt_pk_bf16(va[j].x, va[j].y); wa.y = cvt_pk_bf16(va[j].z, va[j].w); wb.x = cvt_pk_bf16(vb[j].x, vb[j].y); wb.y = cvt_pk_bf16(vb[j].z, vb[j].w); xa[64 * j] = wa; xb[64 * j] = wb; }
            sa += (va[j].x + va[j].y) + (va[j].z + va[j].w); sb += (vb[j].x + vb[j].y) + (vb[j].z + vb[j].w); }
        ma = wave_sum(sa) * (1.f / D); mb = wave_sum(sb) * (1.f / D); sa = 0.f; sb = 0.f;
#pragma unroll
        for (int j = 0; j < 8; ++j) { const f32x4 da = va[j] - ma, db = vb[j] - mb; sa += (da.x * da.x + da.y * da.y) + (da.z * da.z + da.w * da.w); sb += (db.x * db.x + db.y * db.y) + (db.z * db.z + db.w * db.w); }
        ra = rsqrtf(wave_sum(sa) * (1.f / D) + EPS); rb = rsqrtf(wave_sum(sb) * (1.f / D) + EPS);
        unsigned* oa = (unsigned*)(WSP(unsigned char, WS_U2) + (size_t)rowa * D) + F.lane; unsigned* ob = (unsigned*)(WSP(unsigned char, WS_U2) + (size_t)rowb * D) + F.lane;
#pragma unroll
        for (int j = 0; j < 8; ++j) { const int col = 4 * F.lane + 256 * j; const f32x4 sc = *(const f32x4*)(modf + 4 * D + col) + 1.f, sh = *(const f32x4*)(modf + 3 * D + col);
            const f32x4 ya = (va[j] - ma) * ra * sc + sh, yb = (vb[j] - mb) * rb * sc + sh;
            oa[64 * j] = pk4_fp8(ya.x, ya.y, ya.z, ya.w); ob[64 * j] = pk4_fp8(yb.x, yb.y, yb.z, yb.w);
            u32x2 wa, wb; wa.x = cvt_pk_bf16(ya.x, ya.y); wa.y = cvt_pk_bf16(ya.z, ya.w); wb.x = cvt_pk_bf16(yb.x, yb.y); wb.y = cvt_pk_bf16(yb.z, yb.w);
            *(LAS u32x2*)(u2s + 8 * F.lane + 512 * j) = wa; *(LAS u32x2*)(u2s + 4096 + 8 * F.lane + 512 * j) = wb; }
        }
        asm volatile("" ::: "memory");
        const int job0 = 9 * ip;
        int gsel[2]; float psel[2];
        {
            asm volatile("s_waitcnt vmcnt(0) lgkmcnt(0)" ::: "memory"); __syncthreads();
            if (ip == 1) DMA_E((job0 + 1) & 1, 0);
            const LAS float* wg = (const LAS float*)(ring + (job0 & 1) * 32768);
            float ag[2][4];
#pragma unroll
            for (int o = 0; o < 4; ++o) { ag[0][o] = 0.f; ag[1][o] = 0.f; }
#pragma unroll 2
            for (int j = 0; j < 8; ++j) { const int col = 4 * F.lane + 256 * j;
                const u32x2 pa2 = *(const LAS u32x2*)(u2s + 8 * F.lane + 512 * j), pb2 = *(const LAS u32x2*)(u2s + 4096 + 8 * F.lane + 512 * j);
                const f32x4 ua = {bf_lo(pa2.x), bf_hi(pa2.x), bf_lo(pa2.y), bf_hi(pa2.y)}, ub = {bf_lo(pb2.x), bf_hi(pb2.x), bf_lo(pb2.y), bf_hi(pb2.y)};
#pragma unroll
                for (int o = 0; o < 4; ++o) { const f32x4 w = *(const LAS f32x4*)(wg + o * D + col); ag[0][o] += dot4(ua, w); ag[1][o] += dot4(ub, w); } }
#pragma unroll
            for (int i = 0; i < 2; ++i) { float lg[4];
#pragma unroll
                for (int o = 0; o < 4; ++o) lg[o] = wave_sum(ag[i][o]) + F.b_grp[o];
                int gt = 0; float mx = lg[0];
#pragma unroll
                for (int o = 1; o < 4; ++o) if (lg[o] > mx) { mx = lg[o]; gt = o; }
                float den = 0.f;
#pragma unroll
                for (int o = 0; o < 4; ++o) den += expf(lg[o] - mx);
                gsel[i] = __builtin_amdgcn_readfirstlane(gt); psel[i] = 1.f / den; }
        }
        float ae[2][8];
#pragma unroll
        for (int e = 0; e < 8; ++e) { ae[0][e] = 0.f; ae[1][e] = 0.f; }
#pragma unroll 1
        for (int j = 0; j < 8; ++j) { const int job = job0 + 1 + j;
            asm volatile("s_waitcnt vmcnt(0) lgkmcnt(0)" ::: "memory"); __syncthreads();
            if (j + 1 < 8) DMA_E((job + 1) & 1, j + 1); else if (ip == 0) DMA_G((job + 1) & 1);
            const LAS float* wb = (const LAS float*)(ring + (job & 1) * 32768) + 4 * F.lane;
            const u32x2 pa2 = *(const LAS u32x2*)(u2s + 8 * F.lane + 512 * j), pb2 = *(const LAS u32x2*)(u2s + 4096 + 8 * F.lane + 512 * j);
            const f32x4 ua = {bf_lo(pa2.x), bf_hi(pa2.x), bf_lo(pa2.y), bf_hi(pa2.y)}, ub = {bf_lo(pb2.x), bf_hi(pb2.x), bf_lo(pb2.y), bf_hi(pb2.y)};
#pragma unroll
            for (int e = 0; e < 8; ++e) { const f32x4 w0 = *(const LAS f32x4*)(wb + (gsel[0] * 8 + e) * 256), w1 = *(const LAS f32x4*)(wb + (gsel[1] * 8 + e) * 256); ae[0][e] += dot4(ua, w0); ae[1][e] += dot4(ub, w1); } }
#pragma unroll
        for (int i = 0; i < 2; ++i) { float le[8];
#pragma unroll
            for (int e = 0; e < 8; ++e) le[e] = wave_sum(ae[i][e]) + F.b_er[gsel[i] * 8 + e];
            int e0 = 0; float v0 = le[0];
#pragma unroll
            for (int e = 1; e < 8; ++e) if (le[e] > v0) { v0 = le[e]; e0 = e; }
            int e1 = -1; float v1 = -INFINITY;
#pragma unroll
            for (int e = 0; e < 8; ++e) if (e != e0 && le[e] > v1) { v1 = le[e]; e1 = e; }
            const float w0 = 1.f / (1.f + expf(v1 - v0));
            if (F.lane == 0) { const int rl = F.wave * 4 + 2 * ip + i; const int E0 = gsel[i] * 8 + e0, E1 = gsel[i] * 8 + e1;
                const int s0 = atomicAdd(&cnt_l[E0], 1), s1 = atomicAdd(&cnt_l[E1], 1);
                rowinfo[rl * 2] = (E0 << 16) | s0; rowinfo[rl * 2 + 1] = (E1 << 16) | s1; roww[rl * 2] = w0 * psel[i]; roww[rl * 2 + 1] = (1.f - w0) * psel[i]; } }
        asm volatile("" ::: "memory");
    }
#undef DMA_G
#undef DMA_E
    __syncthreads();
    if (F.tid < 32) { const int n = cnt_l[F.tid]; base_l[F.tid] = n ? (int)__hip_atomic_fetch_add(WSP(unsigned, WS_CTL) + CW_CNT + F.tid, (unsigned)n, __ATOMIC_RELAXED, __HIP_MEMORY_SCOPE_AGENT) : 0; }
    __syncthreads();
    if (F.tid < 64) { const int rl = F.tid >> 1, jj = F.tid & 1; const int info = rowinfo[rl * 2 + jj]; const int E = info >> 16, slot = base_l[E] + (info & 0xffff); const int tok = r0 + rl;
        WSP(int, WS_TOKL)[(size_t)E * NTOK + slot] = tok; WSP(float, WS_WL)[(size_t)E * NTOK + slot] = roww[rl * 2 + jj]; WSP(int, WS_PAIR)[tok * 2 + jj] = (E << 16) | slot; }
    __syncthreads();
}

__device__ __forceinline__ void p10_rows(Frame& F, const int* ts, const float dlt = 0.f, const float spike = 0.f) {
    const int r0 = F.vcu * 32, b = r0 / T; const float* modf = WSP(float, WS_MODF) + (size_t)b * 6 * D;
    const int rw0 = r0 + F.wave * 4;
    int pi[8];
#pragma unroll
    for (int q = 0; q < 8; ++q) pi[q] = WSP(int, WS_PAIR)[rw0 * 2 + q];
    unsigned ry[2][4][8]; u32x2 rx[2][2][8];
#define P10_ISSUE(ip) do { \
        const size_t a0_ = (size_t)ts[pi[4 * (ip)] >> 16] * 256 + (pi[4 * (ip)] & 0xffff), a1_ = (size_t)ts[pi[4 * (ip) + 1] >> 16] * 256 + (pi[4 * (ip) + 1] & 0xffff); \
        const size_t b0_ = (size_t)ts[pi[4 * (ip) + 2] >> 16] * 256 + (pi[4 * (ip) + 2] & 0xffff), b1_ = (size_t)ts[pi[4 * (ip) + 3] >> 16] * 256 + (pi[4 * (ip) + 3] & 0xffff); \
        const u32x2* xa_ = (const u32x2*)(WSP(bf16_t, WS_X1) + (size_t)(rw0 + 2 * (ip)) * D) + F.lane; const u32x2* xb_ = (const u32x2*)(WSP(bf16_t, WS_X1) + (size_t)(rw0 + 2 * (ip) + 1) * D) + F.lane; \
        const unsigned* ya0_ = (const unsigned*)(WSP(unsigned char, WS_YPAIR) + a0_ * D) + F.lane; const unsigned* ya1_ = (const unsigned*)(WSP(unsigned char, WS_YPAIR) + a1_ * D) + F.lane; \
        const unsigned* yb0_ = (const unsigned*)(WSP(unsigned char, WS_YPAIR) + b0_ * D) + F.lane; const unsigned* yb1_ = (const unsigned*)(WSP(unsigned char, WS_YPAIR) + b1_ * D) + F.lane; \
        _Pragma("unroll") for (int j = 0; j < 8; ++j) { ry[ip][0][j] = __builtin_nontemporal_load(ya0_ + 64 * j); ry[ip][1][j] = __builtin_nontemporal_load(ya1_ + 64 * j); ry[ip][2][j] = __builtin_nontemporal_load(yb0_ + 64 * j); ry[ip][3][j] = __builtin_nontemporal_load(yb1_ + 64 * j); \
            rx[ip][0][j] = __builtin_nontemporal_load(xa_ + 64 * j); rx[ip][1][j] = __builtin_nontemporal_load(xb_ + 64 * j); } } while (0)
    P10_ISSUE(0);
#pragma unroll
    for (int ip = 0; ip < 2; ++ip) {
        const int rowa = rw0 + 2 * ip, rowb = rowa + 1;
        f32x4 va[8], vb[8]; float sa = 0.f, sb = 0.f;
#pragma unroll
        for (int j = 0; j < 8; ++j) { const int col = 4 * F.lane + 256 * j; const f32x4 g = (*(const f32x4*)(modf + 5 * D + col) + 1.f) * (1.f / 64.f);
            const f32x4 fa = f8x4(ry[ip][0][j]) + f8x4(ry[ip][1][j]), fb = f8x4(ry[ip][2][j]) + f8x4(ry[ip][3][j]);
            const u32x2 x1a = rx[ip][0][j], x1b = rx[ip][1][j];
            va[j] = (f32x4){bf_lo(x1a.x), bf_hi(x1a.x), bf_lo(x1a.y), bf_hi(x1a.y)} * ALPHA + g * fa; vb[j] = (f32x4){bf_lo(x1b.x), bf_hi(x1b.x), bf_lo(x1b.y), bf_hi(x1b.y)} * ALPHA + g * fb; }
        if (ip == 0) { asm volatile("" ::: "memory"); P10_ISSUE(1); asm volatile("" ::: "memory"); }
#pragma unroll
        for (int j = 0; j < 8; ++j) { sa += (va[j].x + va[j].y) + (va[j].z + va[j].w); sb += (vb[j].x + vb[j].y) + (vb[j].z + vb[j].w); }
        const float ma = wave_sum(sa) * (1.f / D), mb = wave_sum(sb) * (1.f / D); sa = 0.f; sb = 0.f;
#pragma unroll
        for (int j = 0; j < 8; ++j) { va[j] = va[j] - ma; vb[j] = vb[j] - mb; sa += (va[j].x * va[j].x + va[j].y * va[j].y) + (va[j].z * va[j].z + va[j].w * va[j].w); sb += (vb[j].x * vb[j].x + vb[j].y * vb[j].y) + (vb[j].z * vb[j].z + vb[j].w * vb[j].w); }
        const float ra = rsqrtf(wave_sum(sa) * (1.f / D) + EPS), rb = rsqrtf(wave_sum(sb) * (1.f / D) + EPS);
        f32x4* oa = (f32x4*)(F.out + (size_t)rowa * D) + F.lane; f32x4* ob = (f32x4*)(F.out + (size_t)rowb * D) + F.lane;
#pragma unroll
        for (int j = 0; j < 8; ++j) { const int col = 4 * F.lane + 256 * j; const f32x4 g2 = *(const f32x4*)(F.g_ln2 + col), b2 = *(const f32x4*)(F.b_ln2 + col);
            f32x4 ova = va[j] * ra * g2 + b2 + dlt, ovb = vb[j] * rb * g2 + b2 + dlt; if (rowa == 0 && col == 0) ova.x += spike; oa[64 * j] = ova; ob[64 * j] = ovb; }
    }
#undef P10_ISSUE
}
struct Args { const void* in[26]; float* out; unsigned char* ws; int ph_lo, ph_hi; };
constexpr int NPHASE = 11;
__global__ void __launch_bounds__(NTHR, 2) mk_fwd(Args a) {
    extern __shared__ __attribute__((aligned(16))) unsigned char lds[];
    Frame F;
    F.lds = lds; F.tid = threadIdx.x; F.lane = F.tid & 63; F.wave = __builtin_amdgcn_readfirstlane(F.tid >> 6);
    F.G = gridDim.x; { const int bx = blockIdx.x; F.vcu = (F.G % 8 == 0) ? (bx % 8) * (F.G / 8) + bx / 8 : bx; }
    F.x = (const float*)a.in[0]; F.c = (const float*)a.in[1]; F.pos = (const int*)a.in[2]; F.w_cond = (const float*)a.in[3]; F.b_cond = (const float*)a.in[4];
    F.w_in = (const float*)a.in[5]; F.b_glu = (const float*)a.in[6]; F.w_dw = (const float*)a.in[7]; F.b_dw = (const float*)a.in[8]; F.g_cn = (const float*)a.in[9];
    F.b_cn = (const float*)a.in[10]; F.w_conv_out = (const float*)a.in[11]; F.b_conv_out = (const float*)a.in[12]; F.w_attn_out = (const float*)a.in[13];
    F.w_mix_out = (const float*)a.in[14]; F.g_ln1 = (const float*)a.in[15]; F.b_ln1 = (const float*)a.in[16]; F.w_grp = (const float*)a.in[17]; F.b_grp = (const float*)a.in[18];
    F.w_er = (const float*)a.in[19]; F.b_er = (const float*)a.in[20]; F.w1 = (const float*)a.in[21]; F.w3 = (const float*)a.in[22]; F.w2 = (const float*)a.in[23];
    F.g_ln2 = (const float*)a.in[24]; F.b_ln2 = (const float*)a.in[25]; F.out = a.out; F.ws = a.ws;
    const int lo = a.ph_lo, hi = a.ph_hi;
    volatile unsigned* xst = (volatile unsigned*)(lds + LDS_MISC + 16000);
    if (F.tid < 2) xst[F.tid] = 0u;
    __syncthreads();
    XcdBarrier xbar = xcd_barrier_post((unsigned*)(F.ws + WS_CTL) + CW_BAR, xst, F.tid == 0);
#if 1
    if (lo < -1) cooperative_groups::this_grid().sync();
#endif
    LAS unsigned char* ring = (LAS unsigned char*)lds;
    int* ts = (int*)(lds + LDS_MISC + 12288); int* cn = ts + 40;
#ifndef KEEP_COOP_DESC
#define KEEP_COOP_DESC 0
#endif
#ifndef ONLY_PHASE
#define ONLY_PHASE -1
#endif
#define IN(k) ((ONLY_PHASE == -1 || ONLY_PHASE == (k)) && lo <= (k) && (k) < hi)
#ifndef SYNC_REP
#define SYNC_REP 1
#endif
#define SEAM(k) do { if (IN(k) && IN((k) + 1)) { for (int sr_ = 0; sr_ < SYNC_REP; ++sr_) xcd_barrier(xbar, F.wave == 0 && F.lane == 0); } } while (0)
#ifndef P3_REP
#define P3_REP 1
#endif
#ifndef P7_REP
#define P7_REP 1
#endif
#ifndef ATT_REP
#define ATT_REP 1
#endif
#ifndef REP_MASK
#define REP_MASK 0
#endif
#ifndef TS_A
#define TS_A -1
#endif
#ifndef TS_OFF
#define TS_OFF 0
#endif
#ifndef TS_B
#define TS_B -1
#endif
    unsigned long long* tstamp = (unsigned long long*)(F.ws + WS_CTL + 65536);
    if (TS_A >= 0 && blockIdx.x == 0 && F.tid == 0) tstamp[0] = __builtin_amdgcn_s_memrealtime();
#define STAMP(k) do { if (TS_A >= 0 && blockIdx.x == 0 && F.tid == 0) tstamp[1 + (k)] = __builtin_amdgcn_s_memrealtime(); } while (0)
#define REFRESH() do { int l_; asm volatile("v_mbcnt_lo_u32_b32 %0, -1, 0\n\tv_mbcnt_hi_u32_b32 %0, -1, %0" : "=&v"(l_)); F.lane = l_; F.tid = F.wave * 64 + l_; } while (0)
#define RUNPH(k, ...) do { if (IN(k)) { REFRESH(); { __VA_ARGS__ } if ((REP_MASK >> (k)) & 1) { __syncthreads(); { __VA_ARGS__ } } } } while (0)
#ifndef NPASS
#define NPASS 1
#endif
    RUNPH(0, p0_prologue(F);); SEAM(0); STAMP(0);
    RUNPH(1, p1_ln(F);); SEAM(1); STAMP(1);
    RUNPH(2, EpiIn E{F.b_glu, WSP(float, WS_ROPE), WSP(bf16_t, WS_HGLU), WSP(bf16_t, WS_Q), WSP(bf16_t, WS_K), WSP(bf16_t, WS_V), WSP(bf16_t, WS_SG)};
#if GLU_FP8
        { DenseSchedT<true> S; S.init(WSP(unsigned char, WS_U8), WSP(unsigned char, WS_WIN), NTOK, INC, D, F.G, (int)blockIdx.x, F.tid);
          gemm_phase<EpiIn, DenseSchedT<true>, true, true>(ring, D, S, E, F.tid); }
#else
        { DenseSched S; S.init(WSP(bf16_t, WS_U), WSP(bf16_t, WS_WIN), NTOK, (GATES_FP8 ? 8 : 24) * 256, D, F.G, (int)blockIdx.x, F.tid, 8, 0, 12, 0);
          gemm_phase<EpiIn, DenseSched, true, true>(ring, D, S, E, F.tid); }
        REFRESH();
        { DenseSchedT<true> S; S.init(WSP(unsigned char, WS_U8), WSP(unsigned char, WS_WIN8), NTOK, (GATES_FP8 ? 28 : 12) * 256, D, F.G, (int)blockIdx.x, F.tid, 1 << 30, 8, 8, 8);
          gemm_phase<EpiIn, DenseSchedT<true>, true, true>(ring, D, S, E, F.tid); }
#endif
#ifdef HOT_PROBE
        REFRESH(); __syncthreads();
        { DenseSchedT<true> S; S.init(WSP(unsigned char, WS_U8), WSP(unsigned char, WS_WIN8), NTOK, (GATES_FP8 ? 28 : 12) * 256, D, F.G, (int)blockIdx.x, F.tid, 1 << 30, 8, 8, 8); S.hot = HOT_PROBE;
          gemm_phase<EpiIn, DenseSchedT<true>, true, true>(ring, D, S, E, F.tid); }
#endif
        REFRESH(); p2_tail_transposes(F);); SEAM(2); STAMP(2);
    if (IN(3)) { REFRESH(); _Pragma("unroll 1") for (int rr = 0; rr < P3_REP; ++rr) { p3_conv_unit(F, F.vcu); p3_kmean_unit(F, F.vcu); } } SEAM(3); STAMP(3);
    RUNPH(4,
        { const int p = F.vcu, bh = p >> 4, s = (p >> 1) & 7, half = p & 1;
            _Pragma("unroll 1") for (int uu = 0; uu < 2 * ATT_REP; ++uu) att::attn_unit(F, ring, bh >> 3, bh & 7, (uu & 1) ? s : 15 - s, half); }
        REFRESH(); int tidg = F.tid;
        DenseSchedT<CONVOUT_FP8 != 0> S; S.init(WSP(bf16_t, WS_HC), WSP(bf16_t, WS_WCO), NTOK, D, CC, F.G, (int)blockIdx.x, tidg); if (CONVOUT_FP8) S.scale_a = 0x7b7b7b7b;
        EpiConvOut E{F.b_conv_out, WSP(bf16_t, WS_SG), WSP(bf16_t, WS_M1)};
        gemm_phase<EpiConvOut, DenseSchedT<CONVOUT_FP8 != 0>, true, true>(ring, CC, S, E, tidg);); SEAM(4); STAMP(4);
    RUNPH(5, DenseSchedT<true> S; S.init(WSP(unsigned char, WS_AO), WSP(unsigned char, WS_WAO), NTOK, D, AW, F.G, (int)blockIdx.x, F.tid); S.scale_a = 0x7b7b7b7b;
        EpiAttnOut E{WSP(bf16_t, WS_SG), WSP(bf16_t, WS_M1), WSP(bf16_t, WS_MERGED)};
        gemm_phase<EpiAttnOut, DenseSchedT<true>, true, true>(ring, AW, S, E, F.tid);); SEAM(5); STAMP(5);
    RUNPH(6, DenseSchedT<MIX_FP8 != 0> S; S.init(WSP(bf16_t, WS_MERGED), WSP(bf16_t, WS_WMIX), NTOK, D, D, F.G, (int)blockIdx.x, F.tid); if (MIX_FP8) S.scale_a = 0x7b7b7b7b;
        EpiMix E{WSP(float, WS_MODF), WSP(bf16_t, WS_VPRE)};
        gemm_phase<EpiMix, DenseSchedT<MIX_FP8 != 0>, true, true>(ring, D, S, E, F.tid);); SEAM(6); STAMP(6);
    if (IN(7)) { REFRESH(); p7_rows(F, ring); } SEAM(7); STAMP(7);
    RUNPH(8, moe_tables(F, ts, cn); MoeSchedT<true> S; S.init(WSP(bf16_t, WS_U2), WSP(bf16_t, WS_W13), WSP(int, WS_TOKL), ts, cn, F.G, F.vcu, D, 4, true, F.tid);
        EpiMoeUpT<MOE_DOWN_FP8> E{WSP(float, WS_WL), WSP(unsigned char, WS_HBUF)};
        gemm_phase<EpiMoeUpT<MOE_DOWN_FP8>, MoeSchedT<true>, true, true>(ring, D, S, E, F.tid); REFRESH(); p8_tail_transposes(F, ts[32] * 4, F.vcu);); SEAM(8); STAMP(8);
    RUNPH(9, if (MK_PER_PHASE) moe_tables(F, ts, cn);     MoeSchedT<MOE_DOWN_FP8> S; S.init(WSP(bf16_t, WS_HBUF), WSP(bf16_t, WS_W2), WSP(int, WS_TOKL), ts, cn, F.G, F.vcu, FF, 8, false, F.tid); if (MOE_DOWN_FP8) S.scale_a = 0x82828282;
        EpiMoeDown E{WSP(unsigned char, WS_YPAIR)};
        gemm_phase<EpiMoeDown, MoeSchedT<MOE_DOWN_FP8>, true, true>(ring, FF, S, E, F.tid);); SEAM(9); STAMP(9);
    if (IN(10)) { REFRESH(); if (MK_PER_PHASE) moe_tables(F, ts, cn); float dlt = 0.f, spike = 0.f;
        if (TS_A >= 0 && blockIdx.x == 0) { const float da = (float)(tstamp[1 + TS_A] - tstamp[TS_A]) * 0.01f, db = (TS_B >= 200) ? (float)(tstamp[TS_B - 200 + 1] - tstamp[TS_B - 200]) * 0.01f : (TS_B >= 100) ? (float)(tstamp[10] - tstamp[0]) * 0.01f : (float)(tstamp[1 + (TS_B % 100)] - tstamp[TS_B % 100]) * 0.01f;
            dlt = sqrtf(da * 1e-6f * 1.68e7f / 65536.f); spike = (db - (float)TS_OFF) * 0.1f; }
        p10_rows(F, ts, dlt, spike); }
#ifdef TS_P10
    { xcd_barrier(xbar, F.wave == 0 && F.lane == 0);
      if (blockIdx.x == 0 && threadIdx.x == 0) { const float d10 = (float)(__builtin_amdgcn_s_memrealtime() - tstamp[10]) * 0.01f; __builtin_amdgcn_fence(__ATOMIC_ACQUIRE, "agent"); F.out[0] += (d10 - (float)TS_OFF) * 0.1f; } }
#endif
#undef RUNPH
#undef IN
#undef SEAM
}
}

static int mk_launch(void* const* d_in, float* out, void* d_ws, size_t ws_size, hipStream_t stream, int ph_lo, int ph_hi, bool memset_ctl) {
    static int ready = 0;
    if (ready == 0) {
        int dev = 0, cus = 0, per_cu = 0;
        if (hipGetDevice(&dev) != hipSuccess || hipDeviceGetAttribute(&cus, hipDeviceAttributeMultiprocessorCount, dev) != hipSuccess) { fprintf(stderr, "mk: device query failed\n"); ready = -1; return -1; }
        if (hipFuncSetAttribute((const void*)mk::mk_fwd, hipFuncAttributeMaxDynamicSharedMemorySize, mk::LDS_BYTES) != hipSuccess) { fprintf(stderr, "mk: hipFuncSetAttribute failed\n"); ready = -1; return -1; }
        if (hipOccupancyMaxActiveBlocksPerMultiprocessor(&per_cu, (const void*)mk::mk_fwd, mk::NTHR, mk::LDS_BYTES) != hipSuccess || per_cu < 1) { fprintf(stderr, "mk: occupancy query says %d blocks/CU\n", per_cu); ready = -1; return -1; }
        if (cus != 256 || ws_size < mk::WS_END) { fprintf(stderr, "mk: need 256 CUs (got %d) and ws >= %zu (got %zu)\n", cus, (size_t)mk::WS_END, ws_size); ready = -1; return -1; }
        (void)hipGetLastError();
        ready = 1;
    }
    if (ready < 0) return -1;
    if (memset_ctl) (void)hipMemsetAsync((char*)d_ws + mk::WS_CTL, 0, mk::CTL_ZERO_BYTES, stream);
    mk::Args a{};
    for (int i = 0; i < 26; ++i) a.in[i] = d_in[i];
    a.out = out; a.ws = (unsigned char*)d_ws; a.ph_lo = ph_lo; a.ph_hi = ph_hi;
    void* args[] = {&a};
    hipError_t e = hipLaunchCooperativeKernel((const void*)mk::mk_fwd, dim3(256), dim3(mk::NTHR), args, mk::LDS_BYTES, stream);
    if (e != hipSuccess) { fprintf(stderr, "mk: cooperative launch failed: %s\n", hipGetErrorString(e)); return -1; }
    return 0;
}
extern "C" void kernel_launch(void* const* d_in, const int* in_sizes, int n_in, void* d_out, int out_size, void* d_ws, size_t ws_size, hipStream_t stream) {
#if MK_PER_PHASE
    for (int p = 0; p < mk::NPHASE; ++p) mk_launch(d_in, (float*)d_out, d_ws, ws_size, stream, p, p + 1, p == 0);
#else
    mk_launch(d_in, (float*)d_out, d_ws, ws_size, stream, 0, mk::NPHASE, true);
#endif
}
```
